# Optimizing an MI355X kernel written in HIP

```python
import jax, jax.numpy as jnp
from jax import lax
import numpy as np

D_MODEL = 1024
BATCH = 32
SEQ = 2048
DEPTH = 2

CHUNK = 64
MIX_WIDTH = D_MODEL
SB_HEAD_DIM = 64
SB_WIDTH = MIX_WIDTH // 2
SB_HEADS = SB_WIDTH // SB_HEAD_DIM
SB_SCALE = SB_HEAD_DIM ** -0.5
Q_BLOCK = 128
SG_GROUP_DIM = 64
SG_WIDTH = MIX_WIDTH - SB_WIDTH
SG_GROUPS = SG_WIDTH // SG_GROUP_DIM
SG_BLOCK = 128
IN_PROJ_WIDTH = 3 * SB_WIDTH + 2 * SG_WIDTH
D_FF = ((8 * D_MODEL // 3 + 127) // 128) * 128
N_EXPERTS = 8
TOP_K = 2
D_EXPERT = 7 * D_MODEL // 2
MOE_BLOCK = 512
N_DENSE = (DEPTH + 1) // 2
N_MOE = DEPTH // 2
EPS = 1e-6

kernel_name = 'hybrid_stickbreak_gmlp_moe_adaln'


def rms_norm(x, g):
    xf = x.astype(jnp.float32)
    y = xf * lax.rsqrt(jnp.mean(xf * xf, axis=-1, keepdims=True) + EPS)
    return (y * g.astype(jnp.float32)).astype(x.dtype)


def layer_norm(x, g, b):
    xf = x.astype(jnp.float32)
    mu = jnp.mean(xf, axis=-1, keepdims=True)
    var = jnp.mean(jnp.square(xf - mu), axis=-1, keepdims=True)
    y = (xf - mu) * lax.rsqrt(var + EPS) * g.astype(jnp.float32) + b.astype(jnp.float32)
    return y.astype(x.dtype)


def stick_breaking_attention(q, k, v):
    S = q.shape[2]
    outs = []
    for i in range(S // Q_BLOCK):
        q0 = i * Q_BLOCK
        kv_len = q0 + Q_BLOCK
        qb = q[:, :, q0:kv_len]
        kb = k[:, :, :kv_len]
        vb = v[:, :, :kv_len]
        z = jnp.einsum('bhqd,bhkd->bhqk', qb, kb).astype(jnp.float32) * SB_SCALE
        q_pos = q0 + jnp.arange(Q_BLOCK)
        k_pos = jnp.arange(kv_len)
        strict = k_pos[None, :] < q_pos[:, None]
        log_keep = jnp.where(strict, jax.nn.log_sigmoid(-z), 0.0)
        log_after = lax.cumsum(log_keep, axis=3, reverse=True) - log_keep
        w = jnp.where(strict, jnp.exp(jax.nn.log_sigmoid(z) + log_after), 0.0)
        outs.append(jnp.einsum('bhqk,bhkd->bhqd', w.astype(vb.dtype), vb))
    return jnp.concatenate(outs, axis=2)


def spatial_gating(u, v, ln_g, ln_b, w_s, b_s):
    B, S, _ = v.shape
    v = layer_norm(v, ln_g, ln_b)
    nb = S // SG_BLOCK
    v = v.reshape(B, nb, SG_BLOCK, SG_GROUPS, SG_GROUP_DIM)
    pos = jnp.arange(SG_BLOCK)
    chunk_causal = (pos[None, :] // CHUNK) <= (pos[:, None] // CHUNK)
    w = jnp.where(chunk_causal[None], w_s, 0.0).astype(v.dtype)
    mixed = jnp.einsum('gij,bnjgc->bnigc', w, v) + b_s.T[None, None, :, :, None].astype(v.dtype)
    return u * mixed.reshape(B, S, SG_WIDTH)


def token_mixer(h, w_in, q_g, k_g, ln_g, ln_b, w_s, b_s, w_out):
    B, S, _ = h.shape
    proj = h @ w_in
    q, k, v, u_sg, v_sg = jnp.split(
        proj, [SB_WIDTH, 2 * SB_WIDTH, 3 * SB_WIDTH, 3 * SB_WIDTH + SG_WIDTH], axis=-1)
    to_heads = lambda t: t.reshape(B, S, SB_HEADS, SB_HEAD_DIM).transpose(0, 2, 1, 3)
    q = rms_norm(to_heads(q), q_g)
    k = rms_norm(to_heads(k), k_g)
    o_a = stick_breaking_attention(q, k, to_heads(v))
    o_a = o_a.transpose(0, 2, 1, 3).reshape(B, S, SB_WIDTH)
    o_b = spatial_gating(jax.nn.gelu(u_sg, approximate=False), jax.nn.gelu(v_sg, approximate=False),
                         ln_g, ln_b, w_s, b_s)
    return jnp.concatenate([o_a, o_b], axis=-1) @ w_out


def swiglu(h, w_gate, w_up, w_down):
    return (jax.nn.silu(h @ w_gate) * (h @ w_up)) @ w_down


def moe_swiglu(h, router_w, router_b, w_gate, w_up, w_down):
    B, S, D = h.shape
    T = B * S
    A = T * TOP_K
    t = h.reshape(T, D)
    logits = (t @ router_w).astype(jnp.float32) + router_b.astype(jnp.float32)
    top_logit, top_e = lax.top_k(logits, TOP_K)
    gate = jax.nn.softmax(top_logit, axis=-1).astype(h.dtype)
    flat_e = top_e.reshape(A)
    flat_tok = jnp.repeat(jnp.arange(T, dtype=jnp.int32), TOP_K)
    flat_gate = gate.reshape(A)
    order = jnp.argsort(flat_e)
    sorted_e = flat_e[order]
    counts = jnp.bincount(flat_e, length=N_EXPERTS)
    seg_start = jnp.cumsum(counts) - counts
    padded = (counts + MOE_BLOCK - 1) // MOE_BLOCK * MOE_BLOCK
    pad_end = jnp.cumsum(padded)
    pad_start = pad_end - padded
    dest = pad_start[sorted_e] + (jnp.arange(A) - seg_start[sorted_e])
    n_blocks = -(-A // MOE_BLOCK) + N_EXPERTS
    P = n_blocks * MOE_BLOCK
    slot_tok = jnp.zeros((P,), jnp.int32).at[dest].set(flat_tok[order])
    slot_gate = jnp.zeros((P,), h.dtype).at[dest].set(flat_gate[order])
    block_e = jnp.minimum(
        jnp.searchsorted(pad_end, jnp.arange(n_blocks) * MOE_BLOCK, side='right'), N_EXPERTS - 1)
    xb = t[slot_tok].reshape(n_blocks, MOE_BLOCK, D)

    def expert_block(args):
        xe, e = args
        return (jax.nn.silu(xe @ w_gate[e]) * (xe @ w_up[e])) @ w_down[e]

    yb = lax.map(expert_block, (xb, block_e)).reshape(P, D)
    y = jax.ops.segment_sum(yb * slot_gate[:, None], slot_tok, num_segments=T)
    return y.reshape(B, S, D)


def setup_inputs(seed: int = 0) -> dict:
    key = jax.random.key(seed)
    ks = jax.random.split(key, 24)
    nrm = lambda k, shape, s: jax.random.normal(k, shape, jnp.float32) * s
    D = D_MODEL
    return {
        'x': nrm(ks[0], (BATCH, SEQ, D), 1.0),
        'c': nrm(ks[1], (BATCH, D), 1.0),
        'ada_w': nrm(ks[2], (DEPTH, D, 6 * D), 0.5 * D ** -0.5),
        'ada_b': nrm(ks[3], (DEPTH, 6 * D), 0.02),
        'norm_mix_g': 1.0 + nrm(ks[4], (DEPTH, D), 0.02),
        'norm_ffn_g': 1.0 + nrm(ks[5], (DEPTH, D), 0.02),
        'w_in': nrm(ks[6], (DEPTH, D, IN_PROJ_WIDTH), D ** -0.5),
        'q_norm_g': 1.0 + nrm(ks[7], (DEPTH, SB_HEAD_DIM), 0.02),
        'k_norm_g': 1.0 + nrm(ks[8], (DEPTH, SB_HEAD_DIM), 0.02),
        'sg_ln_g': 1.0 + nrm(ks[9], (DEPTH, SG_WIDTH), 0.02),
        'sg_ln_b': nrm(ks[10], (DEPTH, SG_WIDTH), 0.02),
        'sg_w_spatial': nrm(ks[11], (DEPTH, SG_GROUPS, SG_BLOCK, SG_BLOCK), 0.5 * SG_BLOCK ** -0.5),
        'sg_b_spatial': 1.0 + nrm(ks[12], (DEPTH, SG_GROUPS, SG_BLOCK), 0.1),
        'w_out': nrm(ks[13], (DEPTH, MIX_WIDTH, D), MIX_WIDTH ** -0.5),
        'ffn_w_gate': nrm(ks[14], (N_DENSE, D, D_FF), D ** -0.5),
        'ffn_w_up': nrm(ks[15], (N_DENSE, D, D_FF), D ** -0.5),
        'ffn_w_down': nrm(ks[16], (N_DENSE, D_FF, D), D_FF ** -0.5),
        'router_w': nrm(ks[17], (N_MOE, D, N_EXPERTS), D ** -0.5),
        'router_b': nrm(ks[18], (N_MOE, N_EXPERTS), 0.01),
        'moe_w_gate': nrm(ks[19], (N_MOE, N_EXPERTS, D, D_EXPERT), D ** -0.5),
        'moe_w_up': nrm(ks[20], (N_MOE, N_EXPERTS, D, D_EXPERT), D ** -0.5),
        'moe_w_down': nrm(ks[21], (N_MOE, N_EXPERTS, D_EXPERT, D), D_EXPERT ** -0.5),
    }


def reference(x, c, ada_w, ada_b, norm_mix_g, norm_ffn_g, w_in, q_norm_g, k_norm_g,
              sg_ln_g, sg_ln_b, sg_w_spatial, sg_b_spatial, w_out,
              ffn_w_gate, ffn_w_up, ffn_w_down, router_w, router_b,
              moe_w_gate, moe_w_up, moe_w_down):
    c_act = jax.nn.silu(c)
    for l in range(DEPTH):
        ada = (c_act @ ada_w[l] + ada_b[l])[:, None, :]
        sh1, sc1, g1, sh2, sc2, g2 = jnp.split(ada, 6, axis=-1)
        h = rms_norm(x, norm_mix_g[l]) * (1.0 + sc1) + sh1
        x = x + g1 * token_mixer(h, w_in[l], q_norm_g[l], k_norm_g[l], sg_ln_g[l], sg_ln_b[l],
                                 sg_w_spatial[l], sg_b_spatial[l], w_out[l])
        h = rms_norm(x, norm_ffn_g[l]) * (1.0 + sc2) + sh2
        if l % 2 == 0:
            j = l // 2
            y = swiglu(h, ffn_w_gate[j], ffn_w_up[j], ffn_w_down[j])
        else:
            j = l // 2
            y = moe_swiglu(h, router_w[j], router_b[j], moe_w_gate[j], moe_w_up[j], moe_w_down[j])
        x = x + g2 * y
    return x
```

```cpp
#ifndef FFN_GU_FP8
#define FFN_GU_FP8 0
#endif
#ifndef FFN_DOWN_FP8
#define FFN_DOWN_FP8 1
#endif
#include <hip/hip_runtime.h>
#include <cstdio>
#include <cstdint>
namespace pg8 {
#define PG8_LAS __attribute__((address_space(3)))
typedef unsigned short bf16_t;
typedef short bf16x8 __attribute__((ext_vector_type(8)));
typedef float f32x4 __attribute__((ext_vector_type(4)));
typedef unsigned u32x4 __attribute__((ext_vector_type(4)));
constexpr int BM = 256, BK = 64, HALF = 128, HTB = HALF * BK * 2  , STAGE_BYTES = 8 * HTB, NXCD = 8, WGM = 8;

__host__ __device__ __forceinline__ int lds_byte(int r, int c) { const int st = (r >> 4) * 2 + (c >> 5), rr = r & 15, cc = c & 31, ob = rr * 64 + cc * 2; return st * 1024 + (ob ^ (((ob >> 9) & 1) << 5)); }
__host__ __device__ __forceinline__ void stage_rc(int b, int& R, int& C) { const int st = b / 1024, sb = b % 1024, swz = sb ^ (((sb >> 9) & 1) << 5); R = (st >> 1) * 16 + swz / 64; C = (st & 1) * 32 + (swz % 64) / 2; }
__host__ __device__ __forceinline__ int perm32(int rho) { const int n = rho >> 4, i = rho & 15; return 8 * (i >> 2) + 4 * n + (i & 3); }

typedef int i32x8 __attribute__((ext_vector_type(8)));
typedef int i32x4 __attribute__((ext_vector_type(4)));
__device__ __forceinline__ i32x8 cat8(bf16x8 lo, bf16x8 hi) { const i32x4 a = __builtin_bit_cast(i32x4, lo), b = __builtin_bit_cast(i32x4, hi); return __builtin_shufflevector(a, b, 0, 1, 2, 3, 4, 5, 6, 7); }
__device__ __forceinline__ void glds16s(const void* sbase, unsigned voff, unsigned lds_dst) { unsigned keep;
    asm volatile("s_mov_b32 %0, m0\n\ts_mov_b32 m0, %3\n\ts_nop 0\n\tglobal_load_lds_dwordx4 %1, %2\n\ts_mov_b32 m0, %0" : "=&s"(keep) : "v"(voff), "s"(sbase), "s"(lds_dst) : "memory"); }
__device__ __forceinline__ void mfma_f8(f32x4& acc, const i32x8 a, const i32x8 b, const int sa, const int sb) {
    asm volatile("v_mfma_scale_f32_16x16x128_f8f6f4 %0, %1, %2, %0, %3, %4 op_sel_hi:[0,0,0]" : "+v"(acc) : "v"(a), "v"(b), "v"(sa), "v"(sb)); }
__device__ __forceinline__ void mfma_f8_z(f32x4& acc, const i32x8 a, const i32x8 b, const int sa, const int sb) {
    asm volatile("v_mfma_scale_f32_16x16x128_f8f6f4 %0, %1, %2, 0, %3, %4 op_sel_hi:[0,0,0]" : "=&v"(acc) : "v"(a), "v"(b), "v"(sa), "v"(sb)); }
__device__ __forceinline__ void mfma_bf16(f32x4& acc, const bf16x8 a, const bf16x8 b) { asm volatile("v_mfma_f32_16x16x32_bf16 %0, %1, %2, %0" : "+v"(acc) : "v"(a), "v"(b)); }
__device__ __forceinline__ void mfma_bf16_z(f32x4& acc, const bf16x8 a, const bf16x8 b) { asm volatile("v_mfma_f32_16x16x32_bf16 %0, %1, %2, 0" : "=&v"(acc) : "v"(a), "v"(b)); }
struct Unit { int pm, pn, bn, skip, kofs; };
struct Gemm { const bf16_t* A; const bf16_t* Bt; int M, N, K, ld; };

struct StaticOrder {
    int nM, nN, nwg, G, c;
    __host__ __device__ void init(int M, int N, int G_, int c_) { nM = M / BM; nN = N / BM; nwg = nM * nN; G = G_; c = c_; }
    __host__ __device__ bool next(int i, Unit& u) const {
        const long L = (long)i * G + c; if (L >= nwg) return false;
        map((int)L, u); return true;
    }
    __host__ __device__ void map(int L, Unit& u) const {
        int wgid = L; { const int q = nwg / NXCD, r = nwg % NXCD, xcd = wgid % NXCD, off = wgid / NXCD; wgid = (xcd < r ? xcd * (q + 1) : r * (q + 1) + (xcd - r) * q) + off; }
        const int nig = WGM * nN, gid = wgid / nig, fm = gid * WGM, gsz = (nM - fm) < WGM ? (nM - fm) : WGM;
        u.pm = fm + ((wgid % nig) % gsz); u.pn = (wgid % nig) / gsz; u.bn = u.pn; u.skip = 0; u.kofs = 0;
    }
    __device__ __forceinline__ void a_ready(const Unit&) const {}
    __device__ __forceinline__ void done(const Unit&) const {}
};

__device__ __forceinline__ unsigned cvt_pk_bf16(float lo, float hi) { unsigned r; asm volatile("v_cvt_pk_bf16_f32 %0, %1, %2" : "=v"(r) : "v"(lo), "v"(hi)); return r; }
typedef float f32x2 __attribute__((ext_vector_type(2)));
__device__ __forceinline__ f32x2 gelu_pk(f32x2 v) {
    const f32x2 av = __builtin_elementwise_abs(v), d = av * 0.2316418882f + 1.0f;
    f32x2 t; t.x = __builtin_amdgcn_rcpf(d.x); t.y = __builtin_amdgcn_rcpf(d.y);
    f32x2 q = t * 0.5307027145f + (-0.7265760135f); q = q * t + 0.7107068705f; q = q * t + (-0.142248368f); q = q * t + 0.127414796f; q = q * t;
    const f32x2 s = (v * v) * (-0.72134752044f);
    f32x2 e; e.x = __builtin_amdgcn_exp2f(s.x); e.y = __builtin_amdgcn_exp2f(s.y);
    const f32x2 m = v * (q * e), r = v - m;
    f32x2 o; o.x = v.x < 0.f ? m.x : r.x; o.y = v.y < 0.f ? m.y : r.y; return o;
}


__device__ __forceinline__ void store_bf16x8(bf16_t* p, const f32x4 v0, const f32x4 v1) {
    u32x4 w; w.x = cvt_pk_bf16(v0[0], v0[1]); w.y = cvt_pk_bf16(v0[2], v0[3]); w.z = cvt_pk_bf16(v1[0], v1[1]); w.w = cvt_pk_bf16(v1[2], v1[3]); *(u32x4*)p = w;
}
__device__ __forceinline__ f32x4 gelu4(const f32x4 v) { const f32x2 a = gelu_pk((f32x2){v[0], v[1]}), b = gelu_pk((f32x2){v[2], v[3]}); return (f32x4){a.x, a.y, b.x, b.y}; }
__device__ __forceinline__ float silu_mul(float g, float u) { return g * u * __builtin_amdgcn_rcpf(1.0f + __builtin_amdgcn_exp2f(-1.4426950408889634f * g)); }
typedef float f32x2 __attribute__((ext_vector_type(2)));
__device__ __forceinline__ f32x4 swiglu4(const f32x4 g, const f32x4 u) {
    const f32x2 ga = {g[0], g[1]}, gb = {g[2], g[3]}, ua = {u[0], u[1]}, ub = {u[2], u[3]};
    const f32x2 ea = {__builtin_amdgcn_exp2f(-ga.x), __builtin_amdgcn_exp2f(-ga.y)}, eb = {__builtin_amdgcn_exp2f(-gb.x), __builtin_amdgcn_exp2f(-gb.y)};
    const f32x2 da = ea + 1.0f, db = eb + 1.0f;
    const f32x2 ra = {__builtin_amdgcn_rcpf(da.x), __builtin_amdgcn_rcpf(da.y)}, rb = {__builtin_amdgcn_rcpf(db.x), __builtin_amdgcn_rcpf(db.y)};
    const f32x2 oa = (ga * ua) * ra, ob = (gb * ub) * rb;
    return (f32x4){oa.x, oa.y, ob.x, ob.y};
}

struct EpiProj {
    static constexpr bool PERM = true, AFTER_DRAIN = false, IDEMP = true; static constexpr int BMODE = 0; static constexpr bool FP8 = false;
    bf16_t* O;
    __device__ __forceinline__ void operator()(const f32x4 (&acc)[2][2][4][2], const Unit& u, int wr, int wc, int fr, int fq) const {
        if (u.skip) return;
        const int row0 = u.pm * BM + wr * 64 + fr, col0 = u.pn * BM + wc * 32 + 8 * fq; const bool act = u.pn >= 6;
#pragma unroll
        for (int ai = 0; ai < 2; ++ai)
#pragma unroll
            for (int m = 0; m < 4; ++m) { bf16_t* rowp = O + (size_t)(row0 + ai * HALF + m * 16) * 2560 + col0;
#pragma unroll
                for (int bj = 0; bj < 2; ++bj) { f32x4 v0 = acc[ai][bj][m][0], v1 = acc[ai][bj][m][1];
                    if (act) { v0 = gelu4(v0); v1 = gelu4(v1); }
                    store_bf16x8(rowp + bj * HALF, v0, v1);
#ifdef DUPSTORE
                    store_bf16x8(rowp + bj * HALF + (size_t)160 * 1024 * 1024, v0, v1);
#endif
                    } }
    }
};
struct EpiProjQK {
    static constexpr bool PERM = true, AFTER_DRAIN = false, IDEMP = true; static constexpr int BMODE = 1; static constexpr bool FP8 = false;
    bf16_t* O; const float* qg; const float* kg; float qscale; float eps;
    __device__ __forceinline__ void operator()(const f32x4 (&acc)[2][2][4][2], const Unit& u, int wr, int wc, int fr, int fq) const {
        const int row0 = u.pm * BM + wr * 64 + fr, col0 = u.pn * BM + wc * 64 + 8 * fq; const int kind = u.pn >> 1;
        if (kind < 2) {
            const float* gp = (kind == 0 ? qg : kg) + 8 * fq; const float gs = (kind == 0) ? qscale : 1.0f;
            f32x4 gv[2][2];
#pragma unroll
            for (int bj = 0; bj < 2; ++bj)
#pragma unroll
                for (int n = 0; n < 2; ++n) gv[bj][n] = *(const f32x4*)(gp + 32 * bj + 4 * n) * gs;
#pragma unroll
            for (int ai = 0; ai < 2; ++ai)
#pragma unroll
                for (int m = 0; m < 4; ++m) { float ss = 0.f;
#pragma unroll
                    for (int bj = 0; bj < 2; ++bj)
#pragma unroll
                        for (int n = 0; n < 2; ++n) { const f32x4 v = acc[ai][bj][m][n]; ss += (v[0] * v[0] + v[1] * v[1]) + (v[2] * v[2] + v[3] * v[3]); }
                    ss += __shfl_xor(ss, 16); ss += __shfl_xor(ss, 32);
                    const float rs = __builtin_amdgcn_rsqf(ss * (1.0f / 64.0f) + eps);
                    bf16_t* rowp = O + (size_t)(row0 + ai * HALF + m * 16) * 2560 + col0;
#pragma unroll
                    for (int bj = 0; bj < 2; ++bj) store_bf16x8(rowp + 32 * bj, acc[ai][bj][m][0] * rs * gv[bj][0], acc[ai][bj][m][1] * rs * gv[bj][1]); }
        } else {
#ifdef GELU_IN_PROJ
            const bool act = kind >= 3;
#else
            constexpr bool act = false;
#endif
#pragma unroll
            for (int ai = 0; ai < 2; ++ai)
#pragma unroll
                for (int m = 0; m < 4; ++m) { bf16_t* rowp = O + (size_t)(row0 + ai * HALF + m * 16) * 2560 + col0;
#pragma unroll
                    for (int bj = 0; bj < 2; ++bj) { f32x4 v0 = acc[ai][bj][m][0], v1 = acc[ai][bj][m][1];
                        if (act) { v0 = gelu4(v0); v1 = gelu4(v1); }
                        store_bf16x8(rowp + 32 * bj, v0, v1); } }
        }
    }
};
struct EpiResid {
    static constexpr bool PERM = false, AFTER_DRAIN = false, IDEMP = false; static constexpr int BMODE = 0; static constexpr bool FP8 = false;
    const float* xin; float* xout; const float* gate;
    __device__ __forceinline__ void operator()(const f32x4 (&acc)[2][2][4][2], const Unit& u, int wr, int wc, int fr, int fq) const {
        const int row0 = u.pm * BM + wr * 64 + fr, col0 = u.pn * BM + wc * 32 + 4 * fq;
        const float* gp = gate + (size_t)(u.pm >> 3) * 6144 + col0;
        f32x4 gv[2][2];
#pragma unroll
        for (int bj = 0; bj < 2; ++bj)
#pragma unroll
            for (int n = 0; n < 2; ++n) gv[bj][n] = *(const f32x4*)(gp + bj * HALF + n * 16);
#pragma unroll
        for (int ai = 0; ai < 2; ++ai) {
            f32x4 xi[4][2][2];
#pragma unroll
            for (int m = 0; m < 4; ++m) { const size_t off = (size_t)(row0 + ai * HALF + m * 16) * 1024 + col0;
#pragma unroll
                for (int bj = 0; bj < 2; ++bj)
#pragma unroll
                    for (int n = 0; n < 2; ++n) xi[m][bj][n] = *(const f32x4*)(xin + off + bj * HALF + n * 16); }
            asm volatile("" ::: "memory");
#pragma unroll
            for (int m = 0; m < 4; ++m) { const size_t off = (size_t)(row0 + ai * HALF + m * 16) * 1024 + col0;
#pragma unroll
                for (int bj = 0; bj < 2; ++bj)
#pragma unroll
                    for (int n = 0; n < 2; ++n) *(f32x4*)(xout + off + bj * HALF + n * 16) = xi[m][bj][n] + gv[bj][n] * acc[ai][bj][m][n]; }
            asm volatile("" ::: "memory");
        }
    }
};
struct EpiSwiglu {
    static constexpr bool PERM = true, AFTER_DRAIN = false, IDEMP = true; static constexpr int BMODE = 0; static constexpr bool FP8 = false;
    bf16_t* O; int ldc;
    __device__ __forceinline__ void operator()(const f32x4 (&acc)[2][2][4][2], const Unit& u, int wr, int wc, int fr, int fq) const {
        const int row0 = u.pm * BM + wr * 64 + fr, col0 = u.pn * HALF + wc * 32 + 8 * fq;
#pragma unroll
        for (int ai = 0; ai < 2; ++ai)
#pragma unroll
            for (int m = 0; m < 4; ++m) { bf16_t* rowp = O + (size_t)(row0 + ai * HALF + m * 16) * ldc + col0;
                const f32x4 g0 = acc[ai][0][m][0], g1 = acc[ai][0][m][1], u0 = acc[ai][1][m][0], u1 = acc[ai][1][m][1];
                const f32x4 r0 = swiglu4(g0, u0), r1 = swiglu4(g1, u1);
                store_bf16x8(rowp, r0, r1); }
    }
};
__device__ __forceinline__ unsigned pk4_fp8(const f32x4 v) {
    int p = 0;
    p = __builtin_amdgcn_cvt_pk_fp8_f32(__builtin_amdgcn_fmed3f(v[0], -448.f, 448.f), __builtin_amdgcn_fmed3f(v[1], -448.f, 448.f), p, false);
    p = __builtin_amdgcn_cvt_pk_fp8_f32(__builtin_amdgcn_fmed3f(v[2], -448.f, 448.f), __builtin_amdgcn_fmed3f(v[3], -448.f, 448.f), p, true);
    return (unsigned)p;
}
struct EpiSwigluF8 {
    static constexpr bool PERM = true, AFTER_DRAIN = false, IDEMP = true; static constexpr int BMODE = 0; static constexpr bool FP8 = true;
    unsigned char* O; int ldc;
    __device__ __forceinline__ void operator()(const f32x4 (&acc)[2][2][4][2], const Unit& u, int wr, int wc, int fr, int fq) const {
        const int row0 = u.pm * BM + wr * 64 + fr, col0 = u.pn * HALF + wc * 32 + 8 * fq;
#pragma unroll
        for (int ai = 0; ai < 2; ++ai)
#pragma unroll
            for (int m = 0; m < 4; ++m) { unsigned char* rowp = O + (size_t)(row0 + ai * HALF + m * 16) * ldc + col0;
                const f32x4 g0 = acc[ai][0][m][0], g1 = acc[ai][0][m][1], u0 = acc[ai][1][m][0], u1 = acc[ai][1][m][1];
                const f32x4 r0 = swiglu4(g0, u0), r1 = swiglu4(g1, u1);
                typedef unsigned u32x2 __attribute__((ext_vector_type(2)));
                u32x2 w; w.x = pk4_fp8(r0); w.y = pk4_fp8(r1); *(u32x2*)rowp = w; }
    }
};
template <bool KF8, bool OF8>
struct EpiSwigluX {
    static constexpr bool PERM = true, AFTER_DRAIN = false, IDEMP = true; static constexpr int BMODE = 0; static constexpr bool FP8 = KF8;
    unsigned char* O; int ldc;
    __device__ __forceinline__ void operator()(const f32x4 (&acc)[2][2][4][2], const Unit& u, int wr, int wc, int fr, int fq) const {
        const int row0 = u.pm * BM + wr * 64 + fr, col0 = u.pn * HALF + wc * 32 + 8 * fq;
#pragma unroll
        for (int ai = 0; ai < 2; ++ai)
#pragma unroll
            for (int m = 0; m < 4; ++m) { unsigned char* rowp = O + ((size_t)(row0 + ai * HALF + m * 16) * ldc + col0) * (OF8 ? 1 : 2);
                const f32x4 r0 = swiglu4(acc[ai][0][m][0], acc[ai][1][m][0]), r1 = swiglu4(acc[ai][0][m][1], acc[ai][1][m][1]);
                if constexpr (OF8) { typedef unsigned u32x2 __attribute__((ext_vector_type(2))); u32x2 w; w.x = pk4_fp8(r0); w.y = pk4_fp8(r1); *(u32x2*)rowp = w; }
                else store_bf16x8((bf16_t*)rowp, r0, r1); }
    }
};
struct EpiSwigluO8 {
    static constexpr bool PERM = true, AFTER_DRAIN = false, IDEMP = true; static constexpr int BMODE = 0; static constexpr bool FP8 = false;
    unsigned char* O; int ldc;
    __device__ __forceinline__ void operator()(const f32x4 (&acc)[2][2][4][2], const Unit& u, int wr, int wc, int fr, int fq) const {
        const int row0 = u.pm * BM + wr * 64 + fr, col0 = u.pn * HALF + wc * 32 + 8 * fq;
#pragma unroll
        for (int ai = 0; ai < 2; ++ai)
#pragma unroll
            for (int m = 0; m < 4; ++m) { unsigned char* rowp = O + (size_t)(row0 + ai * HALF + m * 16) * ldc + col0;
                const f32x4 r0 = swiglu4(acc[ai][0][m][0], acc[ai][1][m][0]), r1 = swiglu4(acc[ai][0][m][1], acc[ai][1][m][1]);
                typedef unsigned u32x2 __attribute__((ext_vector_type(2)));
                u32x2 w; w.x = pk4_fp8(r0); w.y = pk4_fp8(r1); *(u32x2*)rowp = w; }
    }
};
struct EpiMoeDown {
    static constexpr bool PERM = false, AFTER_DRAIN = false, IDEMP = false; static constexpr int BMODE = 0; static constexpr bool FP8 = false;
    float* x; const float* gate; const int* slot_tok; const float* slot_gate;
    __device__ __forceinline__ void operator()(const f32x4 (&acc)[2][2][4][2], const Unit& u, int wr, int wc, int fr, int fq) const {
        const int slot0 = u.pm * BM + wr * 64 + fr, col0 = u.pn * BM + wc * 32 + 4 * fq;
        int tok[2][4]; float sg[2][4];
#pragma unroll
        for (int ai = 0; ai < 2; ++ai)
#pragma unroll
            for (int m = 0; m < 4; ++m) { const int slot = slot0 + ai * HALF + m * 16; tok[ai][m] = slot_tok[slot]; sg[ai][m] = slot_gate[slot]; }
#pragma unroll
        for (int ai = 0; ai < 2; ++ai)
#pragma unroll
            for (int mp = 0; mp < 2; ++mp) {
                f32x4 gvv[2][2][2], xi[2][2][2];
#pragma unroll
                for (int q = 0; q < 2; ++q) { const int t = tok[ai][2 * mp + q], te = t < 0 ? 0 : t;
                    const float* gp = gate + (size_t)(te >> 11) * 6144 + col0; const float* xp = x + (size_t)te * 1024 + col0;
#pragma unroll
                    for (int bj = 0; bj < 2; ++bj)
#pragma unroll
                        for (int n = 0; n < 2; ++n) { gvv[q][bj][n] = *(const f32x4*)(gp + bj * HALF + n * 16); xi[q][bj][n] = *(const f32x4*)(xp + bj * HALF + n * 16); } }
                asm volatile("" ::: "memory");
#pragma unroll
                for (int q = 0; q < 2; ++q) { const int m = 2 * mp + q; const int t = tok[ai][m];
                    if (t >= 0) { float* xp = x + (size_t)t * 1024 + col0; const float g1 = sg[ai][m];
#pragma unroll
                        for (int bj = 0; bj < 2; ++bj)
#pragma unroll
                            for (int n = 0; n < 2; ++n) *(f32x4*)(xp + bj * HALF + n * 16) = xi[q][bj][n] + (gvv[q][bj][n] * g1) * acc[ai][bj][m][n]; } }
                asm volatile("" ::: "memory");
            }
    }
};
struct EpiMoeDownF8 : EpiMoeDown { static constexpr bool FP8 = true; };
struct EpiResidF8 : EpiResid { static constexpr bool FP8 = true; };
__device__ __forceinline__ void unpack_bf16x8(const u32x4 w, f32x4& a, f32x4& b) {
    a = (f32x4){__builtin_bit_cast(float, w.x << 16), __builtin_bit_cast(float, w.x & 0xffff0000u), __builtin_bit_cast(float, w.y << 16), __builtin_bit_cast(float, w.y & 0xffff0000u)};
    b = (f32x4){__builtin_bit_cast(float, w.z << 16), __builtin_bit_cast(float, w.z & 0xffff0000u), __builtin_bit_cast(float, w.w << 16), __builtin_bit_cast(float, w.w & 0xffff0000u)}; }
template <bool IN_F32, bool F8>
struct EpiResidB {
    static constexpr bool PERM = true, AFTER_DRAIN = false, IDEMP = false; static constexpr int BMODE = 0; static constexpr bool FP8 = F8;
    const void* xin; bf16_t* xout; const float* gate;
    __device__ __forceinline__ void operator()(const f32x4 (&acc)[2][2][4][2], const Unit& u, int wr, int wc, int fr, int fq) const {
        const int row0 = u.pm * BM + wr * 64 + fr, col0 = u.pn * BM + wc * 32 + 8 * fq;
        const float* gp = gate + (size_t)(u.pm >> 3) * 6144 + col0;
        f32x4 gv[2][2];
#pragma unroll
        for (int bj = 0; bj < 2; ++bj)
#pragma unroll
            for (int n = 0; n < 2; ++n) gv[bj][n] = *(const f32x4*)(gp + bj * HALF + n * 4);
        const unsigned e0 = (unsigned)row0 * 1024u + (unsigned)col0;
        if constexpr (!IN_F32) {
            u32x4 xw[2][4][2];
#define RB_EO(ai, m, bj) (e0 + (unsigned)(((ai) * HALF + (m) * 16) * 1024 + (bj) * HALF))
#define RB_LD(ai, m, bj) xw[ai][m][bj] = *(const u32x4*)((const char*)xin + (size_t)(RB_EO(ai, m, bj) * 2u))
#define RB_ST(ai, m, bj) do { f32x4 xa_, xc_; unpack_bf16x8(xw[ai][m][bj], xa_, xc_); \
                store_bf16x8((bf16_t*)((char*)xout + (size_t)(RB_EO(ai, m, bj) * 2u)), xa_ + gv[bj][0] * acc[ai][bj][m][0], xc_ + gv[bj][1] * acc[ai][bj][m][1]); } while (0)
#pragma unroll
            for (int m = 0; m < 4; ++m) { RB_LD(0, m, 0); RB_LD(0, m, 1); }
#pragma unroll
            for (int m = 0; m < 2; ++m) { RB_LD(1, m, 0); RB_LD(1, m, 1); }
            asm volatile("" ::: "memory");
#pragma unroll
            for (int m = 0; m < 2; ++m) { RB_ST(0, m, 0); RB_ST(0, m, 1); }
            asm volatile("" ::: "memory");
#pragma unroll
            for (int m = 2; m < 4; ++m) { RB_LD(1, m, 0); RB_LD(1, m, 1); }
            asm volatile("" ::: "memory");
#pragma unroll
            for (int m = 2; m < 4; ++m) { RB_ST(0, m, 0); RB_ST(0, m, 1); }
#pragma unroll
            for (int m = 0; m < 4; ++m) { RB_ST(1, m, 0); RB_ST(1, m, 1); }
            asm volatile("" ::: "memory");
#undef RB_EO
#undef RB_LD
#undef RB_ST
            return;
        }
#pragma unroll
        for (int ai = 0; ai < 2; ++ai) {
            f32x4 xa[4][2], xb2[4][2];
#pragma unroll
            for (int m = 0; m < 4; ++m)
#pragma unroll
                for (int bj = 0; bj < 2; ++bj) { const unsigned eo = e0 + (unsigned)((ai * HALF + m * 16) * 1024 + bj * HALF);
                    if (IN_F32) { xa[m][bj] = *(const f32x4*)((const char*)xin + (size_t)(eo * 4u)); xb2[m][bj] = *(const f32x4*)((const char*)xin + (size_t)(eo * 4u) + 16); }
                    else unpack_bf16x8(*(const u32x4*)((const char*)xin + (size_t)(eo * 2u)), xa[m][bj], xb2[m][bj]); }
            asm volatile("" ::: "memory");
#pragma unroll
            for (int m = 0; m < 4; ++m)
#pragma unroll
                for (int bj = 0; bj < 2; ++bj) { const unsigned eo = e0 + (unsigned)((ai * HALF + m * 16) * 1024 + bj * HALF);
                    store_bf16x8((bf16_t*)((char*)xout + (size_t)(eo * 2u)), xa[m][bj] + gv[bj][0] * acc[ai][bj][m][0], xb2[m][bj] + gv[bj][1] * acc[ai][bj][m][1]); }
            asm volatile("" ::: "memory");
        }
    }
};
template <bool OUT_F32>
struct EpiMoeDownB {
    static constexpr bool PERM = true, AFTER_DRAIN = false, IDEMP = false; static constexpr int BMODE = 0; static constexpr bool FP8 = true;
    const bf16_t* xb; bf16_t* xbo; float* xf; const bf16_t* gate16; const int* slot_tok; const float* slot_gate;
    __device__ __forceinline__ void operator()(const f32x4 (&acc)[2][2][4][2], const Unit& u, int wr, int wc, int fr, int fq) const {
        const int slot0 = u.pm * BM + wr * 64 + fr, col0 = u.pn * BM + wc * 32 + 8 * fq;
        int tok[2][4]; float sg[2][4];
#pragma unroll
        for (int ai = 0; ai < 2; ++ai)
#pragma unroll
            for (int m = 0; m < 4; ++m) { const int slot = slot0 + ai * HALF + m * 16; tok[ai][m] = slot_tok[slot]; sg[ai][m] = slot_gate[slot]; }
#pragma unroll
        for (int ai = 0; ai < 2; ++ai) {
            u32x4 gw[4][2], xw[4][2];
#pragma unroll
            for (int q = 0; q < 4; ++q) { const int t = tok[ai][q], te = t < 0 ? 0 : t;
                const bf16_t* gp = gate16 + (size_t)(te >> 11) * 1024 + col0; const bf16_t* xp = xb + (size_t)te * 1024 + col0;
#pragma unroll
                for (int bj = 0; bj < 2; ++bj) { gw[q][bj] = *(const u32x4*)(gp + bj * HALF); xw[q][bj] = *(const u32x4*)(xp + bj * HALF); } }
            asm volatile("" ::: "memory");
#pragma unroll
            for (int q = 0; q < 4; ++q) { const int t = tok[ai][q];
                if (t >= 0) { const float g1 = sg[ai][q];
#pragma unroll
                    for (int bj = 0; bj < 2; ++bj) { f32x4 ga, gc, xa, xc; unpack_bf16x8(gw[q][bj], ga, gc); unpack_bf16x8(xw[q][bj], xa, xc);
                        const f32x4 r0 = xa + (ga * g1) * acc[ai][bj][q][0], r1 = xc + (gc * g1) * acc[ai][bj][q][1];
                        if (OUT_F32) { float* op = xf + (size_t)t * 1024 + col0 + bj * HALF; *(f32x4*)op = r0; *(f32x4*)(op + 4) = r1; }
                        else store_bf16x8(xbo + (size_t)t * 1024 + col0 + bj * HALF, r0, r1); } } }
            asm volatile("" ::: "memory");
        }
    }
};
struct DupOrder : StaticOrder {
    __device__ __forceinline__ bool next(int i, Unit& u) const { if (!StaticOrder::next(i >> 1, u)) return false; u.skip = i & 1; return true; }
};
struct PanelOrder {
    int nM, nN, G, c;
    __device__ __forceinline__ void init(int M, int N, int G_, int c_) { nM = M / BM; nN = N / BM; G = G_; c = c_; }
    __device__ __forceinline__ bool next(int i, Unit& u) const { const int pi = i / nN; u.pm = c + pi * G; if (u.pm >= nM) return false; u.pn = i - pi * nN; u.bn = u.pn; u.skip = 0; u.kofs = 0; return true; }
    __device__ __forceinline__ void a_ready(const Unit&) const {}
    __device__ __forceinline__ void done(const Unit&) const {}
};
struct MoeOrder : StaticOrder {
    const PG8_LAS unsigned char* tile_e; int ne_tiles; int limit;
    __device__ __forceinline__ bool next(int i, Unit& u) const { const long L = (long)i * G + c; if (L >= limit) return false; map((int)L, u); u.bn = (int)tile_e[u.pm] * ne_tiles + u.pn; return true; }
};
struct MoeOrder2 : StaticOrder {
    const PG8_LAS unsigned char* tile_e0; const PG8_LAS unsigned char* tile_e1; int ne_tiles, nt0, base1;
    __device__ __forceinline__ bool next(int i, Unit& u) const { const long L = (long)i * G + c; if (L >= nwg) return false; map((int)L, u);
        int e; if (u.pm < nt0) e = tile_e0[u.pm]; else { const int pl = u.pm - nt0; e = tile_e1[pl]; u.pm = base1 + pl; }
        u.bn = e * ne_tiles + u.pn; return true; }
};
struct MoeOrder2L : MoeOrder2 { int limit;
    __device__ __forceinline__ bool next(int i, Unit& u) const { const long L = (long)i * G + c; if (L >= limit) return false; map((int)L, u);
        int e; if (u.pm < nt0) e = tile_e0[u.pm]; else { const int pl = u.pm - nt0; e = tile_e1[pl]; u.pm = base1 + pl; }
        u.bn = e * ne_tiles + u.pn; return true; } };
struct MoeTail2 : MoeOrder2 { int base, ntail, nsl, ksl_bytes;
    __device__ __forceinline__ bool next(int i, Unit& u) const { const int j = i * G + c; if (j >= ntail * nsl) return false; const int q = j / nsl; map(base + q, u);
        int e; if (u.pm < nt0) e = tile_e0[u.pm]; else { const int pl = u.pm - nt0; e = tile_e1[pl]; u.pm = base1 + pl; }
        u.bn = e * ne_tiles + u.pn; u.kofs = (j - q * nsl) * ksl_bytes; u.skip = j; return true; } };
struct EpiTileF32F8 {
    static constexpr bool PERM = false, AFTER_DRAIN = false, IDEMP = true; static constexpr int BMODE = 0; static constexpr bool FP8 = true;
    float* S;
    __device__ __forceinline__ void operator()(const f32x4 (&acc)[2][2][4][2], const Unit& u, int wr, int wc, int fr, int fq) const {
        float* base = S + (size_t)u.skip * 65536 + (size_t)(wr * 64 + fr) * 256 + wc * 32 + 4 * fq;
#pragma unroll
        for (int ai = 0; ai < 2; ++ai)
#pragma unroll
            for (int m = 0; m < 4; ++m)
#pragma unroll
                for (int bj = 0; bj < 2; ++bj)
#pragma unroll
                    for (int n = 0; n < 2; ++n) *(f32x4*)(base + (size_t)(ai * HALF + m * 16) * 256 + bj * HALF + n * 16) = acc[ai][bj][m][n];
    }
};
struct MoeTailOrder : StaticOrder {
    const PG8_LAS unsigned char* tile_e; int ne_tiles; int base, ntail, nsl, ksl_bytes;
    __device__ __forceinline__ bool next(int i, Unit& u) const { const int j = i * G + c; if (j >= ntail * nsl) return false; const int q = j / nsl; map(base + q, u);
        u.bn = (int)tile_e[u.pm] * ne_tiles + u.pn; u.kofs = (j - q * nsl) * ksl_bytes; return true; }
};
struct EpiMoeDownAtomic {
    static constexpr bool PERM = false, AFTER_DRAIN = false, IDEMP = false; static constexpr int BMODE = 0; static constexpr bool FP8 = false;
    float* x; const float* gate; const int* slot_tok; const float* slot_gate;
    __device__ __forceinline__ void operator()(const f32x4 (&acc)[2][2][4][2], const Unit& u, int wr, int wc, int fr, int fq) const {
        const int slot0 = u.pm * BM + wr * 64 + fr, col0 = u.pn * BM + wc * 32 + 4 * fq;
#pragma unroll
        for (int ai = 0; ai < 2; ++ai)
#pragma unroll
            for (int m = 0; m < 4; ++m) { const int slot = slot0 + ai * HALF + m * 16; const int tok = slot_tok[slot];
                if (tok >= 0) { const float sg = slot_gate[slot]; const float* gp = gate + (size_t)(tok >> 11) * 6144 + col0; float* xp = x + (size_t)tok * 1024 + col0;
#pragma unroll
                    for (int bj = 0; bj < 2; ++bj)
#pragma unroll
                        for (int n = 0; n < 2; ++n) { const f32x4 v = (*(const f32x4*)(gp + bj * HALF + n * 16) * sg) * acc[ai][bj][m][n];
#pragma unroll
                            for (int e = 0; e < 4; ++e) unsafeAtomicAdd(xp + bj * HALF + n * 16 + e, v[e]); } } }
    }
};

#ifndef EPI_TWICE
#define EPI_TWICE false
#endif
template <class Epi, class Sched, bool ALIGN_EPI = false, bool SP2 = false>
__device__ __forceinline__ void gemm_phase(PG8_LAS unsigned char* lds, const Gemm g, const Sched& S, const Epi& E) {
    int tid_o = threadIdx.x; asm volatile("" : "+v"(tid_o));
    const int tid = tid_o, wid = __builtin_amdgcn_readfirstlane(tid >> 6), lane = tid & 63, wr = wid >> 2, wc = wid & 3, fr = lane & 15, fq = lane >> 4;
    const int nt = g.K / BK, K = g.ld ? g.ld : g.K;
    unsigned voffA[2], voffB[2];
#pragma unroll
    for (int i = 0; i < 2; ++i) { int R, C; stage_rc(tid * 16 + i * 8192, R, C); const int Rb = (Epi::BMODE == 1) ? (64 * (R >> 5) + perm32(R & 31)) : (Epi::PERM ? ((R & ~31) + perm32(R & 31)) : R);
        voffA[i] = (unsigned)(R * K + C) * 2u; voffB[i] = (unsigned)(Rb * K + C) * 2u; }
    const size_t kstep = (size_t)(BK * 2);
    const size_t hstep = (size_t)HALF * K * 2;
    const size_t hstepB = (Epi::BMODE == 1) ? (size_t)32 * K * 2 : hstep;
    const size_t tstep = 2 * hstep;
    const unsigned lds0 = (unsigned)(uintptr_t)lds;
    const unsigned ldsw = (unsigned)wid * 1024u;
    const int aoff = lds_byte(wr * 64 + fr, fq * 8), boff = lds_byte(wc * 32 + fr, fq * 8);
#define PG8_SA(b, h) (((b) * 2 + (h)) * HTB)
#define PG8_SB(b, h) ((4 + (b) * 2 + (h)) * HTB)
#ifndef PG8_ASM_STAGE
#define PG8_ASM_STAGE 1
#endif
#if PG8_ASM_STAGE
#define PG8_STAGE(bufoff, gbase, voff) do { _Pragma("unroll") for (int _i = 0; _i < 2; ++_i) glds16s((const void*)(gbase), (voff)[_i], (unsigned)__builtin_amdgcn_readfirstlane((int)(lds0 + (unsigned)(bufoff) + ldsw + (unsigned)_i * 8192u))); } while (0)
#else
#define PG8_STAGE(bufoff, gbase, voff) do { _Pragma("unroll") for (int _i = 0; _i < 2; ++_i) \
        __builtin_amdgcn_global_load_lds((const unsigned*)((const char*)(gbase) + (voff)[_i]), (PG8_LAS unsigned*)(lds + (bufoff) + ldsw + _i * 8192), 16, 0, 0); } while (0)
#endif
#define PG8_LDA(dst, b, h) do { _Pragma("unroll") for (int m = 0; m < 4; ++m) _Pragma("unroll") for (int k = 0; k < 2; ++k) dst[m][k] = *(const PG8_LAS bf16x8*)(lds + PG8_SA(b, h) + aoff + m * 2048 + k * 1024); } while (0)
#define PG8_LDB(dst, b, h) do { _Pragma("unroll") for (int n = 0; n < 2; ++n) _Pragma("unroll") for (int k = 0; k < 2; ++k) dst[n][k] = *(const PG8_LAS bf16x8*)(lds + PG8_SB(b, h) + boff + n * 2048 + k * 1024); } while (0)
#define PG8_MMA(ai, bj, At, Bt) do { __builtin_amdgcn_s_setprio(1); _Pragma("unroll") for (int m = 0; m < 4; ++m) _Pragma("unroll") for (int n = 0; n < 2; ++n) { \
        if constexpr (Epi::FP8) mfma_f8(acc[ai][bj][m][n], cat8(Bt[n][0], Bt[n][1]), cat8(At[m][0], At[m][1]), 0x7a7a7a7a, 0x7f7f7f7f); \
        else { _Pragma("unroll") for (int k = 0; k < 2; ++k) acc[ai][bj][m][n] = __builtin_amdgcn_mfma_f32_16x16x32_bf16(Bt[n][k], At[m][k], acc[ai][bj][m][n], 0, 0, 0); } } \
        __builtin_amdgcn_s_setprio(0); } while (0)
#define PG8_MMA0(ai, bj, At, Bt) do { __builtin_amdgcn_s_setprio(1); _Pragma("unroll") for (int m = 0; m < 4; ++m) _Pragma("unroll") for (int n = 0; n < 2; ++n) \
        mfma_f8_z(acc[ai][bj][m][n], cat8(Bt[n][0], Bt[n][1]), cat8(At[m][0], At[m][1]), 0x7a7a7a7a, 0x7f7f7f7f); \
        __builtin_amdgcn_s_setprio(0); } while (0)
#define PG8_WAIT_V(n) asm volatile("s_waitcnt vmcnt(" #n ")" ::: "memory")
#define PG8_WAIT_L(n) asm volatile("s_waitcnt lgkmcnt(" #n ")" ::: "memory")
#define PG8_BAR __builtin_amdgcn_s_barrier()
#define PG8_SCHED __builtin_amdgcn_sched_barrier(0)
    Unit cur, nxt; int ui = 0;
    if (!S.next(0, cur)) return;
    f32x4 acc[2][2][4][2];
    if constexpr (!(SP2 && Epi::FP8))
#pragma unroll
    for (int a = 0; a < 2; ++a)
#pragma unroll
        for (int b = 0; b < 2; ++b)
#pragma unroll
            for (int m = 0; m < 4; ++m)
#pragma unroll
                for (int n = 0; n < 2; ++n) acc[a][b][m][n] = (f32x4){0.f, 0.f, 0.f, 0.f};
    bf16x8 At[4][2], B0[2][2], B1[2][2];
    const char* cA = (const char*)g.A + (size_t)cur.pm * tstep + cur.kofs; const char* cB = (const char*)g.Bt + (size_t)cur.bn * tstep + cur.kofs;
    S.a_ready(cur);
    if constexpr (SP2) {
        PG8_STAGE(PG8_SB(0, 0), cB, voffB); PG8_STAGE(PG8_SB(0, 1), cB + hstepB, voffB); PG8_STAGE(PG8_SA(0, 0), cA, voffA); PG8_STAGE(PG8_SA(0, 1), cA + hstep, voffA);
        if (wr == 1) PG8_BAR;
        PG8_WAIT_V(2); PG8_BAR;
        PG8_STAGE(PG8_SB(1, 0), cB + kstep, voffB); PG8_STAGE(PG8_SA(1, 0), cA + kstep, voffA); PG8_STAGE(PG8_SB(1, 1), cB + hstepB + kstep, voffB);
        PG8_WAIT_V(6); PG8_BAR;
    } else {
        PG8_STAGE(PG8_SB(0, 0), cB, voffB); PG8_STAGE(PG8_SA(0, 0), cA, voffA); PG8_STAGE(PG8_SB(0, 1), cB + hstepB, voffB); PG8_STAGE(PG8_SA(0, 1), cA + hstep, voffA);
        if (wr == 1) PG8_BAR;
        PG8_WAIT_V(4); PG8_BAR;
        PG8_STAGE(PG8_SB(1, 0), cB + kstep, voffB); PG8_STAGE(PG8_SA(1, 0), cA + kstep, voffA); PG8_STAGE(PG8_SB(1, 1), cB + hstepB + kstep, voffB);
        PG8_WAIT_V(6); PG8_BAR;
    }
    for (;;) {
        const bool has_next = S.next(ui + 1, nxt);
        const char* nA = has_next ? (const char*)g.A + (size_t)nxt.pm * tstep + nxt.kofs : cA; const char* nB = has_next ? (const char*)g.Bt + (size_t)nxt.bn * tstep + nxt.kofs : cB;
#pragma unroll 1
        for (int t = 0; t < nt; t += 2) {
            const bool last = (t == nt - 2);
            const char* a1 = cA + (size_t)(t + 1) * kstep;
            const char* a2 = last ? nA : cA + (size_t)(t + 2) * kstep; const char* b2 = last ? nB : cB + (size_t)(t + 2) * kstep;
            const char* a3 = a2 + kstep; const char* b3 = b2 + kstep;
            if (last && has_next) S.a_ready(nxt);
            if constexpr (SP2) {
            PG8_LDB(B0, 0, 0); PG8_LDB(B1, 0, 1); PG8_SCHED; PG8_LDA(At, 0, 0); PG8_STAGE(PG8_SA(1, 1), a1 + hstep, voffA);
            PG8_WAIT_V(8); PG8_WAIT_L(0); PG8_BAR; if (Epi::FP8 && t == 0) { PG8_MMA0(0, 0, At, B0); PG8_MMA0(0, 1, At, B1); } else { PG8_MMA(0, 0, At, B0); PG8_MMA(0, 1, At, B1); } PG8_BAR; PG8_SCHED;
            PG8_LDA(At, 0, 1); PG8_STAGE(PG8_SB(0, 0), b2, voffB); PG8_STAGE(PG8_SB(0, 1), b2 + hstepB, voffB); PG8_STAGE(PG8_SA(0, 0), a2, voffA);
            PG8_WAIT_V(8); PG8_WAIT_L(0); PG8_BAR; if (Epi::FP8 && t == 0) { PG8_MMA0(1, 0, At, B0); PG8_MMA0(1, 1, At, B1); } else { PG8_MMA(1, 0, At, B0); PG8_MMA(1, 1, At, B1); } PG8_BAR; PG8_SCHED;
            PG8_LDB(B0, 1, 0); PG8_LDB(B1, 1, 1); PG8_SCHED; PG8_LDA(At, 1, 0); PG8_STAGE(PG8_SA(0, 1), a2 + hstep, voffA);
            PG8_WAIT_V(8); PG8_WAIT_L(0); PG8_BAR; PG8_MMA(0, 0, At, B0); PG8_MMA(0, 1, At, B1); PG8_BAR; PG8_SCHED;
            PG8_LDA(At, 1, 1); PG8_STAGE(PG8_SB(1, 0), b3, voffB); PG8_STAGE(PG8_SB(1, 1), b3 + hstepB, voffB); PG8_STAGE(PG8_SA(1, 0), a3, voffA);
            PG8_WAIT_V(8); PG8_WAIT_L(0); PG8_BAR; PG8_MMA(1, 0, At, B0); PG8_MMA(1, 1, At, B1); PG8_BAR; PG8_SCHED;
            } else {
            PG8_LDB(B0, 0, 0); PG8_SCHED; PG8_LDA(At, 0, 0); PG8_STAGE(PG8_SA(1, 1), a1 + hstep, voffA);
            PG8_WAIT_L(8); PG8_BAR; PG8_WAIT_L(0); PG8_MMA(0, 0, At, B0); PG8_BAR; PG8_SCHED;
            PG8_LDB(B1, 0, 1); PG8_STAGE(PG8_SB(0, 0), b2, voffB);
            PG8_BAR; PG8_WAIT_L(0); PG8_MMA(0, 1, At, B1); PG8_BAR;
            PG8_LDA(At, 0, 1); PG8_STAGE(PG8_SA(0, 0), a2, voffA);
            PG8_BAR; PG8_WAIT_L(0); PG8_MMA(1, 0, At, B0); PG8_BAR; PG8_SCHED;
            PG8_STAGE(PG8_SB(0, 1), b2 + hstepB, voffB);
            PG8_WAIT_V(6); PG8_BAR; PG8_MMA(1, 1, At, B1); PG8_BAR;
            PG8_LDB(B0, 1, 0); PG8_SCHED; PG8_LDA(At, 1, 0); PG8_STAGE(PG8_SA(0, 1), a2 + hstep, voffA);
            PG8_WAIT_L(8); PG8_BAR; PG8_WAIT_L(0); PG8_MMA(0, 0, At, B0); PG8_BAR; PG8_SCHED;
            PG8_LDB(B1, 1, 1); PG8_STAGE(PG8_SB(1, 0), b3, voffB);
            PG8_BAR; PG8_WAIT_L(0); PG8_MMA(0, 1, At, B1); PG8_BAR;
            PG8_LDA(At, 1, 1); PG8_STAGE(PG8_SA(1, 0), a3, voffA);
            PG8_BAR; PG8_WAIT_L(0); PG8_MMA(1, 0, At, B0); PG8_BAR; PG8_SCHED;
            PG8_STAGE(PG8_SB(1, 1), b3 + hstepB, voffB);
            PG8_WAIT_V(6); PG8_BAR; PG8_MMA(1, 1, At, B1); PG8_BAR;
            }
        }
        if constexpr (ALIGN_EPI) { if (wr == 0) PG8_BAR; }
        if constexpr (Epi::FP8) asm volatile("s_nop 15\n\ts_nop 15" ::: "memory");
        if constexpr (!Epi::AFTER_DRAIN) { E(acc, cur, wr, wc, fr, fq); if constexpr (EPI_TWICE && Epi::IDEMP) { asm volatile("" ::: "memory"); E(acc, cur, wr, wc, fr, fq); } S.done(cur); }
        if (!has_next) break;
        if constexpr (!(SP2 && Epi::FP8))
#pragma unroll
        for (int a = 0; a < 2; ++a)
#pragma unroll
            for (int b = 0; b < 2; ++b)
#pragma unroll
                for (int m = 0; m < 4; ++m)
#pragma unroll
                    for (int n = 0; n < 2; ++n) acc[a][b][m][n] = (f32x4){0.f, 0.f, 0.f, 0.f};
        cur = nxt; cA = nA; cB = nB; ++ui;
        if constexpr (ALIGN_EPI) { if (wr == 1) PG8_BAR; }
    }
    PG8_WAIT_V(0);
    if constexpr (!ALIGN_EPI) { if (wr == 0) PG8_BAR; }
    PG8_BAR;
    if constexpr (Epi::AFTER_DRAIN) { E.fused(acc, cur, wr, wc, fr, fq, lds, wid, lane); S.done(cur); }
#undef PG8_SA
#undef PG8_SB
#undef PG8_STAGE
#undef PG8_LDA
#undef PG8_LDB
#undef PG8_MMA
#undef PG8_MMA0
#undef PG8_WAIT_V
#undef PG8_WAIT_L
#undef PG8_BAR
#undef PG8_SCHED
}
}

constexpr int NWAVES = 8;
constexpr int BATCH = 32, SEQ = 2048, T = BATCH * SEQ, D = 1024, NPROJ = 2560, FF = 2816, NE = 8, DE = 3584, ADA = 6 * D;
constexpr float EPS = 1e-6f;
constexpr float C2 = 0.125f * 1.4426950408889634f;
constexpr int MAXTILES = 264;
constexpr size_t MiB = 1u << 20;
constexpr size_t WS_CTL = 0, CTL_ZERO_BYTES = 1 * MiB;
constexpr size_t WS_ADA = 1 * MiB;
constexpr size_t WS_G16 = 2560 * 1024;
constexpr size_t WS_PCNT = 3 * MiB;
constexpr size_t WS_TOKE = 4 * MiB, WS_TOKR = 5 * MiB, WS_TOKG = 6 * MiB;
constexpr size_t WS_SLOTT = 7 * MiB, WS_SLOTG = 3 * MiB + 256 * 1024;
constexpr size_t WS_WIN = 8 * MiB;
constexpr size_t WS_WOUT = 18 * MiB;
constexpr size_t WS_WGU = 22 * MiB;
constexpr size_t WS_WD = 33 * MiB;
constexpr size_t WS_GW = 39 * MiB;
constexpr size_t WS_MWGU = 40 * MiB;
constexpr size_t WS_MWD = 96 * MiB;
constexpr size_t WS_XB = 124 * MiB;
constexpr size_t WS_HB = 252 * MiB;
constexpr size_t WS_BIG = 380 * MiB;
constexpr size_t WS_ACT = WS_BIG;
constexpr size_t WS_XS = WS_BIG, WS_ACTM = WS_BIG + 132 * MiB;
constexpr size_t WS_END = 1024 * MiB;
static_assert(WS_ACTM + (size_t)2 * MAXTILES * 256 * DE <= WS_END && WS_XS + (size_t)2 * MAXTILES * 256 * D <= WS_ACTM && WS_ACT + (size_t)T * FF * 2 <= WS_END && WS_BIG + (size_t)T * NPROJ * 2 <= WS_END, "d_ws map");
static_assert(WS_SLOTG + (size_t)2 * MAXTILES * 256 * 4 <= WS_TOKE && WS_SLOTT + (size_t)2 * MAXTILES * 256 * 4 <= WS_WIN && WS_WD + (size_t)D * FF * 2 <= WS_GW && WS_MWGU + (size_t)NE * 2 * DE * D <= WS_MWD
              && WS_MWD + (size_t)NE * D * DE <= WS_XB && WS_XB + (size_t)T * D * 2 <= WS_HB && WS_HB + (size_t)T * D * 2 <= WS_BIG, "d_ws map");
constexpr int CW_TMO = 0, CW_CODE = 1, CW_BAR = 4096;
constexpr int RING_OFF = 0, RING_BYTES = 131072;
constexpr int LDSCTL_OFF = RING_BYTES, MISC_OFF = LDSCTL_OFF + 320, MOE_OFF = LDSCTL_OFF + 512;
constexpr int LDS_BYTES = 147456;
constexpr int MT_TOT = 0, MT_POFF = 8, MT_NT = 20, MT_PBASE = 24, MT_TILE = 32;
constexpr int MT_STRIDE = 128;
static_assert(MT_TILE * 4 + 272 <= MT_STRIDE * 4 && MOE_OFF + 2 * MT_STRIDE * 4 <= LDS_BYTES, "LDS map");

#define GAS __attribute__((address_space(1)))
#define LAS __attribute__((address_space(3)))
typedef unsigned short bf16;
typedef unsigned v4u __attribute__((ext_vector_type(4)));
typedef unsigned v2u __attribute__((ext_vector_type(2)));
typedef float f32x4 __attribute__((ext_vector_type(4)));
typedef GAS unsigned gu32;
#define RLX_AGENT __ATOMIC_RELAXED, __HIP_MEMORY_SCOPE_AGENT
#define LDS_WAIT() asm volatile("s_waitcnt lgkmcnt(0)" ::: "memory")
#define VM_WAIT() asm volatile("s_waitcnt vmcnt(0)" ::: "memory")
__device__ __forceinline__ unsigned f2bf(float f) { unsigned u = __builtin_bit_cast(unsigned, f); return (u + 0x7fffu + ((u >> 16) & 1u)) >> 16; }
__device__ __forceinline__ unsigned pk2(float lo, float hi) { return f2bf(lo) | (f2bf(hi) << 16); }
__device__ __forceinline__ float bflo(unsigned w) { return __builtin_bit_cast(float, w << 16); }
__device__ __forceinline__ float bfhi(unsigned w) { return __builtin_bit_cast(float, w & 0xffff0000u); }
template <int CTRL, int ROW_MASK>
__device__ __forceinline__ float dpp_f(float v) {
    return __builtin_bit_cast(float, __builtin_amdgcn_update_dpp(0, __builtin_bit_cast(int, v), CTRL, ROW_MASK, 0xf, false)); }
__device__ __forceinline__ float wave_sum(float v) {
    v += dpp_f<0xB1, 0xf>(v);
    v += dpp_f<0x4E, 0xf>(v);
    v += dpp_f<0x141, 0xf>(v);
    v += dpp_f<0x140, 0xf>(v);
    v += dpp_f<0x142, 0xa>(v);
    v += dpp_f<0x143, 0xc>(v);
    return __builtin_bit_cast(float, __builtin_amdgcn_readlane(__builtin_bit_cast(int, v), 63));
}

__device__ __forceinline__ int opaque_tid() { int t = threadIdx.x; asm volatile("" : "+v"(t)); return t; }
__device__ __forceinline__ unsigned char* opaque_ptr(unsigned char* p) { size_t z = 0; asm volatile("" : "+s"(z)); return p + z; }
__device__ __forceinline__ int opaque_i(int v) { asm volatile("" : "+s"(v)); return v; }
#define PHASE_IDS() const int tid = opaque_tid(), lane = tid & 63, wave = __builtin_amdgcn_readfirstlane(tid >> 6); (void)lane; (void)wave

#define XB_TMO      128
#define XB_XCNT(j)  (256  + 64 * (j))
#define XB_XSUB(j)  (1280 + 64 * (j))
#define XB_XGEN(j)  (2304 + 64 * (j))
#define XB_TOP      3328
#define XB_TOPGEN   3392
#define XCD_BAR_WORDS 3456
#define XB_SPIN_CAP (1u << 18)

__device__ __forceinline__ unsigned xb_ld(unsigned* p)              { return __hip_atomic_load(p, __ATOMIC_RELAXED, __HIP_MEMORY_SCOPE_AGENT); }
__device__ __forceinline__ unsigned xb_add(unsigned* p, unsigned v) { return __hip_atomic_fetch_add(p, v, __ATOMIC_RELAXED, __HIP_MEMORY_SCOPE_AGENT); }
__device__ __forceinline__ unsigned xb_xcc_id() { return (unsigned)__builtin_amdgcn_s_getreg((3 << 11) | 20) & 0xFu; }
#define XB_SPIN(cond, bar) do { unsigned _sp = 0; while (cond) { __builtin_amdgcn_s_sleep(1); \
    if ((++_sp & 255u) == 0u) { if (xb_ld(&(bar)[XB_TMO])) break; if (_sp > XB_SPIN_CAP) { atomicAdd(&(bar)[XB_TMO], 1u); break; } } } } while (0)

struct XcdBarrier {
    unsigned* bar; unsigned x;
    volatile LAS unsigned* st;
};

__device__ __forceinline__ XcdBarrier xcd_barrier_post(unsigned* bar, volatile LAS unsigned* st) {
    XcdBarrier b; b.bar = bar; b.x = xb_xcc_id(); b.st = st;
    if (threadIdx.x == 0) (void)xb_add(&bar[XB_XCNT(b.x)], 1u);
    return b;
}
__device__ __forceinline__ void xcd_barrier_complete(unsigned* bar, unsigned x, unsigned& nloc, unsigned& nx) {
    const unsigned G = gridDim.x * gridDim.y * gridDim.z;
    unsigned sum, cnt, mine, sp = 0u;
    for (;;) {
        sum = 0u; cnt = 0u; mine = 0u;
#pragma unroll
        for (unsigned j = 0; j < 16; ++j) { const unsigned c = xb_ld(&bar[XB_XCNT(j)]); sum += c; cnt += (c > 0u) ? 1u : 0u; mine = (j == x) ? c : mine; }
        if (sum == G) break;
        __builtin_amdgcn_s_sleep(1);
        if ((++sp & 255u) == 0u) { if (xb_ld(&bar[XB_TMO])) break; if (sp > XB_SPIN_CAP) { atomicAdd(&bar[XB_TMO], 1u); break; } }
    }
    nloc = mine > 0u ? mine : 1u; nx = cnt > 0u ? cnt : 1u;
}

__device__ __forceinline__ void xcd_barrier(const XcdBarrier& b) {
    asm volatile("s_waitcnt vmcnt(0)" ::: "memory");
    __syncthreads();
    if (threadIdx.x == 0) {
        unsigned* bar = b.bar;
        __builtin_amdgcn_s_waitcnt(0);
        unsigned nloc = b.st[0], nx = b.st[1];
        if (nloc == 0u) { xcd_barrier_complete(bar, b.x, nloc, nx); b.st[0] = nloc; b.st[1] = nx; }
        const unsigned old = xb_add(&bar[XB_XSUB(b.x)], 1u);
        const unsigned gen = old / nloc;
        if (old + 1u == (gen + 1u) * nloc) {
            __builtin_amdgcn_fence(__ATOMIC_RELEASE, "agent");
            asm volatile("s_waitcnt vmcnt(0)" ::: "memory");
            const unsigned og = xb_add(&bar[XB_TOP], 1u);
            const unsigned tg = og / nx;
            if (og + 1u == (tg + 1u) * nx) xb_add(&bar[XB_TOPGEN], 1u);
            else XB_SPIN(xb_ld(&bar[XB_TOPGEN]) == tg, bar);
            __builtin_amdgcn_fence(__ATOMIC_ACQUIRE, "agent");
            xb_add(&bar[XB_XGEN(b.x)], 1u);
            asm volatile("s_waitcnt vmcnt(0)" ::: "memory");
        } else {
            XB_SPIN(xb_ld(&bar[XB_XGEN(b.x)]) == gen, bar);
            __builtin_amdgcn_fence(__ATOMIC_ACQUIRE, "agent");
            asm volatile("s_waitcnt vmcnt(0)" ::: "memory");
        }
    }
    __syncthreads();
}

__device__ __forceinline__ void transpose_item(const float* W, int K, int N, bf16* WT, int mode, LAS float* scr, int item, int lane) {
    const int nblk = N / 32, kb = item / nblk, nb = item % nblk, k0 = 64 * kb, n0 = 32 * nb;
#pragma unroll 8
    for (int i = 0; i < 32; ++i) { const int kk = 2 * i + (lane >> 5); scr[kk * 33 + (lane & 31)] = W[(size_t)(k0 + kk) * N + n0 + (lane & 31)]; }
    LDS_WAIT(); asm volatile("" ::: "memory");
    const int c = lane & 7; const float wsc = (mode == 1) ? 1.4426950408889634f : (mode == 2) ? 0.6931471805599453f : 1.0f;
#pragma unroll
    for (int j = 0; j < 4; ++j) { const int n = (lane >> 3) + 8 * j; const LAS float* s = scr + (8 * c) * 33 + n;
        v4u o; o.x = pk2(s[0 * 33] * wsc, s[1 * 33] * wsc); o.y = pk2(s[2 * 33] * wsc, s[3 * 33] * wsc); o.z = pk2(s[4 * 33] * wsc, s[5 * 33] * wsc); o.w = pk2(s[6 * 33] * wsc, s[7 * 33] * wsc);
        const int nc = n0 + n; const int drow = (mode == 0) ? nc : (((nc >> 7) << 8) + ((mode == 2) ? 128 : 0) + (nc & 127));
        *(GAS v4u*)(WT + (size_t)drow * K + k0 + 8 * c) = o; }
    LDS_WAIT(); asm volatile("" ::: "memory");
}
__device__ __forceinline__ void transpose_item_f8(const float* W, int K, int N, unsigned char* WT, int mode, LAS float* scr, int item, int lane) {
    const int nblk = N / 32, kb = item / nblk, nb = item % nblk, k0 = 64 * kb, n0 = 32 * nb;
#pragma unroll 8
    for (int i = 0; i < 32; ++i) { const int kk = 2 * i + (lane >> 5); scr[kk * 33 + (lane & 31)] = W[(size_t)(k0 + kk) * N + n0 + (lane & 31)]; }
    LDS_WAIT(); asm volatile("" ::: "memory");
    const int c = lane & 7; const float wsc = (mode == 1) ? 1.4426950408889634f : (mode == 2) ? 0.6931471805599453f : 1.0f;
#pragma unroll
    for (int j = 0; j < 4; ++j) { const int n = (lane >> 3) + 8 * j; const LAS float* s = scr + (8 * c) * 33 + n;
        v2u o; o.x = pg8::pk4_fp8((f32x4){s[0 * 33], s[1 * 33], s[2 * 33], s[3 * 33]} * (32.0f * wsc)); o.y = pg8::pk4_fp8((f32x4){s[4 * 33], s[5 * 33], s[6 * 33], s[7 * 33]} * (32.0f * wsc));
        const int nc = n0 + n; const int drow = (mode == 0) ? nc : (((nc >> 7) << 8) + ((mode == 2) ? 128 : 0) + (nc & 127));
        *(GAS v2u*)(WT + (size_t)drow * K + k0 + 8 * c) = o; }
    LDS_WAIT(); asm volatile("" ::: "memory");
}
struct Args { const float* in[22]; float* out; unsigned char* ws; };
__device__ __forceinline__ void p0_transposes(const Args& P, LAS unsigned char* lds, int blk, int G) {
    PHASE_IDS();
    LAS float* scr = (LAS float*)(lds + RING_OFF + wave * 16384);
    const int gw = blk * NWAVES + wave, NGW = G * NWAVES;
    bf16* Win_t = (bf16*)(P.ws + WS_WIN); bf16* Wout_t = (bf16*)(P.ws + WS_WOUT); bf16* Wgu_t = (bf16*)(P.ws + WS_WGU); bf16* Wd_t = (bf16*)(P.ws + WS_WD);
    unsigned char* MWgu8 = P.ws + WS_MWGU; unsigned char* MWd8 = P.ws + WS_MWD;
    constexpr int I_IN = (D / 64) * (NPROJ / 32), I_OUT = (D / 64) * (D / 32), I_GU = (D / 64) * (FF / 32), I_DN = (FF / 64) * (D / 32), I_MGU = (D / 64) * (DE / 32), I_MDN = (DE / 64) * (D / 32);
    constexpr int NITEMS = 2 * I_IN + 2 * I_OUT + 2 * I_GU + I_DN + 16 * I_MGU + 8 * I_MDN;
    for (int it = gw; it < NITEMS; it += NGW) {
        int r = it;
        if (r < 2 * I_IN) { const int l = r / I_IN; transpose_item(P.in[6] + (size_t)l * D * NPROJ, D, NPROJ, Win_t + (size_t)l * NPROJ * D, 0, scr, r % I_IN, lane); continue; } r -= 2 * I_IN;
        if (r < 2 * I_OUT) { const int l = r / I_OUT; transpose_item(P.in[13] + (size_t)l * D * D, D, D, Wout_t + (size_t)l * D * D, 0, scr, r % I_OUT, lane); continue; } r -= 2 * I_OUT;
#ifdef FFN_FP8
        if (r < I_GU) { transpose_item_f8(P.in[14], D, FF, (unsigned char*)Wgu_t, 1, scr, r, lane); continue; } r -= I_GU;
        if (r < I_GU) { transpose_item_f8(P.in[15], D, FF, (unsigned char*)Wgu_t, 2, scr, r, lane); continue; } r -= I_GU;
        if (r < I_DN) { transpose_item_f8(P.in[16], FF, D, (unsigned char*)Wd_t, 0, scr, r, lane); continue; } r -= I_DN;
#else
#if FFN_GU_FP8
        if (r < I_GU) { transpose_item_f8(P.in[14], D, FF, (unsigned char*)Wgu_t, 1, scr, r, lane); continue; } r -= I_GU;
        if (r < I_GU) { transpose_item_f8(P.in[15], D, FF, (unsigned char*)Wgu_t, 2, scr, r, lane); continue; } r -= I_GU;
#else
        if (r < I_GU) { transpose_item(P.in[14], D, FF, Wgu_t, 1, scr, r, lane); continue; } r -= I_GU;
        if (r < I_GU) { transpose_item(P.in[15], D, FF, Wgu_t, 2, scr, r, lane); continue; } r -= I_GU;
#endif
#if FFN_DOWN_FP8
        if (r < I_DN) { transpose_item_f8(P.in[16], FF, D, (unsigned char*)Wd_t, 0, scr, r, lane); continue; } r -= I_DN;
#else
        if (r < I_DN) { transpose_item(P.in[16], FF, D, Wd_t, 0, scr, r, lane); continue; } r -= I_DN;
#endif
#endif
        if (r < 8 * I_MGU) { const int e = r / I_MGU; transpose_item_f8(P.in[19] + (size_t)e * D * DE, D, DE, MWgu8 + (size_t)e * 2 * DE * D, 1, scr, r % I_MGU, lane); continue; } r -= 8 * I_MGU;
        if (r < 8 * I_MGU) { const int e = r / I_MGU; transpose_item_f8(P.in[20] + (size_t)e * D * DE, D, DE, MWgu8 + (size_t)e * 2 * DE * D, 2, scr, r % I_MGU, lane); continue; } r -= 8 * I_MGU;
        { const int e = r / I_MDN; transpose_item_f8(P.in[21] + (size_t)e * DE * D, DE, D, MWd8 + (size_t)e * D * DE, 0, scr, r % I_MDN, lane); }
    }
}
__device__ __forceinline__ void p0_ada(const Args& P, LAS unsigned char* lds, int blk, int G) {
    PHASE_IDS();
    LAS float* ca = (LAS float*)(lds + RING_OFF);
    const float* c = P.in[1]; const float* ada_w = P.in[2]; const float* ada_b = P.in[3]; float* ada = (float*)(P.ws + WS_ADA);
    for (int u = blk; u < 192; u += G) {
        const int l = u / 96, col0 = (u % 96) * 64;
        __syncthreads();
        for (int idx = tid; idx < 32768; idx += NWAVES * 64) { const int b = idx & 31, k = idx >> 5; const float v = c[b * 1024 + k]; ca[idx] = v / (1.0f + expf(-v)); }
        __syncthreads();
        float acc[32];
#pragma unroll
        for (int b = 0; b < 32; ++b) acc[b] = 0.f;
        const float* wp = ada_w + ((size_t)l * 1024 + wave * 128) * ADA + col0 + lane;
        for (int kk = 0; kk < 128; ++kk) { const float wv = wp[(size_t)kk * ADA]; const LAS f32x4* cp = (const LAS f32x4*)(ca + (wave * 128 + kk) * 32);
#pragma unroll
            for (int q = 0; q < 8; ++q) { const f32x4 cv = cp[q]; acc[4 * q] += cv.x * wv; acc[4 * q + 1] += cv.y * wv; acc[4 * q + 2] += cv.z * wv; acc[4 * q + 3] += cv.w * wv; } }
        __syncthreads();
#pragma unroll
        for (int b = 0; b < 32; ++b) ca[(wave * 32 + b) * 64 + lane] = acc[b];
        __syncthreads();
#pragma unroll
        for (int o = 0; o < 4; ++o) { const int idx = tid + 512 * o, b = idx >> 6, ln = idx & 63; float s = 0.f;
#pragma unroll
            for (int w = 0; w < 8; ++w) s += ca[(w * 32 + b) * 64 + ln];
            const float av = s + ada_b[l * ADA + col0 + ln];
            ada[((size_t)l * 32 + b) * ADA + col0 + ln] = av;
            if (l == 1 && col0 >= 5 * D) ((bf16*)(P.ws + WS_G16))[b * D + col0 + ln - 5 * D] = (bf16)f2bf(av); }
    }
    __syncthreads();
}
template <bool ROUTE, bool OUT8 = false, bool XBF = false>
__device__ __forceinline__ void norm_phase(const float* xsrc, const float* gvec, const float* ada_l, int sc_off, int sh_off, bf16* HB,
                                           const float* rw, const float* rb, int* pcnt, int* tok_e, int* tok_rank, float* tok_gate,
                                           LAS unsigned char* lds, int blk, int G) {
    PHASE_IDS();
    LAS int* pe = (LAS int*)(lds + RING_OFF); LAS float* pg = (LAS float*)(lds + RING_OFF + 2048); LAS int* wcnt = (LAS int*)(lds + RING_OFF + 4096);
    const LAS f32x4* rwl = (const LAS f32x4*)(lds + RING_OFF + 8192);
    f32x4 rwr[16];
    if constexpr (ROUTE) {
#pragma unroll
        for (int j = 0; j < 4; ++j)
#pragma unroll
            for (int i = 0; i < 4; ++i) rwr[j * 4 + i] = *(const GAS f32x4*)(rw + (size_t)(256 * j + 4 * lane + i) * 8);
        LAS float* wl = (LAS float*)(lds + RING_OFF + 8192);
        for (int idx = tid; idx < D * 8; idx += NWAVES * 64) { const int col = idx >> 3, e = idx & 7; wl[((((col >> 8) * 4 + (col & 3)) * 2 + (e >> 2)) * 64 + ((col & 255) >> 2)) * 4 + (e & 3)] = rw[idx]; }
        __syncthreads();
    }
    for (int p = blk; p < T / 256; p += G) {
        const int b = p >> 3;
        f32x4 mod[4], sh[4];
#pragma unroll
        for (int j = 0; j < 4; ++j) { const int col = 4 * lane + 256 * j; const f32x4 g4 = *(const f32x4*)(gvec + col); const f32x4 sc4 = *(const f32x4*)(ada_l + (size_t)b * ADA + sc_off + col);
            sh[j] = *(const f32x4*)(ada_l + (size_t)b * ADA + sh_off + col); mod[j] = g4 * (1.0f + sc4); }
        float rbv[8];
        if constexpr (ROUTE) {
#pragma unroll
            for (int e = 0; e < 8; ++e) rbv[e] = rb[e];
        }
        constexpr int NAH = 4;
        f32x4 vbx[NAH][4]; v2u vbb[NAH][4];
#pragma unroll
        for (int q = 0; q < NAH; ++q) {
            if constexpr (XBF) { const GAS v2u* xr0 = (const GAS v2u*)((const bf16*)xsrc + (size_t)(p * 256 + q * 8 + wave) * D) + lane;
#pragma unroll
              for (int j = 0; j < 4; ++j) vbb[q][j] = xr0[64 * j]; }
            else { const GAS f32x4* xr0 = (const GAS f32x4*)(xsrc + (size_t)(p * 256 + q * 8 + wave) * D) + lane;
#pragma unroll
              for (int j = 0; j < 4; ++j) vbx[q][j] = xr0[64 * j]; } }
        for (int rr0 = 0; rr0 < 32; rr0 += NAH)
#pragma unroll
        for (int q = 0; q < NAH; ++q) {
            const int rr = rr0 + q;
            const int row = p * 256 + rr * 8 + wave;
            f32x4 v[4]; float ss = 0.f;
#pragma unroll
            for (int j = 0; j < 4; ++j) { if constexpr (XBF) v[j] = (f32x4){bflo(vbb[q][j].x), bfhi(vbb[q][j].x), bflo(vbb[q][j].y), bfhi(vbb[q][j].y)}; else v[j] = vbx[q][j]; }
            if (rr + NAH < 32) {
                if constexpr (XBF) { const GAS v2u* xr = (const GAS v2u*)((const bf16*)xsrc + (size_t)(row + 8 * NAH) * D) + lane;
#pragma unroll
                    for (int j = 0; j < 4; ++j) vbb[q][j] = xr[64 * j]; }
                else { const GAS f32x4* xr = (const GAS f32x4*)(xsrc + (size_t)(row + 8 * NAH) * D) + lane;
#pragma unroll
                    for (int j = 0; j < 4; ++j) vbx[q][j] = xr[64 * j]; } }
#pragma unroll
            for (int j = 0; j < 4; ++j) ss += (v[j].x * v[j].x + v[j].y * v[j].y) + (v[j].z * v[j].z + v[j].w * v[j].w);
            const float rs = 1.0f / sqrtf(wave_sum(ss) * (1.0f / D) + EPS);
            GAS unsigned long long* o8 = (GAS unsigned long long*)(HB + (size_t)row * D) + lane;
#pragma unroll
            for (int j = 0; j < 4; ++j) { v[j] = v[j] * rs * mod[j] + sh[j];
                if constexpr (OUT8) *(GAS unsigned*)((unsigned char*)HB + (size_t)row * D + 4 * lane + 256 * j) = pg8::pk4_fp8(v[j]);
                else o8[64 * j] = (unsigned long long)pk2(v[j].x, v[j].y) | ((unsigned long long)pk2(v[j].z, v[j].w) << 32); }
            if constexpr (ROUTE) {
                float lg[8];
#pragma unroll
                for (int e = 0; e < 8; ++e) lg[e] = 0.f;
#pragma unroll
                for (int j = 0; j < 4; ++j)
#pragma unroll
                    for (int i = 0; i < 4; ++i) { const float y = v[j][i]; const f32x4 r0 = rwr[j * 4 + i], r1 = rwl[((j * 4 + i) * 2 + 1) * 64 + lane];
#pragma unroll
                        for (int e = 0; e < 4; ++e) { lg[e] += y * r0[e]; lg[4 + e] += y * r1[e]; } }
#pragma unroll
                for (int e = 0; e < 8; ++e) lg[e] = wave_sum(lg[e]) + rbv[e];
                int e1 = 0; float l1 = lg[0];
#pragma unroll
                for (int e = 1; e < 8; ++e) if (lg[e] > l1) { l1 = lg[e]; e1 = e; }
                int e2 = 0; float l2 = -INFINITY;
#pragma unroll
                for (int e = 0; e < 8; ++e) if (e != e1 && lg[e] > l2) { l2 = lg[e]; e2 = e; }
                const float g1 = 1.0f / (1.0f + expf(l2 - l1));
                if (lane == 0) { const int i = rr * 8 + wave; pe[i] = e1; pe[256 + i] = e2; pg[i] = g1; pg[256 + i] = 1.0f - g1; }
            }
        }
        if constexpr (ROUTE) {
            __syncthreads();
            int lr[2] = {0, 0};
            if (tid < 256) {
#pragma unroll
                for (int k = 0; k < 2; ++k) { const int e = pe[k * 256 + tid];
#pragma unroll
                    for (int ee = 0; ee < 8; ++ee) { const unsigned long long m = __ballot(e == ee); if (e == ee) lr[k] = __popcll(m & ((1ull << lane) - 1ull)); if (lane == 0) wcnt[(k * 4 + wave) * 8 + ee] = __popcll(m); } }
            }
            __syncthreads();
            if (tid < 256) { const int t = p * 256 + tid;
#pragma unroll
                for (int k = 0; k < 2; ++k) { const int e = pe[k * 256 + tid]; int base = 0;
#pragma unroll
                    for (int w2 = 0; w2 < 4; ++w2) if (w2 < wave) base += wcnt[(k * 4 + w2) * 8 + e];
                    tok_e[t * 2 + k] = e; tok_rank[t * 2 + k] = base + lr[k]; tok_gate[t * 2 + k] = pg[k * 256 + tid]; } }
            if (tid < 16) { const int k = tid >> 3, ee = tid & 7; pcnt[p * 16 + tid] = wcnt[(k * 4 + 0) * 8 + ee] + wcnt[(k * 4 + 1) * 8 + ee] + wcnt[(k * 4 + 2) * 8 + ee] + wcnt[(k * 4 + 3) * 8 + ee]; }
            __syncthreads();
        }
    }
}
__device__ __forceinline__ void qknorm_phase(bf16* PROJ, const float* qg, const float* kg, int blk, int G) {
    PHASE_IDS();
    const int gw = blk * NWAVES + wave, NGW = G * NWAVES;
    float gq[8], gk[8];
#pragma unroll
    for (int i = 0; i < 8; ++i) { gq[i] = qg[(lane & 7) * 8 + i] * C2; gk[i] = kg[(lane & 7) * 8 + i]; }
    for (int it = gw; it < 2 * T; it += NGW) {
        const int row = it >> 1, which = it & 1;
        GAS v4u* p = (GAS v4u*)(PROJ + (size_t)row * NPROJ + which * 512 + lane * 8);
        const v4u raw = *p; float v[8];
#pragma unroll
        for (int i = 0; i < 4; ++i) { v[2 * i] = bflo(raw[i]); v[2 * i + 1] = bfhi(raw[i]); }
        float ss = 0.f;
#pragma unroll
        for (int i = 0; i < 8; ++i) ss += v[i] * v[i];
        ss += __shfl_xor(ss, 1); ss += __shfl_xor(ss, 2); ss += __shfl_xor(ss, 4);
        const float rs = 1.0f / sqrtf(ss * (1.0f / 64.0f) + EPS);
        v4u o;
#pragma unroll
        for (int i = 0; i < 4; ++i) { const float a = v[2 * i] * rs * (which ? gk[2 * i] : gq[2 * i]), c = v[2 * i + 1] * rs * (which ? gk[2 * i + 1] : gq[2 * i + 1]); o[i] = pk2(a, c); }
        *p = o;
    }
}
__device__ __forceinline__ void attn_simple(const bf16* PROJ, bf16* MIX, LAS unsigned char* lds, int blk, int G) {
    PHASE_IDS();
    LAS float* Ks = (LAS float*)(lds + RING_OFF); LAS float* Vs = Ks + 64 * 64;
    for (int i = 0;; ++i) {
        const int u = i * G + blk; if (u >= BATCH * 8 * 4) break;
        const int bh = u >> 2, qb = ((u & 3) + i) & 3, b = bh >> 3, h = bh & 7;
        const int tq = qb * 512 + tid; const size_t rowq = (size_t)b * SEQ + tq;
        float q[64], o[64];
        { const GAS v4u* qp = (const GAS v4u*)(PROJ + rowq * NPROJ + h * 64);
#pragma unroll
          for (int c = 0; c < 8; ++c) { const v4u w = qp[c];
#pragma unroll
              for (int e = 0; e < 4; ++e) { q[8 * c + 2 * e] = bflo(w[e]); q[8 * c + 2 * e + 1] = bfhi(w[e]); } } }
#pragma unroll
        for (int d = 0; d < 64; ++d) o[d] = 0.f;
        float carry = 0.f;
        const int wq_max = qb * 512 + wave * 64 + 63;
        for (int kt = (qb * 512 + 511) >> 6; kt >= 0; --kt) {
            __syncthreads();
            { const size_t krow = (size_t)b * SEQ + kt * 64 + (tid >> 3); const int d8 = (tid & 7) * 8;
              const v4u kr = *(const GAS v4u*)(PROJ + krow * NPROJ + 512 + h * 64 + d8); const v4u vr = *(const GAS v4u*)(PROJ + krow * NPROJ + 1024 + h * 64 + d8);
              LAS float* kd = Ks + (tid >> 3) * 64 + d8; LAS float* vd = Vs + (tid >> 3) * 64 + d8;
#pragma unroll
              for (int e = 0; e < 4; ++e) { kd[2 * e] = bflo(kr[e]); kd[2 * e + 1] = bfhi(kr[e]); vd[2 * e] = bflo(vr[e]); vd[2 * e + 1] = bfhi(vr[e]); } }
            __syncthreads();
            if (kt * 64 < wq_max) {
                for (int j = 63; j >= 0; --j) {
                    const int key = kt * 64 + j;
                    const LAS f32x4* kp = (const LAS f32x4*)(Ks + j * 64); float z = 0.f;
#pragma unroll
                    for (int d4 = 0; d4 < 16; ++d4) { const f32x4 kv = kp[d4]; z += q[4 * d4] * kv.x + q[4 * d4 + 1] * kv.y + q[4 * d4 + 2] * kv.z + q[4 * d4 + 3] * kv.w; }
                    const bool valid = key < tq;
                    const float sp = fmaxf(z, 0.f) + __builtin_amdgcn_logf(1.0f + __builtin_amdgcn_exp2f(-fabsf(z)));
                    const float L = valid ? -sp : 0.f;
                    const float w = valid ? __builtin_amdgcn_exp2f(z + L + carry) : 0.f;
                    carry += L;
                    const LAS f32x4* vp = (const LAS f32x4*)(Vs + j * 64);
#pragma unroll
                    for (int d4 = 0; d4 < 16; ++d4) { const f32x4 vv = vp[d4]; o[4 * d4] += w * vv.x; o[4 * d4 + 1] += w * vv.y; o[4 * d4 + 2] += w * vv.z; o[4 * d4 + 3] += w * vv.w; }
                }
            }
        }
        { GAS v4u* op = (GAS v4u*)(MIX + rowq * D + h * 64);
#pragma unroll
          for (int c = 0; c < 8; ++c) { v4u w;
#pragma unroll
              for (int e = 0; e < 4; ++e) w[e] = pk2(o[8 * c + 2 * e], o[8 * c + 2 * e + 1]);
              op[c] = w; } }
    }
    __syncthreads();
}
namespace sba {
typedef _Float16 f16x8 __attribute__((ext_vector_type(8)));
typedef _Float16 f16x2 __attribute__((ext_vector_type(2)));
typedef short bf16x8 __attribute__((ext_vector_type(8)));
typedef short s16x4 __attribute__((ext_vector_type(4)));
typedef float f32x16 __attribute__((ext_vector_type(16)));
typedef float f32x2_t __attribute__((ext_vector_type(2)));
typedef __bf16 bf16x2_t __attribute__((ext_vector_type(2)));
typedef unsigned u32x4 __attribute__((ext_vector_type(4)));
constexpr int SLOTB = 8192, NSLOT = 5, LDS_K = 0, LDS_V = NSLOT * SLOTB, LDS_BYTES_ATT = 2 * NSLOT * SLOTB;
constexpr float SBA_DEAD = -160.0f;
__device__ __forceinline__ int crow(int r, int hi) { return (r & 3) + 8 * (r >> 2) + 4 * hi; }
__device__ __forceinline__ unsigned cvtpk_bf16(float lo, float hi) { f32x2_t v = {lo, hi}; bf16x2_t b = __builtin_convertvector(v, bf16x2_t); return __builtin_bit_cast(unsigned, b); }
__device__ __forceinline__ unsigned cvtpk_f16(float lo, float hi) { f32x2_t v = {lo, hi}; f16x2 b = __builtin_convertvector(v, f16x2); return __builtin_bit_cast(unsigned, b); }
__device__ __forceinline__ s16x4 vtr(const LAS unsigned char* p) { return __builtin_bit_cast(s16x4, __builtin_amdgcn_ds_read_tr16_b64_v4i16((LAS s16x4*)p)); }

template <int MODE>
__device__ __forceinline__ void tile64(f32x16 (&oT)[2], float& carry, const bf16x8 (&qr)[4], const f16x8 (&tri)[2], const LAS unsigned char* Kslot, const LAS unsigned char* Vslot, int r32, int hi, int lane) {
    constexpr bool HAS1 = (MODE != 2), DIAG1 = (MODE == 1), DIAG0 = (MODE == 2);
    f32x16 z1, z0;
#pragma unroll
    for (int i = 0; i < 16; ++i) { z1[i] = 0.f; z0[i] = 0.f; }
#pragma unroll
    for (int d0 = 0; d0 < 4; ++d0) { const LAS unsigned char* kp = Kslot + (2 * d0 + hi) * 1024 + r32 * 16;
        if (HAS1) { const bf16x8 kf1 = *(const LAS bf16x8*)(kp + 512); z1 = __builtin_amdgcn_mfma_f32_32x32x16_bf16(kf1, qr[d0], z1, 0, 0, 0); }
        const bf16x8 kf0 = *(const LAS bf16x8*)kp; z0 = __builtin_amdgcn_mfma_f32_32x32x16_bf16(kf0, qr[d0], z0, 0, 0, 0); }
    float lg1[16], lg0[16];
#pragma unroll
    for (int i = 0; i < 16; ++i) {
        if (HAS1) { z1[i] = __builtin_amdgcn_fmed3f(z1[i], -3.0e38f, 126.0f); lg1[i] = __builtin_amdgcn_logf(1.0f + __builtin_amdgcn_exp2f(z1[i]));
            if (DIAG1) { const bool valid = crow(i, hi) < r32; lg1[i] = valid ? lg1[i] : 0.f; z1[i] = valid ? z1[i] : -1.0e30f; } }
        z0[i] = __builtin_amdgcn_fmed3f(z0[i], -3.0e38f, 126.0f); lg0[i] = __builtin_amdgcn_logf(1.0f + __builtin_amdgcn_exp2f(z0[i]));
        if (DIAG0) { const bool valid = crow(i, hi) < r32; lg0[i] = valid ? lg0[i] : 0.f; z0[i] = valid ? z0[i] : -1.0e30f; } }
    const float z1r0 = z1[0], z0r0 = z0[0];
    f32x16 D1 = z1, D0 = z0;
#pragma unroll
    for (int s = 0; s < 2; ++s) {
        if (HAS1) { u32x4 w;
#pragma unroll
            for (int j = 0; j < 4; ++j) w[j] = cvtpk_f16(lg1[8 * s + 2 * j], lg1[8 * s + 2 * j + 1]);
            D1 = __builtin_amdgcn_mfma_f32_32x32x16_f16(tri[s], __builtin_bit_cast(f16x8, w), D1, 0, 0, 0); }
        { u32x4 w;
#pragma unroll
            for (int j = 0; j < 4; ++j) w[j] = cvtpk_f16(lg0[8 * s + 2 * j], lg0[8 * s + 2 * j + 1]);
            D0 = __builtin_amdgcn_mfma_f32_32x32x16_f16(tri[s], __builtin_bit_cast(f16x8, w), D0, 0, 0, 0); } }
    float c0 = carry;
    if (HAS1) { const float t1 = D1[0] - z1r0; const auto rr = __builtin_amdgcn_permlane32_swap(__float_as_uint(t1), __float_as_uint(t1), false, false); c0 = carry + __uint_as_float(rr[0]); }
    const float t0 = D0[0] - z0r0; const auto rr0 = __builtin_amdgcn_permlane32_swap(__float_as_uint(t0), __float_as_uint(t0), false, false);
    float P1[16], P0[16];
#pragma unroll
    for (int i = 0; i < 16; ++i) { if (HAS1) P1[i] = __builtin_amdgcn_exp2f(D1[i] + carry); P0[i] = __builtin_amdgcn_exp2f(D0[i] + c0); }
    carry = c0 + __uint_as_float(rr0[0]);
#pragma unroll
    for (int ks = 3; ks >= 0; --ks) {
        if (ks >= 2 && !HAS1) continue;
        u32x4 w;
#pragma unroll
        for (int j = 0; j < 4; ++j) { const int e = 8 * (ks & 1) + 2 * j; w[j] = (ks >= 2) ? cvtpk_bf16(P1[e], P1[e + 1]) : cvtpk_bf16(P0[e], P0[e + 1]); }
        const bf16x8 pf = __builtin_bit_cast(bf16x8, w);
#pragma unroll
        for (int d0 = 0; d0 < 2; ++d0) { const LAS unsigned char* vp = Vslot + d0 * 4096 + ks * 1024 + ((lane >> 4) & 1) * 32 + (lane & 3) * 8 + (4 * hi + ((lane & 15) >> 2)) * 64;
            const s16x4 lo = vtr(vp), hh = vtr(vp + 512);
            const bf16x8 vf = (bf16x8){lo[0], lo[1], lo[2], lo[3], hh[0], hh[1], hh[2], hh[3]};
            oT[d0] = __builtin_amdgcn_mfma_f32_32x32x16_bf16(vf, pf, oT[d0], 0, 0, 0); } }
}
__device__ __forceinline__ void glds16(const void* gsrc, unsigned lds_dst) { unsigned keep;
    asm volatile("s_mov_b32 %0, m0\n\ts_mov_b32 m0, %2\n\ts_nop 0\n\tglobal_load_lds_dwordx4 %1, off\n\ts_mov_b32 m0, %0" : "=&s"(keep) : "v"(gsrc), "s"(lds_dst) : "memory"); }
#define SBA_DMA(t_, sl_) do { \
    glds16(ksrc + (size_t)(t_) * 64 * NPROJ, (unsigned)__builtin_amdgcn_readfirstlane(lds0 + LDS_K + (sl_) * SLOTB + wave * 1024)); \
    glds16(vsrc + (size_t)(t_) * 64 * NPROJ, (unsigned)__builtin_amdgcn_readfirstlane(lds0 + LDS_V + (sl_) * SLOTB + wave * 1024)); } while (0)
__device__ __forceinline__ void attn_phase(const bf16* PROJ, bf16* MIX, LAS unsigned char* lds, int blk, int G) {
    PHASE_IDS();
    const int r32 = lane & 31, hi = lane >> 5;
    const unsigned lds0 = (unsigned)(uintptr_t)lds;
    LAS unsigned* flg = (LAS unsigned*)(lds + LDS_BYTES_ATT);
    f16x8 tri[2];
#pragma unroll
    for (int s = 0; s < 2; ++s)
#pragma unroll
        for (int j = 0; j < 8; ++j) tri[s][j] = (16 * s + 8 * (j >> 2) + 4 * hi + (j & 3) >= r32) ? (_Float16)(-1.0f) : (_Float16)0.0f;
    int s0 = 0, s1 = 1, s2 = 2;
    int p0 = 3, p1 = 4;
    for (int bh = blk; bh < BATCH * 8; bh += G) {
        const int b = bh >> 3, h = bh & 7;
        const bf16* Kh = PROJ + (size_t)b * SEQ * NPROJ + 512 + h * 64; const bf16* Vh = PROJ + (size_t)b * SEQ * NPROJ + 1024 + h * 64;
        const bf16* ksrc = Kh + (size_t)lane * NPROJ + wave * 8;
        const bf16* vsrc = Vh + (size_t)(16 * (wave & 3) + (lane >> 2)) * NPROJ + (wave >> 2) * 32 + (lane & 3) * 8;
        SBA_DMA(3, s0); SBA_DMA(2, s1);
        bf16x8 qr[4], qn[4];
        { const bf16* qp = PROJ + ((size_t)b * SEQ + wave * 32 + r32) * NPROJ + h * 64 + hi * 8;
#pragma unroll
          for (int d0 = 0; d0 < 4; ++d0) qr[d0] = *(const GAS bf16x8*)(qp + d0 * 16); }
        asm volatile("" : "+v"(qr[0]), "+v"(qr[1]), "+v"(qr[2]), "+v"(qr[3]));
        for (int qb = 0; qb < SEQ / 256; ++qb) {
            const int q0w = qb * 256 + wave * 32, NT = 4 * (qb + 1);
            f32x16 oT[2];
#pragma unroll
            for (int i = 0; i < 16; ++i) { oT[0][i] = 0.f; oT[1][i] = 0.f; }
            float carry = 0.f;
            bool mydone = false;
            for (int t = NT - 1; t >= 0; --t) {
                if (t == NT - 1 && qb > 0) asm volatile("s_waitcnt lgkmcnt(0)\n\ts_barrier" ::: "memory");
                else if (t >= 1) asm volatile("s_waitcnt vmcnt(2) lgkmcnt(0)\n\ts_barrier" ::: "memory"); else asm volatile("s_waitcnt vmcnt(0) lgkmcnt(0)\n\ts_barrier" ::: "memory");
                if (t < NT - 1) { const LAS u32x4* fp = (const LAS u32x4*)(flg + ((t + 1) & 1) * 8); const u32x4 fa = fp[0], fb = fp[1];
                    const unsigned all8 = (fa.x & fa.y & fa.z & fa.w) & (fb.x & fb.y & fb.z & fb.w);
                    if (__builtin_amdgcn_readfirstlane((int)all8) != 0) break; }
                if (t == NT - 1 && qb + 1 < SEQ / 256) {
                    SBA_DMA(NT + 3, p0); SBA_DMA(NT + 2, p1);
                    const bf16* qp = PROJ + ((size_t)b * SEQ + q0w + 256 + r32) * NPROJ + h * 64 + hi * 8;
#pragma unroll
                    for (int d0 = 0; d0 < 4; ++d0) qn[d0] = *(const GAS bf16x8*)(qp + d0 * 16); }
                if (t >= 2) SBA_DMA(t - 2, s2);
                const LAS unsigned char* Kslot = lds + LDS_K + s0 * SLOTB; const LAS unsigned char* Vslot = lds + LDS_V + s0 * SLOTB;
                const int khi = 64 * t + 32;
                if (!mydone) {
                    if (khi < q0w) tile64<0>(oT, carry, qr, tri, Kslot, Vslot, r32, hi, lane);
                    else if (khi == q0w) tile64<1>(oT, carry, qr, tri, Kslot, Vslot, r32, hi, lane);
                    else if (khi == q0w + 32) tile64<2>(oT, carry, qr, tri, Kslot, Vslot, r32, hi, lane);
                    mydone = __all(carry < SBA_DEAD) != 0;
                }
                if (lane == 0) flg[(t & 1) * 8 + wave] = mydone ? 1u : 0u;
                { const int tmp = s0; s0 = s1; s1 = s2; s2 = tmp; }
            }
            { bf16* op = MIX + ((size_t)b * SEQ + q0w + r32) * D + h * 64 + 4 * hi;
#pragma unroll
              for (int d0 = 0; d0 < 2; ++d0)
#pragma unroll
                  for (int g = 0; g < 4; ++g) { v2u w; w.x = cvtpk_bf16(oT[d0][4 * g], oT[d0][4 * g + 1]); w.y = cvtpk_bf16(oT[d0][4 * g + 2], oT[d0][4 * g + 3]);
                      *(GAS v2u*)(op + 32 * d0 + 8 * g) = w; } }
            if (qb + 1 < SEQ / 256) {
                asm volatile("" : "+v"(qn[0]), "+v"(qn[1]), "+v"(qn[2]), "+v"(qn[3]));
#pragma unroll
                for (int d0 = 0; d0 < 4; ++d0) qr[d0] = qn[d0];
                const int o0 = s0, o1 = s1; s0 = p0; s1 = p1; p0 = o0; p1 = o1;
            }
        }
    }
    asm volatile("s_waitcnt vmcnt(0) lgkmcnt(0)" ::: "memory");
    __syncthreads();
}
#undef SBA_DMA
}
__device__ __forceinline__ void gmlp_simple(const bf16* PROJ, bf16* MIX, const float* lng, const float* lnb, const float* Wsp, const float* bsp,
                                            LAS unsigned char* lds, int blk, int G) {
    PHASE_IDS();
    LAS float* stats = (LAS float*)(lds + RING_OFF); LAS float* vln = stats + 256; LAS float* Wt = vln + 128 * 64;
    for (int u = blk; u < BATCH * 16; u += G) {
        const size_t row0 = (size_t)(u >> 4) * SEQ + (u & 15) * 128;
        __syncthreads();
        for (int tt = 0; tt < 16; ++tt) { const int tok = wave * 16 + tt;
            const v4u raw = *(const GAS v4u*)(PROJ + (row0 + tok) * NPROJ + 2048 + lane * 8); float v[8]; float s = 0.f;
#pragma unroll
            for (int i = 0; i < 4; ++i) { v[2 * i] = bflo(raw[i]); v[2 * i + 1] = bfhi(raw[i]); s += v[2 * i] + v[2 * i + 1]; }
            const float mean = wave_sum(s) * (1.0f / 512.0f); float s2 = 0.f;
#pragma unroll
            for (int i = 0; i < 8; ++i) { const float d = v[i] - mean; s2 += d * d; }
            const float rstd = 1.0f / sqrtf(wave_sum(s2) * (1.0f / 512.0f) + EPS);
            if (lane == 0) { stats[2 * tok] = mean; stats[2 * tok + 1] = rstd; } }
        for (int g = 0; g < 8; ++g) {
            __syncthreads();
            { const int tok = tid >> 2, cb = (tid & 3) * 16; const GAS v4u* vp = (const GAS v4u*)(PROJ + (row0 + tok) * NPROJ + 2048 + g * 64 + cb);
              const float mean = stats[2 * tok], rstd = stats[2 * tok + 1];
#pragma unroll
              for (int hh = 0; hh < 2; ++hh) { const v4u raw = vp[hh];
#pragma unroll
                  for (int e = 0; e < 4; ++e) { const int c = g * 64 + cb + hh * 8 + 2 * e;
                      vln[tok * 64 + cb + hh * 8 + 2 * e] = (bflo(raw[e]) - mean) * rstd * lng[c] + lnb[c];
                      vln[tok * 64 + cb + hh * 8 + 2 * e + 1] = (bfhi(raw[e]) - mean) * rstd * lng[c + 1] + lnb[c + 1]; } } }
            { const int i = tid & 127, jq = tid >> 7;
#pragma unroll
              for (int jj = 0; jj < 8; ++jj) { const int j4 = (jq * 8 + jj) * 4; f32x4 w = *(const f32x4*)(Wsp + ((size_t)g * 128 + i) * 128 + j4);
                  if (i < 64 && j4 >= 64) w = (f32x4){0.f, 0.f, 0.f, 0.f};
                  Wt[(j4 + 0) * 132 + i] = w.x; Wt[(j4 + 1) * 132 + i] = w.y; Wt[(j4 + 2) * 132 + i] = w.z; Wt[(j4 + 3) * 132 + i] = w.w; } }
            __syncthreads();
            const int tc = tid & 15, ti = tid >> 4; float acc[4][4];
#pragma unroll
            for (int r = 0; r < 4; ++r)
#pragma unroll
                for (int c = 0; c < 4; ++c) acc[r][c] = 0.f;
            const int jmax = (wave < 4) ? 64 : 128;
            for (int j = 0; j < jmax; ++j) { const f32x4 a = *(const LAS f32x4*)(vln + j * 64 + 4 * tc); const f32x4 w = *(const LAS f32x4*)(Wt + j * 132 + 4 * ti);
#pragma unroll
                for (int r = 0; r < 4; ++r)
#pragma unroll
                    for (int c = 0; c < 4; ++c) acc[r][c] += w[r] * a[c]; }
#pragma unroll
            for (int r = 0; r < 4; ++r) { const int i = 4 * ti + r; const float bias = bsp[g * 128 + i];
                const v2u ur = *(const GAS v2u*)(PROJ + (row0 + i) * NPROJ + 1536 + g * 64 + 4 * tc);
                v2u o; o.x = pk2((acc[r][0] + bias) * bflo(ur.x), (acc[r][1] + bias) * bfhi(ur.x)); o.y = pk2((acc[r][2] + bias) * bflo(ur.y), (acc[r][3] + bias) * bfhi(ur.y));
                *(GAS v2u*)(MIX + (row0 + i) * D + 512 + g * 64 + 4 * tc) = o; }
        }
    }
    __syncthreads();
}
__device__ __forceinline__ void p0_spatial(const Args& P, int blk, int G) {
    PHASE_IDS();
    bf16* GW = (bf16*)(P.ws + WS_GW); const float* W = P.in[11];
    for (int idx = blk * (NWAVES * 64) + tid; idx < 2 * 8 * 128 * 128; idx += G * NWAVES * 64) {
        const int p = idx & 127, i = (idx >> 7) & 127, ks = p >> 4, hh = (p >> 3) & 1, jj = p & 7, j = 16 * ks + 8 * (jj >> 2) + 4 * hh + (jj & 3);
        const float w = ((j >> 6) <= (i >> 6)) ? W[(size_t)(idx & ~127) + j] : 0.f;
        GW[idx] = (bf16)f2bf(w); }
}
__device__ __forceinline__ void gmlp_phase(const bf16* PROJ, bf16* MIX, const float* lng, const float* lnb, const bf16* GW, const float* bsp, LAS unsigned char* lds, int blk, int G) {
    PHASE_IDS();
    typedef short bf16x8 __attribute__((ext_vector_type(8))); typedef float f32x16 __attribute__((ext_vector_type(16)));
    const int r32 = lane & 31, hi = lane >> 5, mi = wave >> 1, ci = wave & 1;
    for (int u = blk; u < BATCH * 16; u += G) {
        const size_t row0 = (size_t)(u >> 4) * SEQ + (u & 15) * 128;
        float gam[8], bet[8];
#pragma unroll
        for (int i = 0; i < 8; ++i) { gam[i] = lng[lane * 8 + i]; bet[i] = lnb[lane * 8 + i]; }
        __syncthreads();
        v4u rawn[4];
#pragma unroll
        for (int q = 0; q < 4; ++q) rawn[q] = *(const GAS v4u*)(PROJ + (row0 + wave * 16 + q) * NPROJ + 2048 + lane * 8);
#pragma unroll 1
        for (int tb = 0; tb < 16; tb += 4) {
            v4u raw4[4];
#pragma unroll
            for (int q = 0; q < 4; ++q) raw4[q] = rawn[q];
            if (tb + 4 < 16) {
#pragma unroll
                for (int q = 0; q < 4; ++q) rawn[q] = *(const GAS v4u*)(PROJ + (row0 + wave * 16 + tb + 4 + q) * NPROJ + 2048 + lane * 8); }
#pragma unroll
            for (int q = 0; q < 4; ++q) { const int tt = tb + q; const v4u raw = raw4[q]; float v[8]; float s = 0.f;
#pragma unroll
                for (int i = 0; i < 4; ++i) {
#ifdef GELU_IN_PROJ
                    v[2 * i] = bflo(raw[i]); v[2 * i + 1] = bfhi(raw[i]);
#else
                    const pg8::f32x2 ge = pg8::gelu_pk((pg8::f32x2){bflo(raw[i]), bfhi(raw[i])}); v[2 * i] = ge.x; v[2 * i + 1] = ge.y;
#endif
                    s += v[2 * i] + v[2 * i + 1]; }
                const float mean = wave_sum(s) * (1.0f / 512.0f); float s2 = 0.f;
#pragma unroll
                for (int i = 0; i < 8; ++i) { v[i] -= mean; s2 += v[i] * v[i]; }
                const float rstd = 1.0f / sqrtf(wave_sum(s2) * (1.0f / 512.0f) + EPS);
                v4u o;
#pragma unroll
                for (int i = 0; i < 4; ++i) o[i] = pk2(v[2 * i] * rstd * gam[2 * i] + bet[2 * i], v[2 * i + 1] * rstd * gam[2 * i + 1] + bet[2 * i + 1]);
                *(LAS v4u*)(lds + RING_OFF + (((lane >> 3) * 2 + ((lane >> 2) & 1)) * 8 + wave) * 1024 + tt * 64 + (lane & 3) * 16) = o; } }
        __syncthreads();
        const int nks = (mi < 2) ? 4 : 8;
        const LAS unsigned char* vb = lds + RING_OFF + ((lane >> 4) & 1) * 32 + (lane & 3) * 8 + (4 * hi + ((lane & 15) >> 2)) * 64;
        const int tokr = mi * 32 + r32;
        bf16x8 wfA[8], wfB[8]; v2u urA[4], urB[4]; float biasA = 0.f, biasB = 0.f;
#define GM_LOAD(g_, W_, U_, B_) do { const bf16* wrow_ = GW + ((size_t)(g_) * 128 + mi * 32 + r32) * 128 + hi * 8; \
            _Pragma("unroll") for (int ks = 0; ks < 8; ++ks) W_[ks] = *(const GAS bf16x8*)(wrow_ + ks * 16);     \
            const bf16* up_ = PROJ + (row0 + tokr) * NPROJ + 1536 + (g_) * 64 + ci * 32 + 4 * hi; \
            _Pragma("unroll") for (int gg = 0; gg < 4; ++gg) U_[gg] = *(const GAS v2u*)(up_ + 8 * gg); \
            B_ = bsp[(g_) * 128 + tokr]; } while (0)
#define GM_COMP(g_, W_, U_, B_) do { f32x16 acc; _Pragma("unroll") for (int i = 0; i < 16; ++i) acc[i] = 0.f; \
            _Pragma("unroll") for (int ks = 0; ks < 8; ++ks) if (ks < nks) { const LAS unsigned char* vp = vb + (((g_) * 2 + ci) * 8 + ks) * 1024; \
                const sba::s16x4 lo = sba::vtr(vp), hh = sba::vtr(vp + 512); const bf16x8 vf = (bf16x8){lo[0], lo[1], lo[2], lo[3], hh[0], hh[1], hh[2], hh[3]}; \
                acc = __builtin_amdgcn_mfma_f32_32x32x16_bf16(vf, W_[ks], acc, 0, 0, 0); } \
            bf16* op = MIX + (row0 + tokr) * D + 512 + (g_) * 64 + ci * 32 + 4 * hi; \
            _Pragma("unroll") for (int gg = 0; gg < 4; ++gg) { const v2u ur = U_[gg]; \
                const pg8::f32x2 ga = pg8::gelu_pk((pg8::f32x2){bflo(ur.x), bfhi(ur.x)}), gb = pg8::gelu_pk((pg8::f32x2){bflo(ur.y), bfhi(ur.y)}); \
                v2u o; o.x = pk2((acc[4 * gg] + B_) * ga.x, (acc[4 * gg + 1] + B_) * ga.y); o.y = pk2((acc[4 * gg + 2] + B_) * gb.x, (acc[4 * gg + 3] + B_) * gb.y); \
                *(GAS v2u*)(op + 8 * gg) = o; } } while (0)
        GM_LOAD(0, wfA, urA, biasA);
#pragma unroll 1
        for (int g = 0; g < 8; g += 2) {
            GM_LOAD(g + 1, wfB, urB, biasB);
            GM_COMP(g, wfA, urA, biasA);
            { const int g2 = (g + 2 < 8) ? g + 2 : 0; GM_LOAD(g2, wfA, urA, biasA); }
            GM_COMP(g + 1, wfB, urB, biasB);
        }
#undef GM_LOAD
#undef GM_COMP
    }
    __syncthreads();
}
__device__ __forceinline__ void moe_tables(const int* pcnt, LAS int* MT, LAS int* stage  , int p, int tid, bool first) {
    __syncthreads();
    if (first) { for (int i = tid; i < 4096; i += NWAVES * 64) stage[i] = pcnt[i]; }
    __syncthreads();
    if (tid < 16) { LAS int* M = MT + (tid >> 3) * MT_STRIDE; const int ee = tid & 7; int sacc = 0, pb = 0;
#pragma unroll 16
        for (int q = 0; q < 256; ++q) { if (q == p) pb = sacc; sacc += stage[q * 16 + tid]; }
        M[MT_TOT + ee] = sacc; M[MT_PBASE + ee] = pb; }
    __syncthreads();
    if (first) {
        if (tid == 0 || tid == 64) { LAS int* M = MT + (tid >> 6) * MT_STRIDE; int o = 0;
            for (int e = 0; e < 8; ++e) { M[MT_POFF + e] = o; o += ((M[MT_TOT + e] + 255) >> 8) << 8; }
            M[MT_POFF + 8] = o; M[MT_NT] = o >> 8; }
        __syncthreads();
#pragma unroll
        for (int k = 0; k < 2; ++k) { LAS int* M = MT + k * MT_STRIDE; LAS unsigned char* tile_e = (LAS unsigned char*)(M + MT_TILE); const int nt = M[MT_NT];
            for (int t = tid; t < nt; t += NWAVES * 64) { const int r = t * 256; int e = 0;
#pragma unroll
                for (int ee = 1; ee < 8; ++ee) if (r >= M[MT_POFF + ee]) e = ee;
                tile_e[t] = (unsigned char)e; } }
        __syncthreads();
    }
}
__device__ __forceinline__ void moe_gather2(const bf16* HB, unsigned char* XS, const int* pcnt, const int* tok_e, const int* tok_rank, const float* tok_gate, int* slot_tok, float* slot_gate,
                                            LAS int* MT, LAS unsigned char* lds, int blk, int G) {
    PHASE_IDS();
    LAS int* stage = (LAS int*)(lds + RING_OFF);
    moe_tables(pcnt, MT, stage, blk < T / 256 ? blk : 0, tid, true);
    if (blk == 0) {
        for (int k = 0; k < 2; ++k) { LAS int* M = MT + k * MT_STRIDE;
            for (int e = 0; e < 8; ++e) for (int s = M[MT_POFF + e] + M[MT_TOT + e] + tid; s < M[MT_POFF + e + 1]; s += NWAVES * 64) slot_tok[k * MAXTILES * 256 + s] = -1; }
    }
    for (int p = blk; p < T / 256; p += G) {
        if (p != blk) moe_tables(pcnt, MT, stage, p, tid, false);
        int myslot;
        { const int tj = p * 256 + (lane >> 1) * 8 + wave  , kj = lane & 1; const LAS int* M = MT + kj * MT_STRIDE;
          const int e = tok_e[tj * 2 + kj]; const int rk = tok_rank[tj * 2 + kj]; const float gt = tok_gate[tj * 2 + kj];
          myslot = kj * MAXTILES * 256 + M[MT_POFF + e] + M[MT_PBASE + e] + rk;
          slot_tok[myslot] = tj; slot_gate[myslot] = gt; }
#pragma unroll
        for (int r0 = 0; r0 < 32; r0 += 16) {
            v4u rowv[16];
#pragma unroll
            for (int q = 0; q < 16; ++q) rowv[q] = ((const GAS v4u*)((const unsigned char*)HB + (size_t)(p * 256 + (r0 + q) * 8 + wave) * D))[lane];
#pragma unroll
            for (int q = 0; q < 16; ++q) { const int sa = __shfl(myslot, 2 * (r0 + q)), sb = __shfl(myslot, 2 * (r0 + q) + 1);
                ((GAS v4u*)(XS + (size_t)sa * D))[lane] = rowv[q]; ((GAS v4u*)(XS + (size_t)sb * D))[lane] = rowv[q]; }
        }
    }
    __syncthreads();
}

template <bool OUT_F32>
__device__ __forceinline__ void moe_tail_combine(int k, const float* S, const bf16* xb, bf16* xbo, float* xf, const float* gate, const int* slot_tok, const float* slot_gate, LAS int* MT, int nsl, int blk, int G) {
    PHASE_IDS();
    const int ntk = MT[k * MT_STRIDE + MT_NT]; const int nwg = ntk * (D / 256); int full = (nwg / G) * G, ntail = nwg - full;
    if (ntail > 32) { full = nwg; ntail = 0; }
    pg8::StaticOrder SO; SO.init(ntk * 256, D, G, 0);
    const int gw = blk * NWAVES + wave, NGW = G * NWAVES;
    for (int idx = gw; idx < ntail * 256; idx += NGW) { const int q = idx >> 8, r = idx & 255;
        pg8::Unit u; SO.map(full + q, u); const int pmr = k * MAXTILES + u.pm;
        const int slot = pmr * 256 + r; const int tok = slot_tok[slot];
        if (tok < 0) continue;
        const float sg = slot_gate[slot]; const int col = u.pn * 256 + 4 * lane;
        f32x4 a = (f32x4){0.f, 0.f, 0.f, 0.f};
        for (int sl = 0; sl < nsl; ++sl) a += *(const f32x4*)(S + ((size_t)(q * nsl + sl) * 256 + r) * 256 + 4 * lane);
        const f32x4 g4 = *(const f32x4*)(gate + (size_t)(tok >> 11) * ADA + col);
        const v2u xw = *(const GAS v2u*)(xb + (size_t)tok * D + col);
        const f32x4 r4 = (f32x4){bflo(xw.x), bfhi(xw.x), bflo(xw.y), bfhi(xw.y)} + (g4 * sg) * a;
        if (OUT_F32) *(f32x4*)(xf + (size_t)tok * D + col) = r4;
        else { v2u o; o.x = pk2(r4[0], r4[1]); o.y = pk2(r4[2], r4[3]); *(GAS v2u*)(xbo + (size_t)tok * D + col) = o; } }
}

#ifndef SKIPMASK
#define SKIPMASK 0u
#endif
#define PH_ON(x) (((SKIPMASK) & (1u << (x))) == 0u)
#ifndef DBLMASK
#define DBLMASK 0u
#endif
#define PH_REP(x) for (int rep_ = 0; rep_ < ((((DBLMASK) >> (x)) & 1u) ? 2 : 1); ++rep_)
#define GRID_BAR() xcd_barrier(bar)
#define WS_() opaque_ptr(args.ws)
#define WG_SYNC() do { asm volatile("s_waitcnt vmcnt(0) lgkmcnt(0)" ::: "memory"); __syncthreads(); } while (0)
#ifndef PANEL_ORDER
typedef pg8::StaticOrder ChainOrder;
#define CHAIN_SYNC() GRID_BAR()
#else
typedef pg8::PanelOrder ChainOrder;
#define CHAIN_SYNC() WG_SYNC()
#endif
constexpr int MOE_NSL = 7, MOE_KSL = (DE / 2) / MOE_NSL;
__device__ __forceinline__ void moe_tail_split(int ntk, int G, int& full, int& ntail) { const int nwg = ntk * (D / 256); full = (nwg / G) * G; ntail = nwg - full; if (ntail > 32) { full = nwg; ntail = 0; } }
template <int K, int L>
__device__ __forceinline__ void moe_down_main(const Args& args, LAS unsigned char* lds, LAS int* MT, int blk, int G) {
    unsigned char* ws = WS_(); const int ntk = MT[K * MT_STRIDE + MT_NT]; int full, ntail; moe_tail_split(ntk, G, full, ntail);
    pg8::Gemm g{(const bf16*)(ws + WS_ACTM), (const bf16*)(ws + WS_MWD), ntk * 256, D, DE / 2, 0}; pg8::MoeOrder2L S; S.init(ntk * 256, D, G, blk);
    S.tile_e0 = (const LAS unsigned char*)(MT + MT_TILE); S.tile_e1 = (const LAS unsigned char*)(MT + MT_STRIDE + MT_TILE); S.ne_tiles = D / 256; S.nt0 = (K == 0) ? ntk : 0; S.base1 = MAXTILES; S.limit = full;
    pg8::EpiMoeDownB<(K == 1)> E{(const bf16*)(ws + WS_XB), (bf16*)(ws + WS_XB), args.out, (const bf16*)(ws + WS_G16), (const int*)(ws + WS_SLOTT), (const float*)(ws + WS_SLOTG)};
    pg8::gemm_phase<pg8::EpiMoeDownB<(K == 1)>, pg8::MoeOrder2L, true, true>(lds + RING_OFF, g, S, E);
}
template <int K>
__device__ __forceinline__ void moe_down_slices(const Args& args, LAS unsigned char* lds, LAS int* MT, int blk, int G) {
    unsigned char* ws2 = WS_(); const int ntk = MT[K * MT_STRIDE + MT_NT]; int full, ntail; moe_tail_split(ntk, G, full, ntail);
    if (ntail > 0) {
        pg8::Gemm g{(const bf16*)(ws2 + WS_ACTM), (const bf16*)(ws2 + WS_MWD), ntk * 256, D, MOE_KSL, DE / 2}; pg8::MoeTail2 S; S.init(ntk * 256, D, G, blk);
        S.tile_e0 = (const LAS unsigned char*)(MT + MT_TILE); S.tile_e1 = (const LAS unsigned char*)(MT + MT_STRIDE + MT_TILE); S.ne_tiles = D / 256; S.nt0 = (K == 0) ? ntk : 0; S.base1 = MAXTILES;
        S.base = full; S.ntail = ntail; S.nsl = MOE_NSL; S.ksl_bytes = MOE_KSL * 2;
        pg8::EpiTileF32F8 E{(float*)(ws2 + WS_XS) + (size_t)K * 32 * MOE_NSL * 65536};
        pg8::gemm_phase<pg8::EpiTileF32F8, pg8::MoeTail2, true, true>(lds + RING_OFF, g, S, E); }
}
template <int K, int L>
__device__ __forceinline__ void moe_down_combine(const Args& args, LAS int* MT, int blk, int G) {
    unsigned char* ws = WS_();
    moe_tail_combine<(K == 1)>(K, (const float*)(ws + WS_XS) + (size_t)K * 32 * MOE_NSL * 65536, (const bf16*)(ws + WS_XB), (bf16*)(ws + WS_XB), args.out,
                               (const float*)(ws + WS_ADA) + (size_t)L * 32 * ADA + 5 * D, (const int*)(ws + WS_SLOTT), (const float*)(ws + WS_SLOTG), MT, MOE_NSL, blk, G);
}
#define WS_() opaque_ptr(args.ws)
#define WG_SYNC() do { asm volatile("s_waitcnt vmcnt(0) lgkmcnt(0)" ::: "memory"); __syncthreads(); } while (0)
#ifndef PANEL_ORDER
typedef pg8::StaticOrder ChainOrder;
#define CHAIN_SYNC() GRID_BAR()
#else
typedef pg8::PanelOrder ChainOrder;
#define CHAIN_SYNC() WG_SYNC()
#endif
template <int K, int L>
__device__ __forceinline__ void moe_down_half(const Args& args, const XcdBarrier& bar, LAS unsigned char* lds, LAS int* MT, int blk, int G) {
    constexpr int NSL = 7, KSL = (DE / 2) / NSL;
    if (PH_ON(14)) { unsigned char* ws = WS_(); const int ntk = MT[K * MT_STRIDE + MT_NT];
      const int nwg = ntk * (D / 256); int full = (nwg / G) * G, ntail = nwg - full;
      if (ntail > 32) { full = nwg; ntail = 0; }
      { pg8::Gemm g{(const bf16*)(ws + WS_ACTM), (const bf16*)(ws + WS_MWD), ntk * 256, D, DE / 2, 0}; pg8::MoeOrder2L S; S.init(ntk * 256, D, G, blk);
        S.tile_e0 = (const LAS unsigned char*)(MT + MT_TILE); S.tile_e1 = (const LAS unsigned char*)(MT + MT_STRIDE + MT_TILE); S.ne_tiles = D / 256; S.nt0 = (K == 0) ? ntk : 0; S.base1 = MAXTILES; S.limit = full;
        pg8::EpiMoeDownB<(K == 1)> E{(const bf16*)(ws + WS_XB), (bf16*)(ws + WS_XB), args.out, (const bf16*)(ws + WS_G16), (const int*)(ws + WS_SLOTT), (const float*)(ws + WS_SLOTG)};
        pg8::gemm_phase<pg8::EpiMoeDownB<(K == 1)>, pg8::MoeOrder2L, true, true>(lds + RING_OFF, g, S, E); }
      if (ntail > 0) { unsigned char* ws2 = WS_();
        pg8::Gemm g{(const bf16*)(ws2 + WS_ACTM), (const bf16*)(ws2 + WS_MWD), ntk * 256, D, KSL, DE / 2}; pg8::MoeTail2 S; S.init(ntk * 256, D, G, blk);
        S.tile_e0 = (const LAS unsigned char*)(MT + MT_TILE); S.tile_e1 = (const LAS unsigned char*)(MT + MT_STRIDE + MT_TILE); S.ne_tiles = D / 256; S.nt0 = (K == 0) ? ntk : 0; S.base1 = MAXTILES;
        S.base = full; S.ntail = ntail; S.nsl = NSL; S.ksl_bytes = KSL * 2;
        pg8::EpiTileF32F8 E{(float*)(ws2 + WS_XS) + (size_t)K * 32 * NSL * 65536};
        pg8::gemm_phase<pg8::EpiTileF32F8, pg8::MoeTail2, true, true>(lds + RING_OFF, g, S, E); } }
    GRID_BAR();
    if (PH_ON(14)) { unsigned char* ws = WS_();
      moe_tail_combine<(K == 1)>(K, (const float*)(ws + WS_XS) + (size_t)K * 32 * NSL * 65536, (const bf16*)(ws + WS_XB), (bf16*)(ws + WS_XB), args.out,
                                 (const float*)(ws + WS_ADA) + (size_t)L * 32 * ADA + 5 * D, (const int*)(ws + WS_SLOTT), (const float*)(ws + WS_SLOTG), MT, NSL, blk, G); }
}
template <int L>
__device__ __forceinline__ void layer_body(const Args& args, const XcdBarrier& bar, LAS unsigned char* lds, int blk, int G) {
    LAS int* MT = (LAS int*)(lds + MOE_OFF);
    PH_REP(2) if (PH_ON(2)) { unsigned char* ws = WS_();
        if constexpr (L == 0) norm_phase<false>(args.in[0], args.in[4] + L * D, (const float*)(ws + WS_ADA) + (size_t)L * 32 * ADA, 1 * D, 0 * D, (bf16*)(ws + WS_HB),
                          nullptr, nullptr, nullptr, nullptr, nullptr, nullptr, lds, blk, G);
        else norm_phase<false, false, true>((const float*)(ws + WS_XB), args.in[4] + L * D, (const float*)(ws + WS_ADA) + (size_t)L * 32 * ADA, 1 * D, 0 * D, (bf16*)(ws + WS_HB),
                          nullptr, nullptr, nullptr, nullptr, nullptr, nullptr, lds, blk, G); }
    CHAIN_SYNC();
    PH_REP(3) if (PH_ON(3)) { unsigned char* ws = WS_();
      pg8::Gemm g{(const bf16*)(ws + WS_HB), (const bf16*)(ws + WS_WIN) + (size_t)L * NPROJ * D, T, NPROJ, D}; ChainOrder S; S.init(T, NPROJ, G, blk);
      pg8::EpiProjQK E{(bf16*)(ws + WS_BIG), args.in[7] + L * 64, args.in[8] + L * 64, C2, EPS};
      pg8::gemm_phase<pg8::EpiProjQK, ChainOrder, true, true>(lds + RING_OFF, g, S, E); }
    GRID_BAR();
    PH_REP(5) if (PH_ON(5)) { unsigned char* ws = WS_();
        sba::attn_phase((const bf16*)(ws + WS_BIG), (bf16*)(ws + WS_HB), lds, blk, G); }
    PH_REP(6) if (PH_ON(6)) { unsigned char* ws = WS_();
        gmlp_phase((const bf16*)(ws + WS_BIG), (bf16*)(ws + WS_HB), args.in[9] + L * 512, args.in[10] + L * 512, (const bf16*)(ws + WS_GW) + (size_t)L * 8 * 128 * 128, args.in[12] + L * 8 * 128, lds, blk, G); }
    GRID_BAR();
    if (PH_ON(7)) { unsigned char* ws = WS_();
      pg8::Gemm g{(const bf16*)(ws + WS_HB), (const bf16*)(ws + WS_WOUT) + (size_t)L * D * D, T, D, D}; ChainOrder S; S.init(T, D, G, blk);
      if constexpr (L == 0) { pg8::EpiResidB<true, false> E{(const void*)args.in[0], (bf16*)(ws + WS_XB), (const float*)(ws + WS_ADA) + (size_t)L * 32 * ADA + 2 * D};
        pg8::gemm_phase<pg8::EpiResidB<true, false>, ChainOrder, true, true>(lds + RING_OFF, g, S, E); }
      else { pg8::EpiResidB<false, false> E{(const void*)(ws + WS_XB), (bf16*)(ws + WS_XB), (const float*)(ws + WS_ADA) + (size_t)L * 32 * ADA + 2 * D};
        pg8::gemm_phase<pg8::EpiResidB<false, false>, ChainOrder, true, true>(lds + RING_OFF, g, S, E); } }
    CHAIN_SYNC();
    if constexpr (L == 0) {
        if (PH_ON(8)) { unsigned char* ws = WS_();
            norm_phase<false, (FFN_GU_FP8 != 0), true>((const float*)(ws + WS_XB), args.in[5] + L * D, (const float*)(ws + WS_ADA) + (size_t)L * 32 * ADA, 4 * D, 3 * D, (bf16*)(ws + WS_HB),
                              nullptr, nullptr, nullptr, nullptr, nullptr, nullptr, lds, blk, G); }
        CHAIN_SYNC();
        PH_REP(9) if (PH_ON(9)) { unsigned char* ws = WS_();
#if FFN_GU_FP8
          pg8::Gemm g{(const bf16*)(ws + WS_HB), (const bf16*)(ws + WS_WGU), T, 2 * FF, D / 2, 0}; ChainOrder S; S.init(T, 2 * FF, G, blk);
          typedef pg8::EpiSwigluX<true, (FFN_DOWN_FP8 != 0)> EpiGU; EpiGU E{ws + WS_ACT, FF};
          pg8::gemm_phase<EpiGU, ChainOrder, true, true>(lds + RING_OFF, g, S, E); }
#elif FFN_DOWN_FP8
          pg8::Gemm g{(const bf16*)(ws + WS_HB), (const bf16*)(ws + WS_WGU), T, 2 * FF, D}; ChainOrder S; S.init(T, 2 * FF, G, blk);
          pg8::EpiSwigluO8 E{ws + WS_ACT, FF};
          pg8::gemm_phase<pg8::EpiSwigluO8, ChainOrder, true, true>(lds + RING_OFF, g, S, E); }
#else
          pg8::Gemm g{(const bf16*)(ws + WS_HB), (const bf16*)(ws + WS_WGU), T, 2 * FF, D}; ChainOrder S; S.init(T, 2 * FF, G, blk);
          pg8::EpiSwiglu E{(bf16*)(ws + WS_ACT), FF};
          pg8::gemm_phase<pg8::EpiSwiglu, ChainOrder, true, true>(lds + RING_OFF, g, S, E); }
#endif
        CHAIN_SYNC();
        if (PH_ON(10)) { unsigned char* ws = WS_();
#if FFN_DOWN_FP8
          pg8::Gemm g{(const bf16*)(ws + WS_ACT), (const bf16*)(ws + WS_WD), T, D, FF / 2, 0}; ChainOrder S; S.init(T, D, G, blk);
          pg8::EpiResidB<false, true> E{(const void*)(ws + WS_XB), (bf16*)(ws + WS_XB), (const float*)(ws + WS_ADA) + (size_t)L * 32 * ADA + 5 * D};
          pg8::gemm_phase<pg8::EpiResidB<false, true>, ChainOrder, true, true>(lds + RING_OFF, g, S, E); }
#else
          pg8::Gemm g{(const bf16*)(ws + WS_ACT), (const bf16*)(ws + WS_WD), T, D, FF}; ChainOrder S; S.init(T, D, G, blk);
          pg8::EpiResidB<false, false> E{(const void*)(ws + WS_XB), (bf16*)(ws + WS_XB), (const float*)(ws + WS_ADA) + (size_t)L * 32 * ADA + 5 * D};
          pg8::gemm_phase<pg8::EpiResidB<false, false>, ChainOrder, true, true>(lds + RING_OFF, g, S, E); }
#endif
        CHAIN_SYNC();
    } else {
        PH_REP(11) if (PH_ON(11)) { unsigned char* ws = WS_();
            norm_phase<true, true, true>((const float*)(ws + WS_XB), args.in[5] + L * D, (const float*)(ws + WS_ADA) + (size_t)L * 32 * ADA, 4 * D, 3 * D, (bf16*)(ws + WS_HB), args.in[17], args.in[18],
                             (int*)(ws + WS_PCNT), (int*)(ws + WS_TOKE), (int*)(ws + WS_TOKR), (float*)(ws + WS_TOKG), lds, blk, G); }
        GRID_BAR();
        PH_REP(12) if (PH_ON(12)) { unsigned char* ws = WS_();
            moe_gather2((const bf16*)(ws + WS_HB), ws + WS_XS, (const int*)(ws + WS_PCNT), (const int*)(ws + WS_TOKE), (const int*)(ws + WS_TOKR), (const float*)(ws + WS_TOKG),
                        (int*)(ws + WS_SLOTT), (float*)(ws + WS_SLOTG), MT, lds, blk, G); }
        GRID_BAR();
        PH_REP(13) if (PH_ON(13)) { unsigned char* ws = WS_(); const int nt0 = MT[MT_NT], nt1 = MT[MT_STRIDE + MT_NT];
          pg8::Gemm g{(const bf16*)(ws + WS_XS), (const bf16*)(ws + WS_MWGU), (nt0 + nt1) * 256, 2 * DE, D / 2, 0}; pg8::MoeOrder2 S; S.init((nt0 + nt1) * 256, 2 * DE, G, blk);
          S.tile_e0 = (const LAS unsigned char*)(MT + MT_TILE); S.tile_e1 = (const LAS unsigned char*)(MT + MT_STRIDE + MT_TILE); S.ne_tiles = 2 * DE / 256; S.nt0 = nt0; S.base1 = MAXTILES;
          pg8::EpiSwigluF8 E{ws + WS_ACTM, DE};
          pg8::gemm_phase<pg8::EpiSwigluF8, pg8::MoeOrder2, true, true>(lds + RING_OFF, g, S, E); }
        GRID_BAR();
        if (PH_ON(14)) { moe_down_main<0, L>(args, lds, MT, blk, G); moe_down_slices<0>(args, lds, MT, blk, G); moe_down_slices<1>(args, lds, MT, blk, G); }
        GRID_BAR();
        if (PH_ON(14)) moe_down_combine<0, L>(args, MT, blk, G);
        GRID_BAR();
        if (PH_ON(14)) { moe_down_main<1, L>(args, lds, MT, blk, G); moe_down_combine<1, L>(args, MT, blk, G); }
    }
}
__global__ void __launch_bounds__(NWAVES * 64, 2) mk_fwd(const Args args) {
    extern __shared__ __attribute__((aligned(16))) unsigned char lds_raw[];
    LAS unsigned char* lds = (LAS unsigned char*)lds_raw;
    volatile LAS unsigned* MISC = (volatile LAS unsigned*)(lds + MISC_OFF);
    const int G = gridDim.x, blk = blockIdx.x;
    for (int u = threadIdx.x; u < (LDS_BYTES - LDSCTL_OFF) / 4; u += NWAVES * 64) ((LAS unsigned*)(lds + LDSCTL_OFF))[u] = 0u;
    __syncthreads();
    const XcdBarrier bar = xcd_barrier_post((unsigned*)(args.ws + WS_CTL) + CW_BAR, MISC + 8);
    PH_REP(0) if (PH_ON(0)) p0_ada(args, lds, blk, G);
    PH_REP(1) if (PH_ON(1)) p0_transposes(args, lds, blk, G);
    if (PH_ON(1)) p0_spatial(args, blk, G);
    GRID_BAR();
#ifdef PROBE_BARS
    for (int i_ = 0; i_ < PROBE_BARS; ++i_) GRID_BAR();
#endif
    layer_body<0>(args, bar, lds, blk, G);
    layer_body<1>(args, bar, lds, blk, G);
}

extern "C" void kernel_launch(void* const* d_in, const int* in_sizes, int n_in, void* d_out, int out_size, void* d_ws, size_t ws_size, hipStream_t stream) {
    static int grid = 0;
    if (grid == 0) {
        if (n_in != 22 || in_sizes[0] != T * D || out_size != T * D || ws_size < WS_END) {
            fprintf(stderr, "kernel_launch: built for 22 inputs, x/out of %d floats, >= %zu bytes of workspace; got n_in %d, in0 %d, out %d, ws %zu; nothing launched\n", T * D, (size_t)WS_END, n_in, n_in > 0 ? in_sizes[0] : -1, out_size, ws_size);
            grid = -1; return; }
        int dev = 0, cus = 0, per_cu = 0;
        if (hipGetDevice(&dev) != hipSuccess || hipDeviceGetAttribute(&cus, hipDeviceAttributeMultiprocessorCount, dev) != hipSuccess) { fprintf(stderr, "kernel_launch: device query failed\n"); grid = -1; return; }
        if (hipFuncSetAttribute((const void*)mk_fwd, hipFuncAttributeMaxDynamicSharedMemorySize, LDS_BYTES) != hipSuccess) { fprintf(stderr, "kernel_launch: hipFuncSetAttribute failed\n"); grid = -1; return; }
        if (hipOccupancyMaxActiveBlocksPerMultiprocessor(&per_cu, (const void*)mk_fwd, NWAVES * 64, LDS_BYTES) != hipSuccess || per_cu < 1)
            fprintf(stderr, "kernel_launch: note: occupancy query reports %d workgroups per CU\n", per_cu);
        (void)hipGetLastError();
        grid = cus;
    }
    if (grid < 0) return;
    if (hipMemsetAsync((char*)d_ws + WS_CTL, 0, CTL_ZERO_BYTES, stream) != hipSuccess) { fprintf(stderr, "kernel_launch: memset failed\n"); return; }
    Args a{};
    for (int i = 0; i < 22; ++i) a.in[i] = (const float*)d_in[i];
    a.out = (float*)d_out; a.ws = (unsigned char*)d_ws;
    hipLaunchKernelGGL(mk_fwd, dim3(grid), dim3(NWAVES * 64), LDS_BYTES, stream, a);
    const hipError_t le = hipPeekAtLastError();
    if (le != hipSuccess) fprintf(stderr, "kernel_launch: launch failed: %s\n", hipGetErrorName(le));
}
```

```cpp
#ifndef FFN_GU_FP8
#define FFN_GU_FP8 0
#endif
#ifndef FFN_DOWN_FP8
#define FFN_DOWN_FP8 1
#endif
#include <hip/hip_runtime.h>
#include <cstdio>
#include <cstdint>
namespace pg8 {
#define PG8_LAS __attribute__((address_space(3)))
typedef unsigned short bf16_t;
typedef short bf16x8 __attribute__((ext_vector_type(8)));
typedef float f32x4 __attribute__((ext_vector_type(4)));
typedef unsigned u32x4 __attribute__((ext_vector_type(4)));
constexpr int BM = 256, BK = 64, HALF = 128, HTB = HALF * BK * 2  , STAGE_BYTES = 8 * HTB, NXCD = 8, WGM = 8;

__host__ __device__ __forceinline__ int lds_byte(int r, int c) { const int st = (r >> 4) * 2 + (c >> 5), rr = r & 15, cc = c & 31, ob = rr * 64 + cc * 2; return st * 1024 + (ob ^ (((ob >> 9) & 1) << 5)); }
__host__ __device__ __forceinline__ void stage_rc(int b, int& R, int& C) { const int st = b / 1024, sb = b % 1024, swz = sb ^ (((sb >> 9) & 1) << 5); R = (st >> 1) * 16 + swz / 64; C = (st & 1) * 32 + (swz % 64) / 2; }
__host__ __device__ __forceinline__ int perm32(int rho) { const int n = rho >> 4, i = rho & 15; return 8 * (i >> 2) + 4 * n + (i & 3); }

typedef int i32x8 __attribute__((ext_vector_type(8)));
typedef int i32x4 __attribute__((ext_vector_type(4)));
__device__ __forceinline__ i32x8 cat8(bf16x8 lo, bf16x8 hi) { const i32x4 a = __builtin_bit_cast(i32x4, lo), b = __builtin_bit_cast(i32x4, hi); return __builtin_shufflevector(a, b, 0, 1, 2, 3, 4, 5, 6, 7); }
__device__ __forceinline__ void glds16s(const void* sbase, unsigned voff, unsigned lds_dst) { unsigned keep;
    asm volatile("s_mov_b32 %0, m0\n\ts_mov_b32 m0, %3\n\ts_nop 0\n\tglobal_load_lds_dwordx4 %1, %2\n\ts_mov_b32 m0, %0" : "=&s"(keep) : "v"(voff), "s"(sbase), "s"(lds_dst) : "memory"); }
__device__ __forceinline__ void mfma_f8(f32x4& acc, const i32x8 a, const i32x8 b, const int sa, const int sb) {
    asm volatile("v_mfma_scale_f32_16x16x128_f8f6f4 %0, %1, %2, %0, %3, %4 op_sel_hi:[0,0,0]" : "+v"(acc) : "v"(a), "v"(b), "v"(sa), "v"(sb)); }
__device__ __forceinline__ void mfma_f8_z(f32x4& acc, const i32x8 a, const i32x8 b, const int sa, const int sb) {
    asm volatile("v_mfma_scale_f32_16x16x128_f8f6f4 %0, %1, %2, 0, %3, %4 op_sel_hi:[0,0,0]" : "=&v"(acc) : "v"(a), "v"(b), "v"(sa), "v"(sb)); }
__device__ __forceinline__ void mfma_bf16(f32x4& acc, const bf16x8 a, const bf16x8 b) { asm volatile("v_mfma_f32_16x16x32_bf16 %0, %1, %2, %0" : "+v"(acc) : "v"(a), "v"(b)); }
__device__ __forceinline__ void mfma_bf16_z(f32x4& acc, const bf16x8 a, const bf16x8 b) { asm volatile("v_mfma_f32_16x16x32_bf16 %0, %1, %2, 0" : "=&v"(acc) : "v"(a), "v"(b)); }
struct Unit { int pm, pn, bn, skip, kofs; };
struct Gemm { const bf16_t* A; const bf16_t* Bt; int M, N, K, ld; };

struct StaticOrder {
    int nM, nN, nwg, G, c;
    __host__ __device__ void init(int M, int N, int G_, int c_) { nM = M / BM; nN = N / BM; nwg = nM * nN; G = G_; c = c_; }
    __host__ __device__ bool next(int i, Unit& u) const {
        const long L = (long)i * G + c; if (L >= nwg) return false;
        map((int)L, u); return true;
    }
    __host__ __device__ void map(int L, Unit& u) const {
        int wgid = L; { const int q = nwg / NXCD, r = nwg % NXCD, xcd = wgid % NXCD, off = wgid / NXCD; wgid = (xcd < r ? xcd * (q + 1) : r * (q + 1) + (xcd - r) * q) + off; }
        const int nig = WGM * nN, gid = wgid / nig, fm = gid * WGM, gsz = (nM - fm) < WGM ? (nM - fm) : WGM;
        u.pm = fm + ((wgid % nig) % gsz); u.pn = (wgid % nig) / gsz; u.bn = u.pn; u.skip = 0; u.kofs = 0;
    }
    __device__ __forceinline__ void a_ready(const Unit&) const {}
    __device__ __forceinline__ void done(const Unit&) const {}
};

__device__ __forceinline__ unsigned cvt_pk_bf16(float lo, float hi) { unsigned r; asm volatile("v_cvt_pk_bf16_f32 %0, %1, %2" : "=v"(r) : "v"(lo), "v"(hi)); return r; }
typedef float f32x2 __attribute__((ext_vector_type(2)));
__device__ __forceinline__ f32x2 gelu_pk(f32x2 v) {
    const f32x2 av = __builtin_elementwise_abs(v), d = av * 0.2316418882f + 1.0f;
    f32x2 t; t.x = __builtin_amdgcn_rcpf(d.x); t.y = __builtin_amdgcn_rcpf(d.y);
    f32x2 q = t * 0.5307027145f + (-0.7265760135f); q = q * t + 0.7107068705f; q = q * t + (-0.142248368f); q = q * t + 0.127414796f; q = q * t;
    const f32x2 s = (v * v) * (-0.72134752044f);
    f32x2 e; e.x = __builtin_amdgcn_exp2f(s.x); e.y = __builtin_amdgcn_exp2f(s.y);
    const f32x2 m = v * (q * e), r = v - m;
    f32x2 o; o.x = v.x < 0.f ? m.x : r.x; o.y = v.y < 0.f ? m.y : r.y; return o;
}


__device__ __forceinline__ void store_bf16x8(bf16_t* p, const f32x4 v0, const f32x4 v1) {
    u32x4 w; w.x = cvt_pk_bf16(v0[0], v0[1]); w.y = cvt_pk_bf16(v0[2], v0[3]); w.z = cvt_pk_bf16(v1[0], v1[1]); w.w = cvt_pk_bf16(v1[2], v1[3]); *(u32x4*)p = w;
}
__device__ __forceinline__ f32x4 gelu4(const f32x4 v) { const f32x2 a = gelu_pk((f32x2){v[0], v[1]}), b = gelu_pk((f32x2){v[2], v[3]}); return (f32x4){a.x, a.y, b.x, b.y}; }
__device__ __forceinline__ float silu_mul(float g, float u) { return g * u * __builtin_amdgcn_rcpf(1.0f + __builtin_amdgcn_exp2f(-1.4426950408889634f * g)); }
typedef float f32x2 __attribute__((ext_vector_type(2)));
__device__ __forceinline__ f32x4 swiglu4(const f32x4 g, const f32x4 u) {
    const f32x2 ga = {g[0], g[1]}, gb = {g[2], g[3]}, ua = {u[0], u[1]}, ub = {u[2], u[3]};
    const f32x2 ea = {__builtin_amdgcn_exp2f(-ga.x), __builtin_amdgcn_exp2f(-ga.y)}, eb = {__builtin_amdgcn_exp2f(-gb.x), __builtin_amdgcn_exp2f(-gb.y)};
    const f32x2 da = ea + 1.0f, db = eb + 1.0f;
    const f32x2 ra = {__builtin_amdgcn_rcpf(da.x), __builtin_amdgcn_rcpf(da.y)}, rb = {__builtin_amdgcn_rcpf(db.x), __builtin_amdgcn_rcpf(db.y)};
    const f32x2 oa = (ga * ua) * ra, ob = (gb * ub) * rb;
    return (f32x4){oa.x, oa.y, ob.x, ob.y};
}

struct EpiProj {
    static constexpr bool PERM = true, AFTER_DRAIN = false, IDEMP = true; static constexpr int BMODE = 0; static constexpr bool FP8 = false;
    bf16_t* O;
    __device__ __forceinline__ void operator()(const f32x4 (&acc)[2][2][4][2], const Unit& u, int wr, int wc, int fr, int fq) const {
        if (u.skip) return;
        const int row0 = u.pm * BM + wr * 64 + fr, col0 = u.pn * BM + wc * 32 + 8 * fq; const bool act = u.pn >= 6;
#pragma unroll
        for (int ai = 0; ai < 2; ++ai)
#pragma unroll
            for (int m = 0; m < 4; ++m) { bf16_t* rowp = O + (size_t)(row0 + ai * HALF + m * 16) * 2560 + col0;
#pragma unroll
                for (int bj = 0; bj < 2; ++bj) { f32x4 v0 = acc[ai][bj][m][0], v1 = acc[ai][bj][m][1];
                    if (act) { v0 = gelu4(v0); v1 = gelu4(v1); }
                    store_bf16x8(rowp + bj * HALF, v0, v1);
#ifdef DUPSTORE
                    store_bf16x8(rowp + bj * HALF + (size_t)160 * 1024 * 1024, v0, v1);
#endif
                    } }
    }
};
struct EpiProjQK {
    static constexpr bool PERM = true, AFTER_DRAIN = false, IDEMP = true; static constexpr int BMODE = 1; static constexpr bool FP8 = false;
    bf16_t* O; const float* qg; const float* kg; float qscale; float eps;
    __device__ __forceinline__ void operator()(const f32x4 (&acc)[2][2][4][2], const Unit& u, int wr, int wc, int fr, int fq) const {
        const int row0 = u.pm * BM + wr * 64 + fr, col0 = u.pn * BM + wc * 64 + 8 * fq; const int kind = u.pn >> 1;
        if (kind < 2) {
            const float* gp = (kind == 0 ? qg : kg) + 8 * fq; const float gs = (kind == 0) ? qscale : 1.0f;
            f32x4 gv[2][2];
#pragma unroll
            for (int bj = 0; bj < 2; ++bj)
#pragma unroll
                for (int n = 0; n < 2; ++n) gv[bj][n] = *(const f32x4*)(gp + 32 * bj + 4 * n) * gs;
#pragma unroll
            for (int ai = 0; ai < 2; ++ai)
#pragma unroll
                for (int m = 0; m < 4; ++m) { float ss = 0.f;
#pragma unroll
                    for (int bj = 0; bj < 2; ++bj)
#pragma unroll
                        for (int n = 0; n < 2; ++n) { const f32x4 v = acc[ai][bj][m][n]; ss += (v[0] * v[0] + v[1] * v[1]) + (v[2] * v[2] + v[3] * v[3]); }
                    ss += __shfl_xor(ss, 16); ss += __shfl_xor(ss, 32);
                    const float rs = __builtin_amdgcn_rsqf(ss * (1.0f / 64.0f) + eps);
                    bf16_t* rowp = O + (size_t)(row0 + ai * HALF + m * 16) * 2560 + col0;
#pragma unroll
                    for (int bj = 0; bj < 2; ++bj) store_bf16x8(rowp + 32 * bj, acc[ai][bj][m][0] * rs * gv[bj][0], acc[ai][bj][m][1] * rs * gv[bj][1]); }
        } else {
#ifdef GELU_IN_PROJ
            const bool act = kind >= 3;
#else
            constexpr bool act = false;
#endif
#pragma unroll
            for (int ai = 0; ai < 2; ++ai)
#pragma unroll
                for (int m = 0; m < 4; ++m) { bf16_t* rowp = O + (size_t)(row0 + ai * HALF + m * 16) * 2560 + col0;
#pragma unroll
                    for (int bj = 0; bj < 2; ++bj) { f32x4 v0 = acc[ai][bj][m][0], v1 = acc[ai][bj][m][1];
                        if (act) { v0 = gelu4(v0); v1 = gelu4(v1); }
                        store_bf16x8(rowp + 32 * bj, v0, v1); } }
        }
    }
};
struct EpiResid {
    static constexpr bool PERM = false, AFTER_DRAIN = false, IDEMP = false; static constexpr int BMODE = 0; static constexpr bool FP8 = false;
    const float* xin; float* xout; const float* gate;
    __device__ __forceinline__ void operator()(const f32x4 (&acc)[2][2][4][2], const Unit& u, int wr, int wc, int fr, int fq) const {
        const int row0 = u.pm * BM + wr * 64 + fr, col0 = u.pn * BM + wc * 32 + 4 * fq;
        const float* gp = gate + (size_t)(u.pm >> 3) * 6144 + col0;
        f32x4 gv[2][2];
#pragma unroll
        for (int bj = 0; bj < 2; ++bj)
#pragma unroll
            for (int n = 0; n < 2; ++n) gv[bj][n] = *(const f32x4*)(gp + bj * HALF + n * 16);
#pragma unroll
        for (int ai = 0; ai < 2; ++ai) {
            f32x4 xi[4][2][2];
#pragma unroll
            for (int m = 0; m < 4; ++m) { const size_t off = (size_t)(row0 + ai * HALF + m * 16) * 1024 + col0;
#pragma unroll
                for (int bj = 0; bj < 2; ++bj)
#pragma unroll
                    for (int n = 0; n < 2; ++n) xi[m][bj][n] = *(const f32x4*)(xin + off + bj * HALF + n * 16); }
            asm volatile("" ::: "memory");
#pragma unroll
            for (int m = 0; m < 4; ++m) { const size_t off = (size_t)(row0 + ai * HALF + m * 16) * 1024 + col0;
#pragma unroll
                for (int bj = 0; bj < 2; ++bj)
#pragma unroll
                    for (int n = 0; n < 2; ++n) *(f32x4*)(xout + off + bj * HALF + n * 16) = xi[m][bj][n] + gv[bj][n] * acc[ai][bj][m][n]; }
            asm volatile("" ::: "memory");
        }
    }
};
struct EpiSwiglu {
    static constexpr bool PERM = true, AFTER_DRAIN = false, IDEMP = true; static constexpr int BMODE = 0; static constexpr bool FP8 = false;
    bf16_t* O; int ldc;
    __device__ __forceinline__ void operator()(const f32x4 (&acc)[2][2][4][2], const Unit& u, int wr, int wc, int fr, int fq) const {
        const int row0 = u.pm * BM + wr * 64 + fr, col0 = u.pn * HALF + wc * 32 + 8 * fq;
#pragma unroll
        for (int ai = 0; ai < 2; ++ai)
#pragma unroll
            for (int m = 0; m < 4; ++m) { bf16_t* rowp = O + (size_t)(row0 + ai * HALF + m * 16) * ldc + col0;
                const f32x4 g0 = acc[ai][0][m][0], g1 = acc[ai][0][m][1], u0 = acc[ai][1][m][0], u1 = acc[ai][1][m][1];
                const f32x4 r0 = swiglu4(g0, u0), r1 = swiglu4(g1, u1);
                store_bf16x8(rowp, r0, r1); }
    }
};
__device__ __forceinline__ unsigned pk4_fp8(const f32x4 v) {
    int p = 0;
    p = __builtin_amdgcn_cvt_pk_fp8_f32(__builtin_amdgcn_fmed3f(v[0], -448.f, 448.f), __builtin_amdgcn_fmed3f(v[1], -448.f, 448.f), p, false);
    p = __builtin_amdgcn_cvt_pk_fp8_f32(__builtin_amdgcn_fmed3f(v[2], -448.f, 448.f), __builtin_amdgcn_fmed3f(v[3], -448.f, 448.f), p, true);
    return (unsigned)p;
}
struct EpiSwigluF8 {
    static constexpr bool PERM = true, AFTER_DRAIN = false, IDEMP = true; static constexpr int BMODE = 0; static constexpr bool FP8 = true;
    unsigned char* O; int ldc;
    __device__ __forceinline__ void operator()(const f32x4 (&acc)[2][2][4][2], const Unit& u, int wr, int wc, int fr, int fq) const {
        const int row0 = u.pm * BM + wr * 64 + fr, col0 = u.pn * HALF + wc * 32 + 8 * fq;
#pragma unroll
        for (int ai = 0; ai < 2; ++ai)
#pragma unroll
            for (int m = 0; m < 4; ++m) { unsigned char* rowp = O + (size_t)(row0 + ai * HALF + m * 16) * ldc + col0;
                const f32x4 g0 = acc[ai][0][m][0], g1 = acc[ai][0][m][1], u0 = acc[ai][1][m][0], u1 = acc[ai][1][m][1];
                const f32x4 r0 = swiglu4(g0, u0), r1 = swiglu4(g1, u1);
                typedef unsigned u32x2 __attribute__((ext_vector_type(2)));
                u32x2 w; w.x = pk4_fp8(r0); w.y = pk4_fp8(r1); *(u32x2*)rowp = w; }
    }
};
template <bool KF8, bool OF8>
struct EpiSwigluX {
    static constexpr bool PERM = true, AFTER_DRAIN = false, IDEMP = true; static constexpr int BMODE = 0; static constexpr bool FP8 = KF8;
    unsigned char* O; int ldc;
    __device__ __forceinline__ void operator()(const f32x4 (&acc)[2][2][4][2], const Unit& u, int wr, int wc, int fr, int fq) const {
        const int row0 = u.pm * BM + wr * 64 + fr, col0 = u.pn * HALF + wc * 32 + 8 * fq;
#pragma unroll
        for (int ai = 0; ai < 2; ++ai)
#pragma unroll
            for (int m = 0; m < 4; ++m) { unsigned char* rowp = O + ((size_t)(row0 + ai * HALF + m * 16) * ldc + col0) * (OF8 ? 1 : 2);
                const f32x4 r0 = swiglu4(acc[ai][0][m][0], acc[ai][1][m][0]), r1 = swiglu4(acc[ai][0][m][1], acc[ai][1][m][1]);
                if constexpr (OF8) { typedef unsigned u32x2 __attribute__((ext_vector_type(2))); u32x2 w; w.x = pk4_fp8(r0); w.y = pk4_fp8(r1); *(u32x2*)rowp = w; }
                else store_bf16x8((bf16_t*)rowp, r0, r1); }
    }
};
struct EpiSwigluO8 {
    static constexpr bool PERM = true, AFTER_DRAIN = false, IDEMP = true; static constexpr int BMODE = 0; static constexpr bool FP8 = false;
    unsigned char* O; int ldc;
    __device__ __forceinline__ void operator()(const f32x4 (&acc)[2][2][4][2], const Unit& u, int wr, int wc, int fr, int fq) const {
        const int row0 = u.pm * BM + wr * 64 + fr, col0 = u.pn * HALF + wc * 32 + 8 * fq;
#pragma unroll
        for (int ai = 0; ai < 2; ++ai)
#pragma unroll
            for (int m = 0; m < 4; ++m) { unsigned char* rowp = O + (size_t)(row0 + ai * HALF + m * 16) * ldc + col0;
                const f32x4 r0 = swiglu4(acc[ai][0][m][0], acc[ai][1][m][0]), r1 = swiglu4(acc[ai][0][m][1], acc[ai][1][m][1]);
                typedef unsigned u32x2 __attribute__((ext_vector_type(2)));
                u32x2 w; w.x = pk4_fp8(r0); w.y = pk4_fp8(r1); *(u32x2*)rowp = w; }
    }
};
struct EpiMoeDown {
    static constexpr bool PERM = false, AFTER_DRAIN = false, IDEMP = false; static constexpr int BMODE = 0; static constexpr bool FP8 = false;
    float* x; const float* gate; const int* slot_tok; const float* slot_gate;
    __device__ __forceinline__ void operator()(const f32x4 (&acc)[2][2][4][2], const Unit& u, int wr, int wc, int fr, int fq) const {
        const int slot0 = u.pm * BM + wr * 64 + fr, col0 = u.pn * BM + wc * 32 + 4 * fq;
        int tok[2][4]; float sg[2][4];
#pragma unroll
        for (int ai = 0; ai < 2; ++ai)
#pragma unroll
            for (int m = 0; m < 4; ++m) { const int slot = slot0 + ai * HALF + m * 16; tok[ai][m] = slot_tok[slot]; sg[ai][m] = slot_gate[slot]; }
#pragma unroll
        for (int ai = 0; ai < 2; ++ai)
#pragma unroll
            for (int mp = 0; mp < 2; ++mp) {
                f32x4 gvv[2][2][2], xi[2][2][2];
#pragma unroll
                for (int q = 0; q < 2; ++q) { const int t = tok[ai][2 * mp + q], te = t < 0 ? 0 : t;
                    const float* gp = gate + (size_t)(te >> 11) * 6144 + col0; const float* xp = x + (size_t)te * 1024 + col0;
#pragma unroll
                    for (int bj = 0; bj < 2; ++bj)
#pragma unroll
                        for (int n = 0; n < 2; ++n) { gvv[q][bj][n] = *(const f32x4*)(gp + bj * HALF + n * 16); xi[q][bj][n] = *(const f32x4*)(xp + bj * HALF + n * 16); } }
                asm volatile("" ::: "memory");
#pragma unroll
                for (int q = 0; q < 2; ++q) { const int m = 2 * mp + q; const int t = tok[ai][m];
                    if (t >= 0) { float* xp = x + (size_t)t * 1024 + col0; const float g1 = sg[ai][m];
#pragma unroll
                        for (int bj = 0; bj < 2; ++bj)
#pragma unroll
                            for (int n = 0; n < 2; ++n) *(f32x4*)(xp + bj * HALF + n * 16) = xi[q][bj][n] + (gvv[q][bj][n] * g1) * acc[ai][bj][m][n]; } }
                asm volatile("" ::: "memory");
            }
    }
};
struct EpiMoeDownF8 : EpiMoeDown { static constexpr bool FP8 = true; };
struct EpiResidF8 : EpiResid { static constexpr bool FP8 = true; };
__device__ __forceinline__ void unpack_bf16x8(const u32x4 w, f32x4& a, f32x4& b) {
    a = (f32x4){__builtin_bit_cast(float, w.x << 16), __builtin_bit_cast(float, w.x & 0xffff0000u), __builtin_bit_cast(float, w.y << 16), __builtin_bit_cast(float, w.y & 0xffff0000u)};
    b = (f32x4){__builtin_bit_cast(float, w.z << 16), __builtin_bit_cast(float, w.z & 0xffff0000u), __builtin_bit_cast(float, w.w << 16), __builtin_bit_cast(float, w.w & 0xffff0000u)}; }
template <bool IN_F32, bool F8>
struct EpiResidB {
    static constexpr bool PERM = true, AFTER_DRAIN = false, IDEMP = false; static constexpr int BMODE = 0; static constexpr bool FP8 = F8;
    const void* xin; bf16_t* xout; const float* gate;
    __device__ __forceinline__ void operator()(const f32x4 (&acc)[2][2][4][2], const Unit& u, int wr, int wc, int fr, int fq) const {
        const int row0 = u.pm * BM + wr * 64 + fr, col0 = u.pn * BM + wc * 32 + 8 * fq;
        const float* gp = gate + (size_t)(u.pm >> 3) * 6144 + col0;
        f32x4 gv[2][2];
#pragma unroll
        for (int bj = 0; bj < 2; ++bj)
#pragma unroll
            for (int n = 0; n < 2; ++n) gv[bj][n] = *(const f32x4*)(gp + bj * HALF + n * 4);
        const unsigned e0 = (unsigned)row0 * 1024u + (unsigned)col0;
        if constexpr (!IN_F32) {
            u32x4 xw[2][4][2];
#define RB_EO(ai, m, bj) (e0 + (unsigned)(((ai) * HALF + (m) * 16) * 1024 + (bj) * HALF))
#define RB_LD(ai, m, bj) xw[ai][m][bj] = *(const u32x4*)((const char*)xin + (size_t)(RB_EO(ai, m, bj) * 2u))
#define RB_ST(ai, m, bj) do { f32x4 xa_, xc_; unpack_bf16x8(xw[ai][m][bj], xa_, xc_); \
                store_bf16x8((bf16_t*)((char*)xout + (size_t)(RB_EO(ai, m, bj) * 2u)), xa_ + gv[bj][0] * acc[ai][bj][m][0], xc_ + gv[bj][1] * acc[ai][bj][m][1]); } while (0)
#pragma unroll
            for (int m = 0; m < 4; ++m) { RB_LD(0, m, 0); RB_LD(0, m, 1); }
#pragma unroll
            for (int m = 0; m < 2; ++m) { RB_LD(1, m, 0); RB_LD(1, m, 1); }
            asm volatile("" ::: "memory");
#pragma unroll
            for (int m = 0; m < 2; ++m) { RB_ST(0, m, 0); RB_ST(0, m, 1); }
            asm volatile("" ::: "memory");
#pragma unroll
            for (int m = 2; m < 4; ++m) { RB_LD(1, m, 0); RB_LD(1, m, 1); }
            asm volatile("" ::: "memory");
#pragma unroll
            for (int m = 2; m < 4; ++m) { RB_ST(0, m, 0); RB_ST(0, m, 1); }
#pragma unroll
            for (int m = 0; m < 4; ++m) { RB_ST(1, m, 0); RB_ST(1, m, 1); }
            asm volatile("" ::: "memory");
#undef RB_EO
#undef RB_LD
#undef RB_ST
            return;
        }
#pragma unroll
        for (int ai = 0; ai < 2; ++ai) {
            f32x4 xa[4][2], xb2[4][2];
#pragma unroll
            for (int m = 0; m < 4; ++m)
#pragma unroll
                for (int bj = 0; bj < 2; ++bj) { const unsigned eo = e0 + (unsigned)((ai * HALF + m * 16) * 1024 + bj * HALF);
                    if (IN_F32) { xa[m][bj] = *(const f32x4*)((const char*)xin + (size_t)(eo * 4u)); xb2[m][bj] = *(const f32x4*)((const char*)xin + (size_t)(eo * 4u) + 16); }
                    else unpack_bf16x8(*(const u32x4*)((const char*)xin + (size_t)(eo * 2u)), xa[m][bj], xb2[m][bj]); }
            asm volatile("" ::: "memory");
#pragma unroll
            for (int m = 0; m < 4; ++m)
#pragma unroll
                for (int bj = 0; bj < 2; ++bj) { const unsigned eo = e0 + (unsigned)((ai * HALF + m * 16) * 1024 + bj * HALF);
                    store_bf16x8((bf16_t*)((char*)xout + (size_t)(eo * 2u)), xa[m][bj] + gv[bj][0] * acc[ai][bj][m][0], xb2[m][bj] + gv[bj][1] * acc[ai][bj][m][1]); }
            asm volatile("" ::: "memory");
        }
    }
};
template <bool OUT_F32>
struct EpiMoeDownB {
    static constexpr bool PERM = true, AFTER_DRAIN = false, IDEMP = false; static constexpr int BMODE = 0; static constexpr bool FP8 = true;
    const bf16_t* xb; bf16_t* xbo; float* xf; const bf16_t* gate16; const int* slot_tok; const float* slot_gate;
    __device__ __forceinline__ void operator()(const f32x4 (&acc)[2][2][4][2], const Unit& u, int wr, int wc, int fr, int fq) const {
        const int slot0 = u.pm * BM + wr * 64 + fr, col0 = u.pn * BM + wc * 32 + 8 * fq;
        int tok[2][4]; float sg[2][4];
#pragma unroll
        for (int ai = 0; ai < 2; ++ai)
#pragma unroll
            for (int m = 0; m < 4; ++m) { const int slot = slot0 + ai * HALF + m * 16; tok[ai][m] = slot_tok[slot]; sg[ai][m] = slot_gate[slot]; }
#pragma unroll
        for (int ai = 0; ai < 2; ++ai) {
            u32x4 gw[4][2], xw[4][2];
#pragma unroll
            for (int q = 0; q < 4; ++q) { const int t = tok[ai][q], te = t < 0 ? 0 : t;
                const bf16_t* gp = gate16 + (size_t)(te >> 11) * 1024 + col0; const bf16_t* xp = xb + (size_t)te * 1024 + col0;
#pragma unroll
                for (int bj = 0; bj < 2; ++bj) { gw[q][bj] = *(const u32x4*)(gp + bj * HALF); xw[q][bj] = *(const u32x4*)(xp + bj * HALF); } }
            asm volatile("" ::: "memory");
#pragma unroll
            for (int q = 0; q < 4; ++q) { const int t = tok[ai][q];
                if (t >= 0) { const float g1 = sg[ai][q];
#pragma unroll
                    for (int bj = 0; bj < 2; ++bj) { f32x4 ga, gc, xa, xc; unpack_bf16x8(gw[q][bj], ga, gc); unpack_bf16x8(xw[q][bj], xa, xc);
                        const f32x4 r0 = xa + (ga * g1) * acc[ai][bj][q][0], r1 = xc + (gc * g1) * acc[ai][bj][q][1];
                        if (OUT_F32) { float* op = xf + (size_t)t * 1024 + col0 + bj * HALF; *(f32x4*)op = r0; *(f32x4*)(op + 4) = r1; }
                        else store_bf16x8(xbo + (size_t)t * 1024 + col0 + bj * HALF, r0, r1); } } }
            asm volatile("" ::: "memory");
        }
    }
};
struct DupOrder : StaticOrder {
    __device__ __forceinline__ bool next(int i, Unit& u) const { if (!StaticOrder::next(i >> 1, u)) return false; u.skip = i & 1; return true; }
};
struct PanelOrder {
    int nM, nN, G, c;
    __device__ __forceinline__ void init(int M, int N, int G_, int c_) { nM = M / BM; nN = N / BM; G = G_; c = c_; }
    __device__ __forceinline__ bool next(int i, Unit& u) const { const int pi = i / nN; u.pm = c + pi * G; if (u.pm >= nM) return false; u.pn = i - pi * nN; u.bn = u.pn; u.skip = 0; u.kofs = 0; return true; }
    __device__ __forceinline__ void a_ready(const Unit&) const {}
    __device__ __forceinline__ void done(const Unit&) const {}
};
struct MoeOrder : StaticOrder {
    const PG8_LAS unsigned char* tile_e; int ne_tiles; int limit;
    __device__ __forceinline__ bool next(int i, Unit& u) const { const long L = (long)i * G + c; if (L >= limit) return false; map((int)L, u); u.bn = (int)tile_e[u.pm] * ne_tiles + u.pn; return true; }
};
struct MoeOrder2 : StaticOrder {
    const PG8_LAS unsigned char* tile_e0; const PG8_LAS unsigned char* tile_e1; int ne_tiles, nt0, base1;
    __device__ __forceinline__ bool next(int i, Unit& u) const { const long L = (long)i * G + c; if (L >= nwg) return false; map((int)L, u);
        int e; if (u.pm < nt0) e = tile_e0[u.pm]; else { const int pl = u.pm - nt0; e = tile_e1[pl]; u.pm = base1 + pl; }
        u.bn = e * ne_tiles + u.pn; return true; }
};
struct MoeOrder2L : MoeOrder2 { int limit;
    __device__ __forceinline__ bool next(int i, Unit& u) const { const long L = (long)i * G + c; if (L >= limit) return false; map((int)L, u);
        int e; if (u.pm < nt0) e = tile_e0[u.pm]; else { const int pl = u.pm - nt0; e = tile_e1[pl]; u.pm = base1 + pl; }
        u.bn = e * ne_tiles + u.pn; return true; } };
struct MoeTail2 : MoeOrder2 { int base, ntail, nsl, ksl_bytes;
    __device__ __forceinline__ bool next(int i, Unit& u) const { const int j = i * G + c; if (j >= ntail * nsl) return false; const int q = j / nsl; map(base + q, u);
        int e; if (u.pm < nt0) e = tile_e0[u.pm]; else { const int pl = u.pm - nt0; e = tile_e1[pl]; u.pm = base1 + pl; }
        u.bn = e * ne_tiles + u.pn; u.kofs = (j - q * nsl) * ksl_bytes; u.skip = j; return true; } };
struct EpiTileF32F8 {
    static constexpr bool PERM = false, AFTER_DRAIN = false, IDEMP = true; static constexpr int BMODE = 0; static constexpr bool FP8 = true;
    float* S;
    __device__ __forceinline__ void operator()(const f32x4 (&acc)[2][2][4][2], const Unit& u, int wr, int wc, int fr, int fq) const {
        float* base = S + (size_t)u.skip * 65536 + (size_t)(wr * 64 + fr) * 256 + wc * 32 + 4 * fq;
#pragma unroll
        for (int ai = 0; ai < 2; ++ai)
#pragma unroll
            for (int m = 0; m < 4; ++m)
#pragma unroll
                for (int bj = 0; bj < 2; ++bj)
#pragma unroll
                    for (int n = 0; n < 2; ++n) *(f32x4*)(base + (size_t)(ai * HALF + m * 16) * 256 + bj * HALF + n * 16) = acc[ai][bj][m][n];
    }
};
struct MoeTailOrder : StaticOrder {
    const PG8_LAS unsigned char* tile_e; int ne_tiles; int base, ntail, nsl, ksl_bytes;
    __device__ __forceinline__ bool next(int i, Unit& u) const { const int j = i * G + c; if (j >= ntail * nsl) return false; const int q = j / nsl; map(base + q, u);
        u.bn = (int)tile_e[u.pm] * ne_tiles + u.pn; u.kofs = (j - q * nsl) * ksl_bytes; return true; }
};
struct EpiMoeDownAtomic {
    static constexpr bool PERM = false, AFTER_DRAIN = false, IDEMP = false; static constexpr int BMODE = 0; static constexpr bool FP8 = false;
    float* x; const float* gate; const int* slot_tok; const float* slot_gate;
    __device__ __forceinline__ void operator()(const f32x4 (&acc)[2][2][4][2], const Unit& u, int wr, int wc, int fr, int fq) const {
        const int slot0 = u.pm * BM + wr * 64 + fr, col0 = u.pn * BM + wc * 32 + 4 * fq;
#pragma unroll
        for (int ai = 0; ai < 2; ++ai)
#pragma unroll
            for (int m = 0; m < 4; ++m) { const int slot = slot0 + ai * HALF + m * 16; const int tok = slot_tok[slot];
                if (tok >= 0) { const float sg = slot_gate[slot]; const float* gp = gate + (size_t)(tok >> 11) * 6144 + col0; float* xp = x + (size_t)tok * 1024 + col0;
#pragma unroll
                    for (int bj = 0; bj < 2; ++bj)
#pragma unroll
                        for (int n = 0; n < 2; ++n) { const f32x4 v = (*(const f32x4*)(gp + bj * HALF + n * 16) * sg) * acc[ai][bj][m][n];
#pragma unroll
                            for (int e = 0; e < 4; ++e) unsafeAtomicAdd(xp + bj * HALF + n * 16 + e, v[e]); } } }
    }
};

#ifndef EPI_TWICE
#define EPI_TWICE false
#endif
template <class Epi, class Sched, bool ALIGN_EPI = false, bool SP2 = false>
__device__ __forceinline__ void gemm_phase(PG8_LAS unsigned char* lds, const Gemm g, const Sched& S, const Epi& E) {
    int tid_o = threadIdx.x; asm volatile("" : "+v"(tid_o));
    const int tid = tid_o, wid = __builtin_amdgcn_readfirstlane(tid >> 6), lane = tid & 63, wr = wid >> 2, wc = wid & 3, fr = lane & 15, fq = lane >> 4;
    const int nt = g.K / BK, K = g.ld ? g.ld : g.K;
    unsigned voffA[2], voffB[2];
#pragma unroll
    for (int i = 0; i < 2; ++i) { int R, C; stage_rc(tid * 16 + i * 8192, R, C); const int Rb = (Epi::BMODE == 1) ? (64 * (R >> 5) + perm32(R & 31)) : (Epi::PERM ? ((R & ~31) + perm32(R & 31)) : R);
        voffA[i] = (unsigned)(R * K + C) * 2u; voffB[i] = (unsigned)(Rb * K + C) * 2u; }
    const size_t kstep = (size_t)(BK * 2);
    const size_t hstep = (size_t)HALF * K * 2;
    const size_t hstepB = (Epi::BMODE == 1) ? (size_t)32 * K * 2 : hstep;
    const size_t tstep = 2 * hstep;
    const unsigned lds0 = (unsigned)(uintptr_t)lds;
    const unsigned ldsw = (unsigned)wid * 1024u;
    const int aoff = lds_byte(wr * 64 + fr, fq * 8), boff = lds_byte(wc * 32 + fr, fq * 8);
#define PG8_SA(b, h) (((b) * 2 + (h)) * HTB)
#define PG8_SB(b, h) ((4 + (b) * 2 + (h)) * HTB)
#ifndef PG8_ASM_STAGE
#define PG8_ASM_STAGE 1
#endif
#if PG8_ASM_STAGE
#define PG8_STAGE(bufoff, gbase, voff) do { _Pragma("unroll") for (int _i = 0; _i < 2; ++_i) glds16s((const void*)(gbase), (voff)[_i], (unsigned)__builtin_amdgcn_readfirstlane((int)(lds0 + (unsigned)(bufoff) + ldsw + (unsigned)_i * 8192u))); } while (0)
#else
#define PG8_STAGE(bufoff, gbase, voff) do { _Pragma("unroll") for (int _i = 0; _i < 2; ++_i) \
        __builtin_amdgcn_global_load_lds((const unsigned*)((const char*)(gbase) + (voff)[_i]), (PG8_LAS unsigned*)(lds + (bufoff) + ldsw + _i * 8192), 16, 0, 0); } while (0)
#endif
#define PG8_LDA(dst, b, h) do { _Pragma("unroll") for (int m = 0; m < 4; ++m) _Pragma("unroll") for (int k = 0; k < 2; ++k) dst[m][k] = *(const PG8_LAS bf16x8*)(lds + PG8_SA(b, h) + aoff + m * 2048 + k * 1024); } while (0)
#define PG8_LDB(dst, b, h) do { _Pragma("unroll") for (int n = 0; n < 2; ++n) _Pragma("unroll") for (int k = 0; k < 2; ++k) dst[n][k] = *(const PG8_LAS bf16x8*)(lds + PG8_SB(b, h) + boff + n * 2048 + k * 1024); } while (0)
#define PG8_MMA(ai, bj, At, Bt) do { __builtin_amdgcn_s_setprio(1); _Pragma("unroll") for (int m = 0; m < 4; ++m) _Pragma("unroll") for (int n = 0; n < 2; ++n) { \
        if constexpr (Epi::FP8) mfma_f8(acc[ai][bj][m][n], cat8(Bt[n][0], Bt[n][1]), cat8(At[m][0], At[m][1]), 0x7a7a7a7a, 0x7f7f7f7f); \
        else { _Pragma("unroll") for (int k = 0; k < 2; ++k) acc[ai][bj][m][n] = __builtin_amdgcn_mfma_f32_16x16x32_bf16(Bt[n][k], At[m][k], acc[ai][bj][m][n], 0, 0, 0); } } \
        __builtin_amdgcn_s_setprio(0); } while (0)
#define PG8_MMA0(ai, bj, At, Bt) do { __builtin_amdgcn_s_setprio(1); _Pragma("unroll") for (int m = 0; m < 4; ++m) _Pragma("unroll") for (int n = 0; n < 2; ++n) \
        mfma_f8_z(acc[ai][bj][m][n], cat8(Bt[n][0], Bt[n][1]), cat8(At[m][0], At[m][1]), 0x7a7a7a7a, 0x7f7f7f7f); \
        __builtin_amdgcn_s_setprio(0); } while (0)
#define PG8_WAIT_V(n) asm volatile("s_waitcnt vmcnt(" #n ")" ::: "memory")
#define PG8_WAIT_L(n) asm volatile("s_waitcnt lgkmcnt(" #n ")" ::: "memory")
#define PG8_BAR __builtin_amdgcn_s_barrier()
#define PG8_SCHED __builtin_amdgcn_sched_barrier(0)
    Unit cur, nxt; int ui = 0;
    if (!S.next(0, cur)) return;
    f32x4 acc[2][2][4][2];
    if constexpr (!(SP2 && Epi::FP8))
#pragma unroll
    for (int a = 0; a < 2; ++a)
#pragma unroll
        for (int b = 0; b < 2; ++b)
#pragma unroll
            for (int m = 0; m < 4; ++m)
#pragma unroll
                for (int n = 0; n < 2; ++n) acc[a][b][m][n] = (f32x4){0.f, 0.f, 0.f, 0.f};
    bf16x8 At[4][2], B0[2][2], B1[2][2];
    const char* cA = (const char*)g.A + (size_t)cur.pm * tstep + cur.kofs; const char* cB = (const char*)g.Bt + (size_t)cur.bn * tstep + cur.kofs;
    S.a_ready(cur);
    if constexpr (SP2) {
        PG8_STAGE(PG8_SB(0, 0), cB, voffB); PG8_STAGE(PG8_SB(0, 1), cB + hstepB, voffB); PG8_STAGE(PG8_SA(0, 0), cA, voffA); PG8_STAGE(PG8_SA(0, 1), cA + hstep, voffA);
        if (wr == 1) PG8_BAR;
        PG8_WAIT_V(2); PG8_BAR;
        PG8_STAGE(PG8_SB(1, 0), cB + kstep, voffB); PG8_STAGE(PG8_SA(1, 0), cA + kstep, voffA); PG8_STAGE(PG8_SB(1, 1), cB + hstepB + kstep, voffB);
        PG8_WAIT_V(6); PG8_BAR;
    } else {
        PG8_STAGE(PG8_SB(0, 0), cB, voffB); PG8_STAGE(PG8_SA(0, 0), cA, voffA); PG8_STAGE(PG8_SB(0, 1), cB + hstepB, voffB); PG8_STAGE(PG8_SA(0, 1), cA + hstep, voffA);
        if (wr == 1) PG8_BAR;
        PG8_WAIT_V(4); PG8_BAR;
        PG8_STAGE(PG8_SB(1, 0), cB + kstep, voffB); PG8_STAGE(PG8_SA(1, 0), cA + kstep, voffA); PG8_STAGE(PG8_SB(1, 1), cB + hstepB + kstep, voffB);
        PG8_WAIT_V(6); PG8_BAR;
    }
    for (;;) {
        const bool has_next = S.next(ui + 1, nxt);
        const char* nA = has_next ? (const char*)g.A + (size_t)nxt.pm * tstep + nxt.kofs : cA; const char* nB = has_next ? (const char*)g.Bt + (size_t)nxt.bn * tstep + nxt.kofs : cB;
#pragma unroll 1
        for (int t = 0; t < nt; t += 2) {
            const bool last = (t == nt - 2);
            const char* a1 = cA + (size_t)(t + 1) * kstep;
            const char* a2 = last ? nA : cA + (size_t)(t + 2) * kstep; const char* b2 = last ? nB : cB + (size_t)(t + 2) * kstep;
            const char* a3 = a2 + kstep; const char* b3 = b2 + kstep;
            if (last && has_next) S.a_ready(nxt);
            if constexpr (SP2) {
            PG8_LDB(B0, 0, 0); PG8_LDB(B1, 0, 1); PG8_SCHED; PG8_LDA(At, 0, 0); PG8_STAGE(PG8_SA(1, 1), a1 + hstep, voffA);
            PG8_WAIT_V(8); PG8_WAIT_L(0); PG8_BAR; if (Epi::FP8 && t == 0) { PG8_MMA0(0, 0, At, B0); PG8_MMA0(0, 1, At, B1); } else { PG8_MMA(0, 0, At, B0); PG8_MMA(0, 1, At, B1); } PG8_BAR; PG8_SCHED;
            PG8_LDA(At, 0, 1); PG8_STAGE(PG8_SB(0, 0), b2, voffB); PG8_STAGE(PG8_SB(0, 1), b2 + hstepB, voffB); PG8_STAGE(PG8_SA(0, 0), a2, voffA);
            PG8_WAIT_V(8); PG8_WAIT_L(0); PG8_BAR; if (Epi::FP8 && t == 0) { PG8_MMA0(1, 0, At, B0); PG8_MMA0(1, 1, At, B1); } else { PG8_MMA(1, 0, At, B0); PG8_MMA(1, 1, At, B1); } PG8_BAR; PG8_SCHED;
            PG8_LDB(B0, 1, 0); PG8_LDB(B1, 1, 1); PG8_SCHED; PG8_LDA(At, 1, 0); PG8_STAGE(PG8_SA(0, 1), a2 + hstep, voffA);
            PG8_WAIT_V(8); PG8_WAIT_L(0); PG8_BAR; PG8_MMA(0, 0, At, B0); PG8_MMA(0, 1, At, B1); PG8_BAR; PG8_SCHED;
            PG8_LDA(At, 1, 1); PG8_STAGE(PG8_SB(1, 0), b3, voffB); PG8_STAGE(PG8_SB(1, 1), b3 + hstepB, voffB); PG8_STAGE(PG8_SA(1, 0), a3, voffA);
            PG8_WAIT_V(8); PG8_WAIT_L(0); PG8_BAR; PG8_MMA(1, 0, At, B0); PG8_MMA(1, 1, At, B1); PG8_BAR; PG8_SCHED;
            } else {
            PG8_LDB(B0, 0, 0); PG8_SCHED; PG8_LDA(At, 0, 0); PG8_STAGE(PG8_SA(1, 1), a1 + hstep, voffA);
            PG8_WAIT_L(8); PG8_BAR; PG8_WAIT_L(0); PG8_MMA(0, 0, At, B0); PG8_BAR; PG8_SCHED;
            PG8_LDB(B1, 0, 1); PG8_STAGE(PG8_SB(0, 0), b2, voffB);
            PG8_BAR; PG8_WAIT_L(0); PG8_MMA(0, 1, At, B1); PG8_BAR;
            PG8_LDA(At, 0, 1); PG8_STAGE(PG8_SA(0, 0), a2, voffA);
            PG8_BAR; PG8_WAIT_L(0); PG8_MMA(1, 0, At, B0); PG8_BAR; PG8_SCHED;
            PG8_STAGE(PG8_SB(0, 1), b2 + hstepB, voffB);
            PG8_WAIT_V(6); PG8_BAR; PG8_MMA(1, 1, At, B1); PG8_BAR;
            PG8_LDB(B0, 1, 0); PG8_SCHED; PG8_LDA(At, 1, 0); PG8_STAGE(PG8_SA(0, 1), a2 + hstep, voffA);
            PG8_WAIT_L(8); PG8_BAR; PG8_WAIT_L(0); PG8_MMA(0, 0, At, B0); PG8_BAR; PG8_SCHED;
            PG8_LDB(B1, 1, 1); PG8_STAGE(PG8_SB(1, 0), b3, voffB);
            PG8_BAR; PG8_WAIT_L(0); PG8_MMA(0, 1, At, B1); PG8_BAR;
            PG8_LDA(At, 1, 1); PG8_STAGE(PG8_SA(1, 0), a3, voffA);
            PG8_BAR; PG8_WAIT_L(0); PG8_MMA(1, 0, At, B0); PG8_BAR; PG8_SCHED;
            PG8_STAGE(PG8_SB(1, 1), b3 + hstepB, voffB);
            PG8_WAIT_V(6); PG8_BAR; PG8_MMA(1, 1, At, B1); PG8_BAR;
            }
        }
        if constexpr (ALIGN_EPI) { if (wr == 0) PG8_BAR; }
        if constexpr (Epi::FP8) asm volatile("s_nop 15\n\ts_nop 15" ::: "memory");
        if constexpr (!Epi::AFTER_DRAIN) { E(acc, cur, wr, wc, fr, fq); if constexpr (EPI_TWICE && Epi::IDEMP) { asm volatile("" ::: "memory"); E(acc, cur, wr, wc, fr, fq); } S.done(cur); }
        if (!has_next) break;
        if constexpr (!(SP2 && Epi::FP8))
#pragma unroll
        for (int a = 0; a < 2; ++a)
#pragma unroll
            for (int b = 0; b < 2; ++b)
#pragma unroll
                for (int m = 0; m < 4; ++m)
#pragma unroll
                    for (int n = 0; n < 2; ++n) acc[a][b][m][n] = (f32x4){0.f, 0.f, 0.f, 0.f};
        cur = nxt; cA = nA; cB = nB; ++ui;
        if constexpr (ALIGN_EPI) { if (wr == 1) PG8_BAR; }
    }
    PG8_WAIT_V(0);
    if constexpr (!ALIGN_EPI) { if (wr == 0) PG8_BAR; }
    PG8_BAR;
    if constexpr (Epi::AFTER_DRAIN) { E.fused(acc, cur, wr, wc, fr, fq, lds, wid, lane); S.done(cur); }
#undef PG8_SA
#undef PG8_SB
#undef PG8_STAGE
#undef PG8_LDA
#undef PG8_LDB
#undef PG8_MMA
#undef PG8_MMA0
#undef PG8_WAIT_V
#undef PG8_WAIT_L
#undef PG8_BAR
#undef PG8_SCHED
}
}

constexpr int NWAVES = 8;
constexpr int BATCH = 32, SEQ = 2048, T = BATCH * SEQ, D = 1024, NPROJ = 2560, FF = 2816, NE = 8, DE = 3584, ADA = 6 * D;
constexpr float EPS = 1e-6f;
constexpr float C2 = 0.125f * 1.4426950408889634f;
constexpr int MAXTILES = 264;
constexpr size_t MiB = 1u << 20;
constexpr size_t WS_CTL = 0, CTL_ZERO_BYTES = 1 * MiB;
constexpr size_t WS_ADA = 1 * MiB;
constexpr size_t WS_G16 = 2560 * 1024;
constexpr size_t WS_PCNT = 3 * MiB;
constexpr size_t WS_TOKE = 4 * MiB, WS_TOKR = 5 * MiB, WS_TOKG = 6 * MiB;
constexpr size_t WS_SLOTT = 7 * MiB, WS_SLOTG = 3 * MiB + 256 * 1024;
constexpr size_t WS_WIN = 8 * MiB;
constexpr size_t WS_WOUT = 18 * MiB;
constexpr size_t WS_WGU = 22 * MiB;
constexpr size_t WS_WD = 33 * MiB;
constexpr size_t WS_GW = 39 * MiB;
constexpr size_t WS_MWGU = 40 * MiB;
constexpr size_t WS_MWD = 96 * MiB;
constexpr size_t WS_XB = 124 * MiB;
constexpr size_t WS_HB = 252 * MiB;
constexpr size_t WS_BIG = 380 * MiB;
constexpr size_t WS_ACT = WS_BIG;
constexpr size_t WS_XS = WS_BIG, WS_ACTM = WS_BIG + 132 * MiB;
constexpr size_t WS_END = 1024 * MiB;
static_assert(WS_ACTM + (size_t)2 * MAXTILES * 256 * DE <= WS_END && WS_XS + (size_t)2 * MAXTILES * 256 * D <= WS_ACTM && WS_ACT + (size_t)T * FF * 2 <= WS_END && WS_BIG + (size_t)T * NPROJ * 2 <= WS_END, "d_ws map");
static_assert(WS_SLOTG + (size_t)2 * MAXTILES * 256 * 4 <= WS_TOKE && WS_SLOTT + (size_t)2 * MAXTILES * 256 * 4 <= WS_WIN && WS_WD + (size_t)D * FF * 2 <= WS_GW && WS_MWGU + (size_t)NE * 2 * DE * D <= WS_MWD
              && WS_MWD + (size_t)NE * D * DE <= WS_XB && WS_XB + (size_t)T * D * 2 <= WS_HB && WS_HB + (size_t)T * D * 2 <= WS_BIG, "d_ws map");
constexpr int CW_TMO = 0, CW_CODE = 1, CW_BAR = 4096;
constexpr int RING_OFF = 0, RING_BYTES = 131072;
constexpr int LDSCTL_OFF = RING_BYTES, MISC_OFF = LDSCTL_OFF + 320, MOE_OFF = LDSCTL_OFF + 512;
constexpr int LDS_BYTES = 147456;
constexpr int MT_TOT = 0, MT_POFF = 8, MT_NT = 20, MT_PBASE = 24, MT_TILE = 32;
constexpr int MT_STRIDE = 128;
static_assert(MT_TILE * 4 + 272 <= MT_STRIDE * 4 && MOE_OFF + 2 * MT_STRIDE * 4 <= LDS_BYTES, "LDS map");

#define GAS __attribute__((address_space(1)))
#define LAS __attribute__((address_space(3)))
typedef unsigned short bf16;
typedef unsigned v4u __attribute__((ext_vector_type(4)));
typedef unsigned v2u __attribute__((ext_vector_type(2)));
typedef float f32x4 __attribute__((ext_vector_type(4)));
typedef GAS unsigned gu32;
#define RLX_AGENT __ATOMIC_RELAXED, __HIP_MEMORY_SCOPE_AGENT
#define LDS_WAIT() asm volatile("s_waitcnt lgkmcnt(0)" ::: "memory")
#define VM_WAIT() asm volatile("s_waitcnt vmcnt(0)" ::: "memory")
__device__ __forceinline__ unsigned f2bf(float f) { unsigned u = __builtin_bit_cast(unsigned, f); return (u + 0x7fffu + ((u >> 16) & 1u)) >> 16; }
__device__ __forceinline__ unsigned pk2(float lo, float hi) { return f2bf(lo) | (f2bf(hi) << 16); }
__device__ __forceinline__ float bflo(unsigned w) { return __builtin_bit_cast(float, w << 16); }
__device__ __forceinline__ float bfhi(unsigned w) { return __builtin_bit_cast(float, w & 0xffff0000u); }
template <int CTRL, int ROW_MASK>
__device__ __forceinline__ float dpp_f(float v) {
    return __builtin_bit_cast(float, __builtin_amdgcn_update_dpp(0, __builtin_bit_cast(int, v), CTRL, ROW_MASK, 0xf, false)); }
__device__ __forceinline__ float wave_sum(float v) {
    v += dpp_f<0xB1, 0xf>(v);
    v += dpp_f<0x4E, 0xf>(v);
    v += dpp_f<0x141, 0xf>(v);
    v += dpp_f<0x140, 0xf>(v);
    v += dpp_f<0x142, 0xa>(v);
    v += dpp_f<0x143, 0xc>(v);
    return __builtin_bit_cast(float, __builtin_amdgcn_readlane(__builtin_bit_cast(int, v), 63));
}

__device__ __forceinline__ int opaque_tid() { int t = threadIdx.x; asm volatile("" : "+v"(t)); return t; }
__device__ __forceinline__ unsigned char* opaque_ptr(unsigned char* p) { size_t z = 0; asm volatile("" : "+s"(z)); return p + z; }
__device__ __forceinline__ int opaque_i(int v) { asm volatile("" : "+s"(v)); return v; }
#define PHASE_IDS() const int tid = opaque_tid(), lane = tid & 63, wave = __builtin_amdgcn_readfirstlane(tid >> 6); (void)lane; (void)wave

#define XB_TMO      128
#define XB_XCNT(j)  (256  + 64 * (j))
#define XB_XSUB(j)  (1280 + 64 * (j))
#define XB_XGEN(j)  (2304 + 64 * (j))
#define XB_TOP      3328
#define XB_TOPGEN   3392
#define XCD_BAR_WORDS 3456
#define XB_SPIN_CAP (1u << 18)

__device__ __forceinline__ unsigned xb_ld(unsigned* p)              { return __hip_atomic_load(p, __ATOMIC_RELAXED, __HIP_MEMORY_SCOPE_AGENT); }
__device__ __forceinline__ unsigned xb_add(unsigned* p, unsigned v) { return __hip_atomic_fetch_add(p, v, __ATOMIC_RELAXED, __HIP_MEMORY_SCOPE_AGENT); }
__device__ __forceinline__ unsigned xb_xcc_id() { return (unsigned)__builtin_amdgcn_s_getreg((3 << 11) | 20) & 0xFu; }
#define XB_SPIN(cond, bar) do { unsigned _sp = 0; while (cond) { __builtin_amdgcn_s_sleep(1); \
    if ((++_sp & 255u) == 0u) { if (xb_ld(&(bar)[XB_TMO])) break; if (_sp > XB_SPIN_CAP) { atomicAdd(&(bar)[XB_TMO], 1u); break; } } } } while (0)

struct XcdBarrier {
    unsigned* bar; unsigned x;
    volatile LAS unsigned* st;
};

__device__ __forceinline__ XcdBarrier xcd_barrier_post(unsigned* bar, volatile LAS unsigned* st) {
    XcdBarrier b; b.bar = bar; b.x = xb_xcc_id(); b.st = st;
    if (threadIdx.x == 0) (void)xb_add(&bar[XB_XCNT(b.x)], 1u);
    return b;
}
__device__ __forceinline__ void xcd_barrier_complete(unsigned* bar, unsigned x, unsigned& nloc, unsigned& nx) {
    const unsigned G = gridDim.x * gridDim.y * gridDim.z;
    unsigned sum, cnt, mine, sp = 0u;
    for (;;) {
        sum = 0u; cnt = 0u; mine = 0u;
#pragma unroll
        for (unsigned j = 0; j < 16; ++j) { const unsigned c = xb_ld(&bar[XB_XCNT(j)]); sum += c; cnt += (c > 0u) ? 1u : 0u; mine = (j == x) ? c : mine; }
        if (sum == G) break;
        __builtin_amdgcn_s_sleep(1);
        if ((++sp & 255u) == 0u) { if (xb_ld(&bar[XB_TMO])) break; if (sp > XB_SPIN_CAP) { atomicAdd(&bar[XB_TMO], 1u); break; } }
    }
    nloc = mine > 0u ? mine : 1u; nx = cnt > 0u ? cnt : 1u;
}

__device__ __forceinline__ void xcd_barrier(const XcdBarrier& b) {
    asm volatile("s_waitcnt vmcnt(0)" ::: "memory");
    __syncthreads();
    if (threadIdx.x == 0) {
        unsigned* bar = b.bar;
        __builtin_amdgcn_s_waitcnt(0);
        unsigned nloc = b.st[0], nx = b.st[1];
        if (nloc == 0u) { xcd_barrier_complete(bar, b.x, nloc, nx); b.st[0] = nloc; b.st[1] = nx; }
        const unsigned old = xb_add(&bar[XB_XSUB(b.x)], 1u);
        const unsigned gen = old / nloc;
        if (old + 1u == (gen + 1u) * nloc) {
            __builtin_amdgcn_fence(__ATOMIC_RELEASE, "agent");
            asm volatile("s_waitcnt vmcnt(0)" ::: "memory");
            const unsigned og = xb_add(&bar[XB_TOP], 1u);
            const unsigned tg = og / nx;
            if (og + 1u == (tg + 1u) * nx) xb_add(&bar[XB_TOPGEN], 1u);
            else XB_SPIN(xb_ld(&bar[XB_TOPGEN]) == tg, bar);
            __builtin_amdgcn_fence(__ATOMIC_ACQUIRE, "agent");
            xb_add(&bar[XB_XGEN(b.x)], 1u);
            asm volatile("s_waitcnt vmcnt(0)" ::: "memory");
        } else {
            XB_SPIN(xb_ld(&bar[XB_XGEN(b.x)]) == gen, bar);
            __builtin_amdgcn_fence(__ATOMIC_ACQUIRE, "agent");
            asm volatile("s_waitcnt vmcnt(0)" ::: "memory");
        }
    }
    __syncthreads();
}

__device__ __forceinline__ void transpose_item(const float* W, int K, int N, bf16* WT, int mode, LAS float* scr, int item, int lane) {
    const int nblk = N / 32, kb = item / nblk, nb = item % nblk, k0 = 64 * kb, n0 = 32 * nb;
#pragma unroll 8
    for (int i = 0; i < 32; ++i) { const int kk = 2 * i + (lane >> 5); scr[kk * 33 + (lane & 31)] = W[(size_t)(k0 + kk) * N + n0 + (lane & 31)]; }
    LDS_WAIT(); asm volatile("" ::: "memory");
    const int c = lane & 7; const float wsc = (mode == 1) ? 1.4426950408889634f : (mode == 2) ? 0.6931471805599453f : 1.0f;
#pragma unroll
    for (int j = 0; j < 4; ++j) { const int n = (lane >> 3) + 8 * j; const LAS float* s = scr + (8 * c) * 33 + n;
        v4u o; o.x = pk2(s[0 * 33] * wsc, s[1 * 33] * wsc); o.y = pk2(s[2 * 33] * wsc, s[3 * 33] * wsc); o.z = pk2(s[4 * 33] * wsc, s[5 * 33] * wsc); o.w = pk2(s[6 * 33] * wsc, s[7 * 33] * wsc);
        const int nc = n0 + n; const int drow = (mode == 0) ? nc : (((nc >> 7) << 8) + ((mode == 2) ? 128 : 0) + (nc & 127));
        *(GAS v4u*)(WT + (size_t)drow * K + k0 + 8 * c) = o; }
    LDS_WAIT(); asm volatile("" ::: "memory");
}
__device__ __forceinline__ void transpose_item_f8(const float* W, int K, int N, unsigned char* WT, int mode, LAS float* scr, int item, int lane) {
    const int nblk = N / 32, kb = item / nblk, nb = item % nblk, k0 = 64 * kb, n0 = 32 * nb;
#pragma unroll 8
    for (int i = 0; i < 32; ++i) { const int kk = 2 * i + (lane >> 5); scr[kk * 33 + (lane & 31)] = W[(size_t)(k0 + kk) * N + n0 + (lane & 31)]; }
    LDS_WAIT(); asm volatile("" ::: "memory");
    const int c = lane & 7; const float wsc = (mode == 1) ? 1.4426950408889634f : (mode == 2) ? 0.6931471805599453f : 1.0f;
#pragma unroll
    for (int j = 0; j < 4; ++j) { const int n = (lane >> 3) + 8 * j; const LAS float* s = scr + (8 * c) * 33 + n;
        v2u o; o.x = pg8::pk4_fp8((f32x4){s[0 * 33], s[1 * 33], s[2 * 33], s[3 * 33]} * (32.0f * wsc)); o.y = pg8::pk4_fp8((f32x4){s[4 * 33], s[5 * 33], s[6 * 33], s[7 * 33]} * (32.0f * wsc));
        const int nc = n0 + n; const int drow = (mode == 0) ? nc : (((nc >> 7) << 8) + ((mode == 2) ? 128 : 0) + (nc & 127));
        *(GAS v2u*)(WT + (size_t)drow * K + k0 + 8 * c) = o; }
    LDS_WAIT(); asm volatile("" ::: "memory");
}
struct Args { const float* in[22]; float* out; unsigned char* ws; };
__device__ __forceinline__ void p0_transposes(const Args& P, LAS unsigned char* lds, int blk, int G) {
    PHASE_IDS();
    LAS float* scr = (LAS float*)(lds + RING_OFF + wave * 16384);
    const int gw = blk * NWAVES + wave, NGW = G * NWAVES;
    bf16* Win_t = (bf16*)(P.ws + WS_WIN); bf16* Wout_t = (bf16*)(P.ws + WS_WOUT); bf16* Wgu_t = (bf16*)(P.ws + WS_WGU); bf16* Wd_t = (bf16*)(P.ws + WS_WD);
    unsigned char* MWgu8 = P.ws + WS_MWGU; unsigned char* MWd8 = P.ws + WS_MWD;
    constexpr int I_IN = (D / 64) * (NPROJ / 32), I_OUT = (D / 64) * (D / 32), I_GU = (D / 64) * (FF / 32), I_DN = (FF / 64) * (D / 32), I_MGU = (D / 64) * (DE / 32), I_MDN = (DE / 64) * (D / 32);
    constexpr int NITEMS = 2 * I_IN + 2 * I_OUT + 2 * I_GU + I_DN + 16 * I_MGU + 8 * I_MDN;
    for (int it = gw; it < NITEMS; it += NGW) {
        int r = it;
        if (r < 2 * I_IN) { const int l = r / I_IN; transpose_item(P.in[6] + (size_t)l * D * NPROJ, D, NPROJ, Win_t + (size_t)l * NPROJ * D, 0, scr, r % I_IN, lane); continue; } r -= 2 * I_IN;
        if (r < 2 * I_OUT) { const int l = r / I_OUT; transpose_item(P.in[13] + (size_t)l * D * D, D, D, Wout_t + (size_t)l * D * D, 0, scr, r % I_OUT, lane); continue; } r -= 2 * I_OUT;
#ifdef FFN_FP8
        if (r < I_GU) { transpose_item_f8(P.in[14], D, FF, (unsigned char*)Wgu_t, 1, scr, r, lane); continue; } r -= I_GU;
        if (r < I_GU) { transpose_item_f8(P.in[15], D, FF, (unsigned char*)Wgu_t, 2, scr, r, lane); continue; } r -= I_GU;
        if (r < I_DN) { transpose_item_f8(P.in[16], FF, D, (unsigned char*)Wd_t, 0, scr, r, lane); continue; } r -= I_DN;
#else
#if FFN_GU_FP8
        if (r < I_GU) { transpose_item_f8(P.in[14], D, FF, (unsigned char*)Wgu_t, 1, scr, r, lane); continue; } r -= I_GU;
        if (r < I_GU) { transpose_item_f8(P.in[15], D, FF, (unsigned char*)Wgu_t, 2, scr, r, lane); continue; } r -= I_GU;
#else
        if (r < I_GU) { transpose_item(P.in[14], D, FF, Wgu_t, 1, scr, r, lane); continue; } r -= I_GU;
        if (r < I_GU) { transpose_item(P.in[15], D, FF, Wgu_t, 2, scr, r, lane); continue; } r -= I_GU;
#endif
#if FFN_DOWN_FP8
        if (r < I_DN) { transpose_item_f8(P.in[16], FF, D, (unsigned char*)Wd_t, 0, scr, r, lane); continue; } r -= I_DN;
#else
        if (r < I_DN) { transpose_item(P.in[16], FF, D, Wd_t, 0, scr, r, lane); continue; } r -= I_DN;
#endif
#endif
        if (r < 8 * I_MGU) { const int e = r / I_MGU; transpose_item_f8(P.in[19] + (size_t)e * D * DE, D, DE, MWgu8 + (size_t)e * 2 * DE * D, 1, scr, r % I_MGU, lane); continue; } r -= 8 * I_MGU;
        if (r < 8 * I_MGU) { const int e = r / I_MGU; transpose_item_f8(P.in[20] + (size_t)e * D * DE, D, DE, MWgu8 + (size_t)e * 2 * DE * D, 2, scr, r % I_MGU, lane); continue; } r -= 8 * I_MGU;
        { const int e = r / I_MDN; transpose_item_f8(P.in[21] + (size_t)e * DE * D, DE, D, MWd8 + (size_t)e * D * DE, 0, scr, r % I_MDN, lane); }
    }
}
__device__ __forceinline__ void p0_ada(const Args& P, LAS unsigned char* lds, int blk, int G) {
    PHASE_IDS();
    LAS float* ca = (LAS float*)(lds + RING_OFF);
    const float* c = P.in[1]; const float* ada_w = P.in[2]; const float* ada_b = P.in[3]; float* ada = (float*)(P.ws + WS_ADA);
    for (int u = blk; u < 192; u += G) {
        const int l = u / 96, col0 = (u % 96) * 64;
        __syncthreads();
        for (int idx = tid; idx < 32768; idx += NWAVES * 64) { const int b = idx & 31, k = idx >> 5; const float v = c[b * 1024 + k]; ca[idx] = v / (1.0f + expf(-v)); }
        __syncthreads();
        float acc[32];
#pragma unroll
        for (int b = 0; b < 32; ++b) acc[b] = 0.f;
        const float* wp = ada_w + ((size_t)l * 1024 + wave * 128) * ADA + col0 + lane;
        for (int kk = 0; kk < 128; ++kk) { const float wv = wp[(size_t)kk * ADA]; const LAS f32x4* cp = (const LAS f32x4*)(ca + (wave * 128 + kk) * 32);
#pragma unroll
            for (int q = 0; q < 8; ++q) { const f32x4 cv = cp[q]; acc[4 * q] += cv.x * wv; acc[4 * q + 1] += cv.y * wv; acc[4 * q + 2] += cv.z * wv; acc[4 * q + 3] += cv.w * wv; } }
        __syncthreads();
#pragma unroll
        for (int b = 0; b < 32; ++b) ca[(wave * 32 + b) * 64 + lane] = acc[b];
        __syncthreads();
#pragma unroll
        for (int o = 0; o < 4; ++o) { const int idx = tid + 512 * o, b = idx >> 6, ln = idx & 63; float s = 0.f;
#pragma unroll
            for (int w = 0; w < 8; ++w) s += ca[(w * 32 + b) * 64 + ln];
            const float av = s + ada_b[l * ADA + col0 + ln];
            ada[((size_t)l * 32 + b) * ADA + col0 + ln] = av;
            if (l == 1 && col0 >= 5 * D) ((bf16*)(P.ws + WS_G16))[b * D + col0 + ln - 5 * D] = (bf16)f2bf(av); }
    }
    __syncthreads();
}
template <bool ROUTE, bool OUT8 = false, bool XBF = false>
__device__ __forceinline__ void norm_phase(const float* xsrc, const float* gvec, const float* ada_l, int sc_off, int sh_off, bf16* HB,
                                           const float* rw, const float* rb, int* pcnt, int* tok_e, int* tok_rank, float* tok_gate,
                                           LAS unsigned char* lds, int blk, int G) {
    PHASE_IDS();
    LAS int* pe = (LAS int*)(lds + RING_OFF); LAS float* pg = (LAS float*)(lds + RING_OFF + 2048); LAS int* wcnt = (LAS int*)(lds + RING_OFF + 4096);
    const LAS f32x4* rwl = (const LAS f32x4*)(lds + RING_OFF + 8192);
    f32x4 rwr[16];
    if constexpr (ROUTE) {
#pragma unroll
        for (int j = 0; j < 4; ++j)
#pragma unroll
            for (int i = 0; i < 4; ++i) rwr[j * 4 + i] = *(const GAS f32x4*)(rw + (size_t)(256 * j + 4 * lane + i) * 8);
        LAS float* wl = (LAS float*)(lds + RING_OFF + 8192);
        for (int idx = tid; idx < D * 8; idx += NWAVES * 64) { const int col = idx >> 3, e = idx & 7; wl[((((col >> 8) * 4 + (col & 3)) * 2 + (e >> 2)) * 64 + ((col & 255) >> 2)) * 4 + (e & 3)] = rw[idx]; }
        __syncthreads();
    }
    for (int p = blk; p < T / 256; p += G) {
        const int b = p >> 3;
        f32x4 mod[4], sh[4];
#pragma unroll
        for (int j = 0; j < 4; ++j) { const int col = 4 * lane + 256 * j; const f32x4 g4 = *(const f32x4*)(gvec + col); const f32x4 sc4 = *(const f32x4*)(ada_l + (size_t)b * ADA + sc_off + col);
            sh[j] = *(const f32x4*)(ada_l + (size_t)b * ADA + sh_off + col); mod[j] = g4 * (1.0f + sc4); }
        float rbv[8];
        if constexpr (ROUTE) {
#pragma unroll
            for (int e = 0; e < 8; ++e) rbv[e] = rb[e];
        }
        constexpr int NAH = XBF ? 8 : 4;
        f32x4 vbx[NAH][4]; v2u vbb[NAH][4];
#pragma unroll
        for (int q = 0; q < NAH; ++q) {
            if constexpr (XBF) { const GAS v2u* xr0 = (const GAS v2u*)((const bf16*)xsrc + (size_t)(p * 256 + q * 8 + wave) * D) + lane;
#pragma unroll
              for (int j = 0; j < 4; ++j) vbb[q][j] = xr0[64 * j]; }
            else { const GAS f32x4* xr0 = (const GAS f32x4*)(xsrc + (size_t)(p * 256 + q * 8 + wave) * D) + lane;
#pragma unroll
              for (int j = 0; j < 4; ++j) vbx[q][j] = xr0[64 * j]; } }
        for (int rr0 = 0; rr0 < 32; rr0 += NAH)
#pragma unroll
        for (int q = 0; q < NAH; ++q) {
            const int rr = rr0 + q;
            const int row = p * 256 + rr * 8 + wave;
            f32x4 v[4]; float ss = 0.f;
#pragma unroll
            for (int j = 0; j < 4; ++j) { if constexpr (XBF) v[j] = (f32x4){bflo(vbb[q][j].x), bfhi(vbb[q][j].x), bflo(vbb[q][j].y), bfhi(vbb[q][j].y)}; else v[j] = vbx[q][j]; }
            if (rr + NAH < 32) {
                if constexpr (XBF) { const GAS v2u* xr = (const GAS v2u*)((const bf16*)xsrc + (size_t)(row + 8 * NAH) * D) + lane;
#pragma unroll
                    for (int j = 0; j < 4; ++j) vbb[q][j] = xr[64 * j]; }
                else { const GAS f32x4* xr = (const GAS f32x4*)(xsrc + (size_t)(row + 8 * NAH) * D) + lane;
#pragma unroll
                    for (int j = 0; j < 4; ++j) vbx[q][j] = xr[64 * j]; } }
#pragma unroll
            for (int j = 0; j < 4; ++j) ss += (v[j].x * v[j].x + v[j].y * v[j].y) + (v[j].z * v[j].z + v[j].w * v[j].w);
            const float rs = 1.0f / sqrtf(wave_sum(ss) * (1.0f / D) + EPS);
            GAS unsigned long long* o8 = (GAS unsigned long long*)(HB + (size_t)row * D) + lane;
#pragma unroll
            for (int j = 0; j < 4; ++j) { v[j] = v[j] * rs * mod[j] + sh[j];
                if constexpr (OUT8) *(GAS unsigned*)((unsigned char*)HB + (size_t)row * D + 4 * lane + 256 * j) = pg8::pk4_fp8(v[j]);
                else o8[64 * j] = (unsigned long long)pk2(v[j].x, v[j].y) | ((unsigned long long)pk2(v[j].z, v[j].w) << 32); }
            if constexpr (ROUTE) {
                float lg[8];
#pragma unroll
                for (int e = 0; e < 8; ++e) lg[e] = 0.f;
#pragma unroll
                for (int j = 0; j < 4; ++j)
#pragma unroll
                    for (int i = 0; i < 4; ++i) { const float y = v[j][i]; const f32x4 r0 = rwr[j * 4 + i], r1 = rwl[((j * 4 + i) * 2 + 1) * 64 + lane];
#pragma unroll
                        for (int e = 0; e < 4; ++e) { lg[e] += y * r0[e]; lg[4 + e] += y * r1[e]; } }
#pragma unroll
                for (int e = 0; e < 8; ++e) lg[e] = wave_sum(lg[e]) + rbv[e];
                int e1 = 0; float l1 = lg[0];
#pragma unroll
                for (int e = 1; e < 8; ++e) if (lg[e] > l1) { l1 = lg[e]; e1 = e; }
                int e2 = 0; float l2 = -INFINITY;
#pragma unroll
                for (int e = 0; e < 8; ++e) if (e != e1 && lg[e] > l2) { l2 = lg[e]; e2 = e; }
                const float g1 = 1.0f / (1.0f + expf(l2 - l1));
                if (lane == 0) { const int i = rr * 8 + wave; pe[i] = e1; pe[256 + i] = e2; pg[i] = g1; pg[256 + i] = 1.0f - g1; }
            }
        }
        if constexpr (ROUTE) {
            __syncthreads();
            int lr[2] = {0, 0};
            if (tid < 256) {
#pragma unroll
                for (int k = 0; k < 2; ++k) { const int e = pe[k * 256 + tid];
#pragma unroll
                    for (int ee = 0; ee < 8; ++ee) { const unsigned long long m = __ballot(e == ee); if (e == ee) lr[k] = __popcll(m & ((1ull << lane) - 1ull)); if (lane == 0) wcnt[(k * 4 + wave) * 8 + ee] = __popcll(m); } }
            }
            __syncthreads();
            if (tid < 256) { const int t = p * 256 + tid;
#pragma unroll
                for (int k = 0; k < 2; ++k) { const int e = pe[k * 256 + tid]; int base = 0;
#pragma unroll
                    for (int w2 = 0; w2 < 4; ++w2) if (w2 < wave) base += wcnt[(k * 4 + w2) * 8 + e];
                    tok_e[t * 2 + k] = e; tok_rank[t * 2 + k] = base + lr[k]; tok_gate[t * 2 + k] = pg[k * 256 + tid]; } }
            if (tid < 16) { const int k = tid >> 3, ee = tid & 7; pcnt[p * 16 + tid] = wcnt[(k * 4 + 0) * 8 + ee] + wcnt[(k * 4 + 1) * 8 + ee] + wcnt[(k * 4 + 2) * 8 + ee] + wcnt[(k * 4 + 3) * 8 + ee]; }
            __syncthreads();
        }
    }
}
__device__ __forceinline__ void qknorm_phase(bf16* PROJ, const float* qg, const float* kg, int blk, int G) {
    PHASE_IDS();
    const int gw = blk * NWAVES + wave, NGW = G * NWAVES;
    float gq[8], gk[8];
#pragma unroll
    for (int i = 0; i < 8; ++i) { gq[i] = qg[(lane & 7) * 8 + i] * C2; gk[i] = kg[(lane & 7) * 8 + i]; }
    for (int it = gw; it < 2 * T; it += NGW) {
        const int row = it >> 1, which = it & 1;
        GAS v4u* p = (GAS v4u*)(PROJ + (size_t)row * NPROJ + which * 512 + lane * 8);
        const v4u raw = *p; float v[8];
#pragma unroll
        for (int i = 0; i < 4; ++i) { v[2 * i] = bflo(raw[i]); v[2 * i + 1] = bfhi(raw[i]); }
        float ss = 0.f;
#pragma unroll
        for (int i = 0; i < 8; ++i) ss += v[i] * v[i];
        ss += __shfl_xor(ss, 1); ss += __shfl_xor(ss, 2); ss += __shfl_xor(ss, 4);
        const float rs = 1.0f / sqrtf(ss * (1.0f / 64.0f) + EPS);
        v4u o;
#pragma unroll
        for (int i = 0; i < 4; ++i) { const float a = v[2 * i] * rs * (which ? gk[2 * i] : gq[2 * i]), c = v[2 * i + 1] * rs * (which ? gk[2 * i + 1] : gq[2 * i + 1]); o[i] = pk2(a, c); }
        *p = o;
    }
}
__device__ __forceinline__ void attn_simple(const bf16* PROJ, bf16* MIX, LAS unsigned char* lds, int blk, int G) {
    PHASE_IDS();
    LAS float* Ks = (LAS float*)(lds + RING_OFF); LAS float* Vs = Ks + 64 * 64;
    for (int i = 0;; ++i) {
        const int u = i * G + blk; if (u >= BATCH * 8 * 4) break;
        const int bh = u >> 2, qb = ((u & 3) + i) & 3, b = bh >> 3, h = bh & 7;
        const int tq = qb * 512 + tid; const size_t rowq = (size_t)b * SEQ + tq;
        float q[64], o[64];
        { const GAS v4u* qp = (const GAS v4u*)(PROJ + rowq * NPROJ + h * 64);
#pragma unroll
          for (int c = 0; c < 8; ++c) { const v4u w = qp[c];
#pragma unroll
              for (int e = 0; e < 4; ++e) { q[8 * c + 2 * e] = bflo(w[e]); q[8 * c + 2 * e + 1] = bfhi(w[e]); } } }
#pragma unroll
        for (int d = 0; d < 64; ++d) o[d] = 0.f;
        float carry = 0.f;
        const int wq_max = qb * 512 + wave * 64 + 63;
        for (int kt = (qb * 512 + 511) >> 6; kt >= 0; --kt) {
            __syncthreads();
            { const size_t krow = (size_t)b * SEQ + kt * 64 + (tid >> 3); const int d8 = (tid & 7) * 8;
              const v4u kr = *(const GAS v4u*)(PROJ + krow * NPROJ + 512 + h * 64 + d8); const v4u vr = *(const GAS v4u*)(PROJ + krow * NPROJ + 1024 + h * 64 + d8);
              LAS float* kd = Ks + (tid >> 3) * 64 + d8; LAS float* vd = Vs + (tid >> 3) * 64 + d8;
#pragma unroll
              for (int e = 0; e < 4; ++e) { kd[2 * e] = bflo(kr[e]); kd[2 * e + 1] = bfhi(kr[e]); vd[2 * e] = bflo(vr[e]); vd[2 * e + 1] = bfhi(vr[e]); } }
            __syncthreads();
            if (kt * 64 < wq_max) {
                for (int j = 63; j >= 0; --j) {
                    const int key = kt * 64 + j;
                    const LAS f32x4* kp = (const LAS f32x4*)(Ks + j * 64); float z = 0.f;
#pragma unroll
                    for (int d4 = 0; d4 < 16; ++d4) { const f32x4 kv = kp[d4]; z += q[4 * d4] * kv.x + q[4 * d4 + 1] * kv.y + q[4 * d4 + 2] * kv.z + q[4 * d4 + 3] * kv.w; }
                    const bool valid = key < tq;
                    const float sp = fmaxf(z, 0.f) + __builtin_amdgcn_logf(1.0f + __builtin_amdgcn_exp2f(-fabsf(z)));
                    const float L = valid ? -sp : 0.f;
                    const float w = valid ? __builtin_amdgcn_exp2f(z + L + carry) : 0.f;
                    carry += L;
                    const LAS f32x4* vp = (const LAS f32x4*)(Vs + j * 64);
#pragma unroll
                    for (int d4 = 0; d4 < 16; ++d4) { const f32x4 vv = vp[d4]; o[4 * d4] += w * vv.x; o[4 * d4 + 1] += w * vv.y; o[4 * d4 + 2] += w * vv.z; o[4 * d4 + 3] += w * vv.w; }
                }
            }
        }
        { GAS v4u* op = (GAS v4u*)(MIX + rowq * D + h * 64);
#pragma unroll
          for (int c = 0; c < 8; ++c) { v4u w;
#pragma unroll
              for (int e = 0; e < 4; ++e) w[e] = pk2(o[8 * c + 2 * e], o[8 * c + 2 * e + 1]);
              op[c] = w; } }
    }
    __syncthreads();
}
namespace sba {
typedef _Float16 f16x8 __attribute__((ext_vector_type(8)));
typedef _Float16 f16x2 __attribute__((ext_vector_type(2)));
typedef short bf16x8 __attribute__((ext_vector_type(8)));
typedef short s16x4 __attribute__((ext_vector_type(4)));
typedef float f32x16 __attribute__((ext_vector_type(16)));
typedef float f32x2_t __attribute__((ext_vector_type(2)));
typedef __bf16 bf16x2_t __attribute__((ext_vector_type(2)));
typedef unsigned u32x4 __attribute__((ext_vector_type(4)));
constexpr int SLOTB = 8192, NSLOT = 5, LDS_K = 0, LDS_V = NSLOT * SLOTB, LDS_BYTES_ATT = 2 * NSLOT * SLOTB;
constexpr float SBA_DEAD = -160.0f;
__device__ __forceinline__ int crow(int r, int hi) { return (r & 3) + 8 * (r >> 2) + 4 * hi; }
__device__ __forceinline__ unsigned cvtpk_bf16(float lo, float hi) { f32x2_t v = {lo, hi}; bf16x2_t b = __builtin_convertvector(v, bf16x2_t); return __builtin_bit_cast(unsigned, b); }
__device__ __forceinline__ unsigned cvtpk_f16(float lo, float hi) { f32x2_t v = {lo, hi}; f16x2 b = __builtin_convertvector(v, f16x2); return __builtin_bit_cast(unsigned, b); }
__device__ __forceinline__ s16x4 vtr(const LAS unsigned char* p) { return __builtin_bit_cast(s16x4, __builtin_amdgcn_ds_read_tr16_b64_v4i16((LAS s16x4*)p)); }

template <int MODE>
__device__ __forceinline__ void tile64(f32x16 (&oT)[2], float& carry, const bf16x8 (&qr)[4], const f16x8 (&tri)[2], const LAS unsigned char* Kslot, const LAS unsigned char* Vslot, int r32, int hi, int lane) {
    constexpr bool HAS1 = (MODE != 2), DIAG1 = (MODE == 1), DIAG0 = (MODE == 2);
    f32x16 z1, z0;
#pragma unroll
    for (int i = 0; i < 16; ++i) { z1[i] = 0.f; z0[i] = 0.f; }
#pragma unroll
    for (int d0 = 0; d0 < 4; ++d0) { const LAS unsigned char* kp = Kslot + (2 * d0 + hi) * 1024 + r32 * 16;
        if (HAS1) { const bf16x8 kf1 = *(const LAS bf16x8*)(kp + 512); z1 = __builtin_amdgcn_mfma_f32_32x32x16_bf16(kf1, qr[d0], z1, 0, 0, 0); }
        const bf16x8 kf0 = *(const LAS bf16x8*)kp; z0 = __builtin_amdgcn_mfma_f32_32x32x16_bf16(kf0, qr[d0], z0, 0, 0, 0); }
    float lg1[16], lg0[16];
#pragma unroll
    for (int i = 0; i < 16; ++i) {
        if (HAS1) { z1[i] = __builtin_amdgcn_fmed3f(z1[i], -3.0e38f, 126.0f); lg1[i] = __builtin_amdgcn_logf(1.0f + __builtin_amdgcn_exp2f(z1[i]));
            if (DIAG1) { const bool valid = crow(i, hi) < r32; lg1[i] = valid ? lg1[i] : 0.f; z1[i] = valid ? z1[i] : -1.0e30f; } }
        z0[i] = __builtin_amdgcn_fmed3f(z0[i], -3.0e38f, 126.0f); lg0[i] = __builtin_amdgcn_logf(1.0f + __builtin_amdgcn_exp2f(z0[i]));
        if (DIAG0) { const bool valid = crow(i, hi) < r32; lg0[i] = valid ? lg0[i] : 0.f; z0[i] = valid ? z0[i] : -1.0e30f; } }
    const float z1r0 = z1[0], z0r0 = z0[0];
    f32x16 D1 = z1, D0 = z0;
#pragma unroll
    for (int s = 0; s < 2; ++s) {
        if (HAS1) { u32x4 w;
#pragma unroll
            for (int j = 0; j < 4; ++j) w[j] = cvtpk_f16(lg1[8 * s + 2 * j], lg1[8 * s + 2 * j + 1]);
            D1 = __builtin_amdgcn_mfma_f32_32x32x16_f16(tri[s], __builtin_bit_cast(f16x8, w), D1, 0, 0, 0); }
        { u32x4 w;
#pragma unroll
            for (int j = 0; j < 4; ++j) w[j] = cvtpk_f16(lg0[8 * s + 2 * j], lg0[8 * s + 2 * j + 1]);
            D0 = __builtin_amdgcn_mfma_f32_32x32x16_f16(tri[s], __builtin_bit_cast(f16x8, w), D0, 0, 0, 0); } }
    float c0 = carry;
    if (HAS1) { const float t1 = D1[0] - z1r0; const auto rr = __builtin_amdgcn_permlane32_swap(__float_as_uint(t1), __float_as_uint(t1), false, false); c0 = carry + __uint_as_float(rr[0]); }
    const float t0 = D0[0] - z0r0; const auto rr0 = __builtin_amdgcn_permlane32_swap(__float_as_uint(t0), __float_as_uint(t0), false, false);
    float P1[16], P0[16];
#pragma unroll
    for (int i = 0; i < 16; ++i) { if (HAS1) P1[i] = __builtin_amdgcn_exp2f(D1[i] + carry); P0[i] = __builtin_amdgcn_exp2f(D0[i] + c0); }
    carry = c0 + __uint_as_float(rr0[0]);
#pragma unroll
    for (int ks = 3; ks >= 0; --ks) {
        if (ks >= 2 && !HAS1) continue;
        u32x4 w;
#pragma unroll
        for (int j = 0; j < 4; ++j) { const int e = 8 * (ks & 1) + 2 * j; w[j] = (ks >= 2) ? cvtpk_bf16(P1[e], P1[e + 1]) : cvtpk_bf16(P0[e], P0[e + 1]); }
        const bf16x8 pf = __builtin_bit_cast(bf16x8, w);
#pragma unroll
        for (int d0 = 0; d0 < 2; ++d0) { const LAS unsigned char* vp = Vslot + d0 * 4096 + ks * 1024 + ((lane >> 4) & 1) * 32 + (lane & 3) * 8 + (4 * hi + ((lane & 15) >> 2)) * 64;
            const s16x4 lo = vtr(vp), hh = vtr(vp + 512);
            const bf16x8 vf = (bf16x8){lo[0], lo[1], lo[2], lo[3], hh[0], hh[1], hh[2], hh[3]};
            oT[d0] = __builtin_amdgcn_mfma_f32_32x32x16_bf16(vf, pf, oT[d0], 0, 0, 0); } }
}
__device__ __forceinline__ void glds16(const void* gsrc, unsigned lds_dst) { unsigned keep;
    asm volatile("s_mov_b32 %0, m0\n\ts_mov_b32 m0, %2\n\ts_nop 0\n\tglobal_load_lds_dwordx4 %1, off\n\ts_mov_b32 m0, %0" : "=&s"(keep) : "v"(gsrc), "s"(lds_dst) : "memory"); }
#define SBA_DMA(t_, sl_) do { \
    glds16(ksrc + (size_t)(t_) * 64 * NPROJ, (unsigned)__builtin_amdgcn_readfirstlane(lds0 + LDS_K + (sl_) * SLOTB + wave * 1024)); \
    glds16(vsrc + (size_t)(t_) * 64 * NPROJ, (unsigned)__builtin_amdgcn_readfirstlane(lds0 + LDS_V + (sl_) * SLOTB + wave * 1024)); } while (0)
__device__ __forceinline__ void attn_phase(const bf16* PROJ, bf16* MIX, LAS unsigned char* lds, int blk, int G) {
    PHASE_IDS();
    const int r32 = lane & 31, hi = lane >> 5;
    const unsigned lds0 = (unsigned)(uintptr_t)lds;
    LAS unsigned* flg = (LAS unsigned*)(lds + LDS_BYTES_ATT);
    f16x8 tri[2];
#pragma unroll
    for (int s = 0; s < 2; ++s)
#pragma unroll
        for (int j = 0; j < 8; ++j) tri[s][j] = (16 * s + 8 * (j >> 2) + 4 * hi + (j & 3) >= r32) ? (_Float16)(-1.0f) : (_Float16)0.0f;
    int s0 = 0, s1 = 1, s2 = 2;
    int p0 = 3, p1 = 4;
    for (int bh = blk; bh < BATCH * 8; bh += G) {
        const int b = bh >> 3, h = bh & 7;
        const bf16* Kh = PROJ + (size_t)b * SEQ * NPROJ + 512 + h * 64; const bf16* Vh = PROJ + (size_t)b * SEQ * NPROJ + 1024 + h * 64;
        const bf16* ksrc = Kh + (size_t)lane * NPROJ + wave * 8;
        const bf16* vsrc = Vh + (size_t)(16 * (wave & 3) + (lane >> 2)) * NPROJ + (wave >> 2) * 32 + (lane & 3) * 8;
        SBA_DMA(3, s0); SBA_DMA(2, s1);
        bf16x8 qr[4], qn[4];
        { const bf16* qp = PROJ + ((size_t)b * SEQ + wave * 32 + r32) * NPROJ + h * 64 + hi * 8;
#pragma unroll
          for (int d0 = 0; d0 < 4; ++d0) qr[d0] = *(const GAS bf16x8*)(qp + d0 * 16); }
        asm volatile("" : "+v"(qr[0]), "+v"(qr[1]), "+v"(qr[2]), "+v"(qr[3]));
        for (int qb = 0; qb < SEQ / 256; ++qb) {
            const int q0w = qb * 256 + wave * 32, NT = 4 * (qb + 1);
            f32x16 oT[2];
#pragma unroll
            for (int i = 0; i < 16; ++i) { oT[0][i] = 0.f; oT[1][i] = 0.f; }
            float carry = 0.f;
            bool mydone = false;
            for (int t = NT - 1; t >= 0; --t) {
                if (t == NT - 1 && qb > 0) asm volatile("s_waitcnt lgkmcnt(0)\n\ts_barrier" ::: "memory");
                else if (t >= 1) asm volatile("s_waitcnt vmcnt(2) lgkmcnt(0)\n\ts_barrier" ::: "memory"); else asm volatile("s_waitcnt vmcnt(0) lgkmcnt(0)\n\ts_barrier" ::: "memory");
                if (t < NT - 1) { const LAS u32x4* fp = (const LAS u32x4*)(flg + ((t + 1) & 1) * 8); const u32x4 fa = fp[0], fb = fp[1];
                    const unsigned all8 = (fa.x & fa.y & fa.z & fa.w) & (fb.x & fb.y & fb.z & fb.w);
                    if (__builtin_amdgcn_readfirstlane((int)all8) != 0) break; }
                if (t == NT - 1 && qb + 1 < SEQ / 256) {
                    SBA_DMA(NT + 3, p0); SBA_DMA(NT + 2, p1);
                    const bf16* qp = PROJ + ((size_t)b * SEQ + q0w + 256 + r32) * NPROJ + h * 64 + hi * 8;
#pragma unroll
                    for (int d0 = 0; d0 < 4; ++d0) qn[d0] = *(const GAS bf16x8*)(qp + d0 * 16); }
                if (t >= 2) SBA_DMA(t - 2, s2);
                const LAS unsigned char* Kslot = lds + LDS_K + s0 * SLOTB; const LAS unsigned char* Vslot = lds + LDS_V + s0 * SLOTB;
                const int khi = 64 * t + 32;
                if (!mydone) {
                    if (khi < q0w) tile64<0>(oT, carry, qr, tri, Kslot, Vslot, r32, hi, lane);
                    else if (khi == q0w) tile64<1>(oT, carry, qr, tri, Kslot, Vslot, r32, hi, lane);
                    else if (khi == q0w + 32) tile64<2>(oT, carry, qr, tri, Kslot, Vslot, r32, hi, lane);
                    mydone = __all(carry < SBA_DEAD) != 0;
                }
                if (lane == 0) flg[(t & 1) * 8 + wave] = mydone ? 1u : 0u;
                { const int tmp = s0; s0 = s1; s1 = s2; s2 = tmp; }
            }
            { bf16* op = MIX + ((size_t)b * SEQ + q0w + r32) * D + h * 64 + 4 * hi;
#pragma unroll
              for (int d0 = 0; d0 < 2; ++d0)
#pragma unroll
                  for (int g = 0; g < 4; ++g) { v2u w; w.x = cvtpk_bf16(oT[d0][4 * g], oT[d0][4 * g + 1]); w.y = cvtpk_bf16(oT[d0][4 * g + 2], oT[d0][4 * g + 3]);
                      *(GAS v2u*)(op + 32 * d0 + 8 * g) = w; } }
            if (qb + 1 < SEQ / 256) {
                asm volatile("" : "+v"(qn[0]), "+v"(qn[1]), "+v"(qn[2]), "+v"(qn[3]));
#pragma unroll
                for (int d0 = 0; d0 < 4; ++d0) qr[d0] = qn[d0];
                const int o0 = s0, o1 = s1; s0 = p0; s1 = p1; p0 = o0; p1 = o1;
            }
        }
    }
    asm volatile("s_waitcnt vmcnt(0) lgkmcnt(0)" ::: "memory");
    __syncthreads();
}
#undef SBA_DMA
}
__device__ __forceinline__ void gmlp_simple(const bf16* PROJ, bf16* MIX, const float* lng, const float* lnb, const float* Wsp, const float* bsp,
                                            LAS unsigned char* lds, int blk, int G) {
    PHASE_IDS();
    LAS float* stats = (LAS float*)(lds + RING_OFF); LAS float* vln = stats + 256; LAS float* Wt = vln + 128 * 64;
    for (int u = blk; u < BATCH * 16; u += G) {
        const size_t row0 = (size_t)(u >> 4) * SEQ + (u & 15) * 128;
        __syncthreads();
        for (int tt = 0; tt < 16; ++tt) { const int tok = wave * 16 + tt;
            const v4u raw = *(const GAS v4u*)(PROJ + (row0 + tok) * NPROJ + 2048 + lane * 8); float v[8]; float s = 0.f;
#pragma unroll
            for (int i = 0; i < 4; ++i) { v[2 * i] = bflo(raw[i]); v[2 * i + 1] = bfhi(raw[i]); s += v[2 * i] + v[2 * i + 1]; }
            const float mean = wave_sum(s) * (1.0f / 512.0f); float s2 = 0.f;
#pragma unroll
            for (int i = 0; i < 8; ++i) { const float d = v[i] - mean; s2 += d * d; }
            const float rstd = 1.0f / sqrtf(wave_sum(s2) * (1.0f / 512.0f) + EPS);
            if (lane == 0) { stats[2 * tok] = mean; stats[2 * tok + 1] = rstd; } }
        for (int g = 0; g < 8; ++g) {
            __syncthreads();
            { const int tok = tid >> 2, cb = (tid & 3) * 16; const GAS v4u* vp = (const GAS v4u*)(PROJ + (row0 + tok) * NPROJ + 2048 + g * 64 + cb);
              const float mean = stats[2 * tok], rstd = stats[2 * tok + 1];
#pragma unroll
              for (int hh = 0; hh < 2; ++hh) { const v4u raw = vp[hh];
#pragma unroll
                  for (int e = 0; e < 4; ++e) { const int c = g * 64 + cb + hh * 8 + 2 * e;
                      vln[tok * 64 + cb + hh * 8 + 2 * e] = (bflo(raw[e]) - mean) * rstd * lng[c] + lnb[c];
                      vln[tok * 64 + cb + hh * 8 + 2 * e + 1] = (bfhi(raw[e]) - mean) * rstd * lng[c + 1] + lnb[c + 1]; } } }
            { const int i = tid & 127, jq = tid >> 7;
#pragma unroll
              for (int jj = 0; jj < 8; ++jj) { const int j4 = (jq * 8 + jj) * 4; f32x4 w = *(const f32x4*)(Wsp + ((size_t)g * 128 + i) * 128 + j4);
                  if (i < 64 && j4 >= 64) w = (f32x4){0.f, 0.f, 0.f, 0.f};
                  Wt[(j4 + 0) * 132 + i] = w.x; Wt[(j4 + 1) * 132 + i] = w.y; Wt[(j4 + 2) * 132 + i] = w.z; Wt[(j4 + 3) * 132 + i] = w.w; } }
            __syncthreads();
            const int tc = tid & 15, ti = tid >> 4; float acc[4][4];
#pragma unroll
            for (int r = 0; r < 4; ++r)
#pragma unroll
                for (int c = 0; c < 4; ++c) acc[r][c] = 0.f;
            const int jmax = (wave < 4) ? 64 : 128;
            for (int j = 0; j < jmax; ++j) { const f32x4 a = *(const LAS f32x4*)(vln + j * 64 + 4 * tc); const f32x4 w = *(const LAS f32x4*)(Wt + j * 132 + 4 * ti);
#pragma unroll
                for (int r = 0; r < 4; ++r)
#pragma unroll
                    for (int c = 0; c < 4; ++c) acc[r][c] += w[r] * a[c]; }
#pragma unroll
            for (int r = 0; r < 4; ++r) { const int i = 4 * ti + r; const float bias = bsp[g * 128 + i];
                const v2u ur = *(const GAS v2u*)(PROJ + (row0 + i) * NPROJ + 1536 + g * 64 + 4 * tc);
                v2u o; o.x = pk2((acc[r][0] + bias) * bflo(ur.x), (acc[r][1] + bias) * bfhi(ur.x)); o.y = pk2((acc[r][2] + bias) * bflo(ur.y), (acc[r][3] + bias) * bfhi(ur.y));
                *(GAS v2u*)(MIX + (row0 + i) * D + 512 + g * 64 + 4 * tc) = o; }
        }
    }
    __syncthreads();
}
__device__ __forceinline__ void p0_spatial(const Args& P, int blk, int G) {
    PHASE_IDS();
    bf16* GW = (bf16*)(P.ws + WS_GW); const float* W = P.in[11];
    for (int idx = blk * (NWAVES * 64) + tid; idx < 2 * 8 * 128 * 128; idx += G * NWAVES * 64) {
        const int p = idx & 127, i = (idx >> 7) & 127, ks = p >> 4, hh = (p >> 3) & 1, jj = p & 7, j = 16 * ks + 8 * (jj >> 2) + 4 * hh + (jj & 3);
        const float w = ((j >> 6) <= (i >> 6)) ? W[(size_t)(idx & ~127) + j] : 0.f;
        GW[idx] = (bf16)f2bf(w); }
}
__device__ __forceinline__ void gmlp_phase(const bf16* PROJ, bf16* MIX, const float* lng, const float* lnb, const bf16* GW, const float* bsp, LAS unsigned char* lds, int blk, int G) {
    PHASE_IDS();
    typedef short bf16x8 __attribute__((ext_vector_type(8))); typedef float f32x16 __attribute__((ext_vector_type(16)));
    const int r32 = lane & 31, hi = lane >> 5, mi = wave >> 1, ci = wave & 1;
    for (int u = blk; u < BATCH * 16; u += G) {
        const size_t row0 = (size_t)(u >> 4) * SEQ + (u & 15) * 128;
        float gam[8], bet[8];
#pragma unroll
        for (int i = 0; i < 8; ++i) { gam[i] = lng[lane * 8 + i]; bet[i] = lnb[lane * 8 + i]; }
        __syncthreads();
        v4u rawn[4];
#pragma unroll
        for (int q = 0; q < 4; ++q) rawn[q] = *(const GAS v4u*)(PROJ + (row0 + wave * 16 + q) * NPROJ + 2048 + lane * 8);
#pragma unroll 1
        for (int tb = 0; tb < 16; tb += 4) {
            v4u raw4[4];
#pragma unroll
            for (int q = 0; q < 4; ++q) raw4[q] = rawn[q];
            if (tb + 4 < 16) {
#pragma unroll
                for (int q = 0; q < 4; ++q) rawn[q] = *(const GAS v4u*)(PROJ + (row0 + wave * 16 + tb + 4 + q) * NPROJ + 2048 + lane * 8); }
#pragma unroll
            for (int q = 0; q < 4; ++q) { const int tt = tb + q; const v4u raw = raw4[q]; float v[8]; float s = 0.f;
#pragma unroll
                for (int i = 0; i < 4; ++i) {
#ifdef GELU_IN_PROJ
                    v[2 * i] = bflo(raw[i]); v[2 * i + 1] = bfhi(raw[i]);
#else
                    const pg8::f32x2 ge = pg8::gelu_pk((pg8::f32x2){bflo(raw[i]), bfhi(raw[i])}); v[2 * i] = ge.x; v[2 * i + 1] = ge.y;
#endif
                    s += v[2 * i] + v[2 * i + 1]; }
                const float mean = wave_sum(s) * (1.0f / 512.0f); float s2 = 0.f;
#pragma unroll
                for (int i = 0; i < 8; ++i) { v[i] -= mean; s2 += v[i] * v[i]; }
                const float rstd = 1.0f / sqrtf(wave_sum(s2) * (1.0f / 512.0f) + EPS);
                v4u o;
#pragma unroll
                for (int i = 0; i < 4; ++i) o[i] = pk2(v[2 * i] * rstd * gam[2 * i] + bet[2 * i], v[2 * i + 1] * rstd * gam[2 * i + 1] + bet[2 * i + 1]);
                *(LAS v4u*)(lds + RING_OFF + (((lane >> 3) * 2 + ((lane >> 2) & 1)) * 8 + wave) * 1024 + tt * 64 + (lane & 3) * 16) = o; } }
        __syncthreads();
        const int nks = (mi < 2) ? 4 : 8;
        const LAS unsigned char* vb = lds + RING_OFF + ((lane >> 4) & 1) * 32 + (lane & 3) * 8 + (4 * hi + ((lane & 15) >> 2)) * 64;
        const int tokr = mi * 32 + r32;
        bf16x8 wfA[8], wfB[8]; v2u urA[4], urB[4]; float biasA = 0.f, biasB = 0.f;
#define GM_LOAD(g_, W_, U_, B_) do { const bf16* wrow_ = GW + ((size_t)(g_) * 128 + mi * 32 + r32) * 128 + hi * 8; \
            _Pragma("unroll") for (int ks = 0; ks < 8; ++ks) W_[ks] = *(const GAS bf16x8*)(wrow_ + ks * 16);     \
            const bf16* up_ = PROJ + (row0 + tokr) * NPROJ + 1536 + (g_) * 64 + ci * 32 + 4 * hi; \
            _Pragma("unroll") for (int gg = 0; gg < 4; ++gg) U_[gg] = *(const GAS v2u*)(up_ + 8 * gg); \
            B_ = bsp[(g_) * 128 + tokr]; } while (0)
#define GM_COMP(g_, W_, U_, B_) do { f32x16 acc; _Pragma("unroll") for (int i = 0; i < 16; ++i) acc[i] = 0.f; \
            _Pragma("unroll") for (int ks = 0; ks < 8; ++ks) if (ks < nks) { const LAS unsigned char* vp = vb + (((g_) * 2 + ci) * 8 + ks) * 1024; \
                const sba::s16x4 lo = sba::vtr(vp), hh = sba::vtr(vp + 512); const bf16x8 vf = (bf16x8){lo[0], lo[1], lo[2], lo[3], hh[0], hh[1], hh[2], hh[3]}; \
                acc = __builtin_amdgcn_mfma_f32_32x32x16_bf16(vf, W_[ks], acc, 0, 0, 0); } \
            bf16* op = MIX + (row0 + tokr) * D + 512 + (g_) * 64 + ci * 32 + 4 * hi; \
            _Pragma("unroll") for (int gg = 0; gg < 4; ++gg) { const v2u ur = U_[gg]; \
                const pg8::f32x2 ga = pg8::gelu_pk((pg8::f32x2){bflo(ur.x), bfhi(ur.x)}), gb = pg8::gelu_pk((pg8::f32x2){bflo(ur.y), bfhi(ur.y)}); \
                v2u o; o.x = pk2((acc[4 * gg] + B_) * ga.x, (acc[4 * gg + 1] + B_) * ga.y); o.y = pk2((acc[4 * gg + 2] + B_) * gb.x, (acc[4 * gg + 3] + B_) * gb.y); \
                *(GAS v2u*)(op + 8 * gg) = o; } } while (0)
        GM_LOAD(0, wfA, urA, biasA);
#pragma unroll 1
        for (int g = 0; g < 8; g += 2) {
            GM_LOAD(g + 1, wfB, urB, biasB);
            GM_COMP(g, wfA, urA, biasA);
            { const int g2 = (g + 2 < 8) ? g + 2 : 0; GM_LOAD(g2, wfA, urA, biasA); }
            GM_COMP(g + 1, wfB, urB, biasB);
        }
#undef GM_LOAD
#undef GM_COMP
    }
    __syncthreads();
}
__device__ __forceinline__ void moe_tables(const int* pcnt, LAS int* MT, LAS int* stage  , int p, int tid, bool first) {
    __syncthreads();
    if (first) { for (int i = tid; i < 4096; i += NWAVES * 64) stage[i] = pcnt[i]; }
    __syncthreads();
    if (tid < 16) { LAS int* M = MT + (tid >> 3) * MT_STRIDE; const int ee = tid & 7; int sacc = 0, pb = 0;
#pragma unroll 16
        for (int q = 0; q < 256; ++q) { if (q == p) pb = sacc; sacc += stage[q * 16 + tid]; }
        M[MT_TOT + ee] = sacc; M[MT_PBASE + ee] = pb; }
    __syncthreads();
    if (first) {
        if (tid == 0 || tid == 64) { LAS int* M = MT + (tid >> 6) * MT_STRIDE; int o = 0;
            for (int e = 0; e < 8; ++e) { M[MT_POFF + e] = o; o += ((M[MT_TOT + e] + 255) >> 8) << 8; }
            M[MT_POFF + 8] = o; M[MT_NT] = o >> 8; }
        __syncthreads();
#pragma unroll
        for (int k = 0; k < 2; ++k) { LAS int* M = MT + k * MT_STRIDE; LAS unsigned char* tile_e = (LAS unsigned char*)(M + MT_TILE); const int nt = M[MT_NT];
            for (int t = tid; t < nt; t += NWAVES * 64) { const int r = t * 256; int e = 0;
#pragma unroll
                for (int ee = 1; ee < 8; ++ee) if (r >= M[MT_POFF + ee]) e = ee;
                tile_e[t] = (unsigned char)e; } }
        __syncthreads();
    }
}
__device__ __forceinline__ void moe_gather2(const bf16* HB, unsigned char* XS, const int* pcnt, const int* tok_e, const int* tok_rank, const float* tok_gate, int* slot_tok, float* slot_gate,
                                            LAS int* MT, LAS unsigned char* lds, int blk, int G) {
    PHASE_IDS();
    LAS int* stage = (LAS int*)(lds + RING_OFF);
    moe_tables(pcnt, MT, stage, blk < T / 256 ? blk : 0, tid, true);
    if (blk == 0) {
        for (int k = 0; k < 2; ++k) { LAS int* M = MT + k * MT_STRIDE;
            for (int e = 0; e < 8; ++e) for (int s = M[MT_POFF + e] + M[MT_TOT + e] + tid; s < M[MT_POFF + e + 1]; s += NWAVES * 64) slot_tok[k * MAXTILES * 256 + s] = -1; }
    }
    for (int p = blk; p < T / 256; p += G) {
        if (p != blk) moe_tables(pcnt, MT, stage, p, tid, false);
        int myslot;
        { const int tj = p * 256 + wave * 32 + (lane >> 1), kj = lane & 1; const LAS int* M = MT + kj * MT_STRIDE;
          const int e = tok_e[tj * 2 + kj]; const int rk = tok_rank[tj * 2 + kj]; const float gt = tok_gate[tj * 2 + kj];
          myslot = kj * MAXTILES * 256 + M[MT_POFF + e] + M[MT_PBASE + e] + rk;
          slot_tok[myslot] = tj; slot_gate[myslot] = gt; }
#pragma unroll
        for (int r0 = 0; r0 < 32; r0 += 16) {
            v4u rowv[16];
#pragma unroll
            for (int q = 0; q < 16; ++q) rowv[q] = ((const GAS v4u*)((const unsigned char*)HB + (size_t)(p * 256 + wave * 32 + r0 + q) * D))[lane];
#pragma unroll
            for (int q = 0; q < 16; ++q) { const int sa = __shfl(myslot, 2 * (r0 + q)), sb = __shfl(myslot, 2 * (r0 + q) + 1);
                ((GAS v4u*)(XS + (size_t)sa * D))[lane] = rowv[q]; ((GAS v4u*)(XS + (size_t)sb * D))[lane] = rowv[q]; }
        }
    }
    __syncthreads();
}

template <bool OUT_F32>
__device__ __forceinline__ void moe_tail_combine(int k, const float* S, const bf16* xb, bf16* xbo, float* xf, const float* gate, const int* slot_tok, const float* slot_gate, LAS int* MT, int nsl, int blk, int G) {
    PHASE_IDS();
    const int ntk = MT[k * MT_STRIDE + MT_NT]; const int nwg = ntk * (D / 256); int full = (nwg / G) * G, ntail = nwg - full;
    if (ntail > 32) { full = nwg; ntail = 0; }
    pg8::StaticOrder SO; SO.init(ntk * 256, D, G, 0);
    const int gw = blk * NWAVES + wave, NGW = G * NWAVES;
    for (int idx = gw; idx < ntail * 256; idx += NGW) { const int q = idx >> 8, r = idx & 255;
        pg8::Unit u; SO.map(full + q, u); const int pmr = k * MAXTILES + u.pm;
        const int slot = pmr * 256 + r; const int tok = slot_tok[slot];
        if (tok < 0) continue;
        const float sg = slot_gate[slot]; const int col = u.pn * 256 + 4 * lane;
        f32x4 a = (f32x4){0.f, 0.f, 0.f, 0.f};
        for (int sl = 0; sl < nsl; ++sl) a += *(const f32x4*)(S + ((size_t)(q * nsl + sl) * 256 + r) * 256 + 4 * lane);
        const f32x4 g4 = *(const f32x4*)(gate + (size_t)(tok >> 11) * ADA + col);
        const v2u xw = *(const GAS v2u*)(xb + (size_t)tok * D + col);
        const f32x4 r4 = (f32x4){bflo(xw.x), bfhi(xw.x), bflo(xw.y), bfhi(xw.y)} + (g4 * sg) * a;
        if (OUT_F32) *(f32x4*)(xf + (size_t)tok * D + col) = r4;
        else { v2u o; o.x = pk2(r4[0], r4[1]); o.y = pk2(r4[2], r4[3]); *(GAS v2u*)(xbo + (size_t)tok * D + col) = o; } }
}

#ifndef SKIPMASK
#define SKIPMASK 0u
#endif
#define PH_ON(x) (((SKIPMASK) & (1u << (x))) == 0u)
#ifndef DBLMASK
#define DBLMASK 0u
#endif
#define PH_REP(x) for (int rep_ = 0; rep_ < ((((DBLMASK) >> (x)) & 1u) ? 2 : 1); ++rep_)
#define GRID_BAR() xcd_barrier(bar)
#define WS_() opaque_ptr(args.ws)
#define WG_SYNC() do { asm volatile("s_waitcnt vmcnt(0) lgkmcnt(0)" ::: "memory"); __syncthreads(); } while (0)
#ifndef PANEL_ORDER
typedef pg8::StaticOrder ChainOrder;
#define CHAIN_SYNC() GRID_BAR()
#else
typedef pg8::PanelOrder ChainOrder;
#define CHAIN_SYNC() WG_SYNC()
#endif
constexpr int MOE_NSL = 7, MOE_KSL = (DE / 2) / MOE_NSL;
__device__ __forceinline__ void moe_tail_split(int ntk, int G, int& full, int& ntail) { const int nwg = ntk * (D / 256); full = (nwg / G) * G; ntail = nwg - full; if (ntail > 32) { full = nwg; ntail = 0; } }
template <int K, int L>
__device__ __forceinline__ void moe_down_main(const Args& args, LAS unsigned char* lds, LAS int* MT, int blk, int G) {
    unsigned char* ws = WS_(); const int ntk = MT[K * MT_STRIDE + MT_NT]; int full, ntail; moe_tail_split(ntk, G, full, ntail);
    pg8::Gemm g{(const bf16*)(ws + WS_ACTM), (const bf16*)(ws + WS_MWD), ntk * 256, D, DE / 2, 0}; pg8::MoeOrder2L S; S.init(ntk * 256, D, G, blk);
    S.tile_e0 = (const LAS unsigned char*)(MT + MT_TILE); S.tile_e1 = (const LAS unsigned char*)(MT + MT_STRIDE + MT_TILE); S.ne_tiles = D / 256; S.nt0 = (K == 0) ? ntk : 0; S.base1 = MAXTILES; S.limit = full;
    pg8::EpiMoeDownB<(K == 1)> E{(const bf16*)(ws + WS_XB), (bf16*)(ws + WS_XB), args.out, (const bf16*)(ws + WS_G16), (const int*)(ws + WS_SLOTT), (const float*)(ws + WS_SLOTG)};
    pg8::gemm_phase<pg8::EpiMoeDownB<(K == 1)>, pg8::MoeOrder2L, true, true>(lds + RING_OFF, g, S, E);
}
template <int K>
__device__ __forceinline__ void moe_down_slices(const Args& args, LAS unsigned char* lds, LAS int* MT, int blk, int G) {
    unsigned char* ws2 = WS_(); const int ntk = MT[K * MT_STRIDE + MT_NT]; int full, ntail; moe_tail_split(ntk, G, full, ntail);
    if (ntail > 0) {
        pg8::Gemm g{(const bf16*)(ws2 + WS_ACTM), (const bf16*)(ws2 + WS_MWD), ntk * 256, D, MOE_KSL, DE / 2}; pg8::MoeTail2 S; S.init(ntk * 256, D, G, blk);
        S.tile_e0 = (const LAS unsigned char*)(MT + MT_TILE); S.tile_e1 = (const LAS unsigned char*)(MT + MT_STRIDE + MT_TILE); S.ne_tiles = D / 256; S.nt0 = (K == 0) ? ntk : 0; S.base1 = MAXTILES;
        S.base = full; S.ntail = ntail; S.nsl = MOE_NSL; S.ksl_bytes = MOE_KSL * 2;
        pg8::EpiTileF32F8 E{(float*)(ws2 + WS_XS) + (size_t)K * 32 * MOE_NSL * 65536};
        pg8::gemm_phase<pg8::EpiTileF32F8, pg8::MoeTail2, true, true>(lds + RING_OFF, g, S, E); }
}
template <int K, int L>
__device__ __forceinline__ void moe_down_combine(const Args& args, LAS int* MT, int blk, int G) {
    unsigned char* ws = WS_();
    moe_tail_combine<(K == 1)>(K, (const float*)(ws + WS_XS) + (size_t)K * 32 * MOE_NSL * 65536, (const bf16*)(ws + WS_XB), (bf16*)(ws + WS_XB), args.out,
                               (const float*)(ws + WS_ADA) + (size_t)L * 32 * ADA + 5 * D, (const int*)(ws + WS_SLOTT), (const float*)(ws + WS_SLOTG), MT, MOE_NSL, blk, G);
}
#define WS_() opaque_ptr(args.ws)
#define WG_SYNC() do { asm volatile("s_waitcnt vmcnt(0) lgkmcnt(0)" ::: "memory"); __syncthreads(); } while (0)
#ifndef PANEL_ORDER
typedef pg8::StaticOrder ChainOrder;
#define CHAIN_SYNC() GRID_BAR()
#else
typedef pg8::PanelOrder ChainOrder;
#define CHAIN_SYNC() WG_SYNC()
#endif
template <int K, int L>
__device__ __forceinline__ void moe_down_half(const Args& args, const XcdBarrier& bar, LAS unsigned char* lds, LAS int* MT, int blk, int G) {
    constexpr int NSL = 7, KSL = (DE / 2) / NSL;
    if (PH_ON(14)) { unsigned char* ws = WS_(); const int ntk = MT[K * MT_STRIDE + MT_NT];
      const int nwg = ntk * (D / 256); int full = (nwg / G) * G, ntail = nwg - full;
      if (ntail > 32) { full = nwg; ntail = 0; }
      { pg8::Gemm g{(const bf16*)(ws + WS_ACTM), (const bf16*)(ws + WS_MWD), ntk * 256, D, DE / 2, 0}; pg8::MoeOrder2L S; S.init(ntk * 256, D, G, blk);
        S.tile_e0 = (const LAS unsigned char*)(MT + MT_TILE); S.tile_e1 = (const LAS unsigned char*)(MT + MT_STRIDE + MT_TILE); S.ne_tiles = D / 256; S.nt0 = (K == 0) ? ntk : 0; S.base1 = MAXTILES; S.limit = full;
        pg8::EpiMoeDownB<(K == 1)> E{(const bf16*)(ws + WS_XB), (bf16*)(ws + WS_XB), args.out, (const bf16*)(ws + WS_G16), (const int*)(ws + WS_SLOTT), (const float*)(ws + WS_SLOTG)};
        pg8::gemm_phase<pg8::EpiMoeDownB<(K == 1)>, pg8::MoeOrder2L, true, true>(lds + RING_OFF, g, S, E); }
      if (ntail > 0) { unsigned char* ws2 = WS_();
        pg8::Gemm g{(const bf16*)(ws2 + WS_ACTM), (const bf16*)(ws2 + WS_MWD), ntk * 256, D, KSL, DE / 2}; pg8::MoeTail2 S; S.init(ntk * 256, D, G, blk);
        S.tile_e0 = (const LAS unsigned char*)(MT + MT_TILE); S.tile_e1 = (const LAS unsigned char*)(MT + MT_STRIDE + MT_TILE); S.ne_tiles = D / 256; S.nt0 = (K == 0) ? ntk : 0; S.base1 = MAXTILES;
        S.base = full; S.ntail = ntail; S.nsl = NSL; S.ksl_bytes = KSL * 2;
        pg8::EpiTileF32F8 E{(float*)(ws2 + WS_XS) + (size_t)K * 32 * NSL * 65536};
        pg8::gemm_phase<pg8::EpiTileF32F8, pg8::MoeTail2, true, true>(lds + RING_OFF, g, S, E); } }
    GRID_BAR();
    if (PH_ON(14)) { unsigned char* ws = WS_();
      moe_tail_combine<(K == 1)>(K, (const float*)(ws + WS_XS) + (size_t)K * 32 * NSL * 65536, (const bf16*)(ws + WS_XB), (bf16*)(ws + WS_XB), args.out,
                                 (const float*)(ws + WS_ADA) + (size_t)L * 32 * ADA + 5 * D, (const int*)(ws + WS_SLOTT), (const float*)(ws + WS_SLOTG), MT, NSL, blk, G); }
}
template <int L>
__device__ __forceinline__ void layer_body(const Args& args, const XcdBarrier& bar, LAS unsigned char* lds, int blk, int G) {
    LAS int* MT = (LAS int*)(lds + MOE_OFF);
    PH_REP(2) if (PH_ON(2)) { unsigned char* ws = WS_();
        if constexpr (L == 0) norm_phase<false>(args.in[0], args.in[4] + L * D, (const float*)(ws + WS_ADA) + (size_t)L * 32 * ADA, 1 * D, 0 * D, (bf16*)(ws + WS_HB),
                          nullptr, nullptr, nullptr, nullptr, nullptr, nullptr, lds, blk, G);
        else norm_phase<false, false, true>((const float*)(ws + WS_XB), args.in[4] + L * D, (const float*)(ws + WS_ADA) + (size_t)L * 32 * ADA, 1 * D, 0 * D, (bf16*)(ws + WS_HB),
                          nullptr, nullptr, nullptr, nullptr, nullptr, nullptr, lds, blk, G); }
    CHAIN_SYNC();
    PH_REP(3) if (PH_ON(3)) { unsigned char* ws = WS_();
      pg8::Gemm g{(const bf16*)(ws + WS_HB), (const bf16*)(ws + WS_WIN) + (size_t)L * NPROJ * D, T, NPROJ, D}; ChainOrder S; S.init(T, NPROJ, G, blk);
      pg8::EpiProjQK E{(bf16*)(ws + WS_BIG), args.in[7] + L * 64, args.in[8] + L * 64, C2, EPS};
      pg8::gemm_phase<pg8::EpiProjQK, ChainOrder, true, true>(lds + RING_OFF, g, S, E); }
    GRID_BAR();
    PH_REP(5) if (PH_ON(5)) { unsigned char* ws = WS_();
        sba::attn_phase((const bf16*)(ws + WS_BIG), (bf16*)(ws + WS_HB), lds, blk, G); }
    PH_REP(6) if (PH_ON(6)) { unsigned char* ws = WS_();
        gmlp_phase((const bf16*)(ws + WS_BIG), (bf16*)(ws + WS_HB), args.in[9] + L * 512, args.in[10] + L * 512, (const bf16*)(ws + WS_GW) + (size_t)L * 8 * 128 * 128, args.in[12] + L * 8 * 128, lds, blk, G); }
    GRID_BAR();
    if (PH_ON(7)) { unsigned char* ws = WS_();
      pg8::Gemm g{(const bf16*)(ws + WS_HB), (const bf16*)(ws + WS_WOUT) + (size_t)L * D * D, T, D, D}; ChainOrder S; S.init(T, D, G, blk);
      if constexpr (L == 0) { pg8::EpiResidB<true, false> E{(const void*)args.in[0], (bf16*)(ws + WS_XB), (const float*)(ws + WS_ADA) + (size_t)L * 32 * ADA + 2 * D};
        pg8::gemm_phase<pg8::EpiResidB<true, false>, ChainOrder, true, true>(lds + RING_OFF, g, S, E); }
      else { pg8::EpiResidB<false, false> E{(const void*)(ws + WS_XB), (bf16*)(ws + WS_XB), (const float*)(ws + WS_ADA) + (size_t)L * 32 * ADA + 2 * D};
        pg8::gemm_phase<pg8::EpiResidB<false, false>, ChainOrder, true, true>(lds + RING_OFF, g, S, E); } }
    CHAIN_SYNC();
    if constexpr (L == 0) {
        if (PH_ON(8)) { unsigned char* ws = WS_();
            norm_phase<false, (FFN_GU_FP8 != 0), true>((const float*)(ws + WS_XB), args.in[5] + L * D, (const float*)(ws + WS_ADA) + (size_t)L * 32 * ADA, 4 * D, 3 * D, (bf16*)(ws + WS_HB),
                              nullptr, nullptr, nullptr, nullptr, nullptr, nullptr, lds, blk, G); }
        CHAIN_SYNC();
        PH_REP(9) if (PH_ON(9)) { unsigned char* ws = WS_();
#if FFN_GU_FP8
          pg8::Gemm g{(const bf16*)(ws + WS_HB), (const bf16*)(ws + WS_WGU), T, 2 * FF, D / 2, 0}; ChainOrder S; S.init(T, 2 * FF, G, blk);
          typedef pg8::EpiSwigluX<true, (FFN_DOWN_FP8 != 0)> EpiGU; EpiGU E{ws + WS_ACT, FF};
          pg8::gemm_phase<EpiGU, ChainOrder, true, true>(lds + RING_OFF, g, S, E); }
#elif FFN_DOWN_FP8
          pg8::Gemm g{(const bf16*)(ws + WS_HB), (const bf16*)(ws + WS_WGU), T, 2 * FF, D}; ChainOrder S; S.init(T, 2 * FF, G, blk);
          pg8::EpiSwigluO8 E{ws + WS_ACT, FF};
          pg8::gemm_phase<pg8::EpiSwigluO8, ChainOrder, true, true>(lds + RING_OFF, g, S, E); }
#else
          pg8::Gemm g{(const bf16*)(ws + WS_HB), (const bf16*)(ws + WS_WGU), T, 2 * FF, D}; ChainOrder S; S.init(T, 2 * FF, G, blk);
          pg8::EpiSwiglu E{(bf16*)(ws + WS_ACT), FF};
          pg8::gemm_phase<pg8::EpiSwiglu, ChainOrder, true, true>(lds + RING_OFF, g, S, E); }
#endif
        CHAIN_SYNC();
        if (PH_ON(10)) { unsigned char* ws = WS_();
#if FFN_DOWN_FP8
          pg8::Gemm g{(const bf16*)(ws + WS_ACT), (const bf16*)(ws + WS_WD), T, D, FF / 2, 0}; ChainOrder S; S.init(T, D, G, blk);
          pg8::EpiResidB<false, true> E{(const void*)(ws + WS_XB), (bf16*)(ws + WS_XB), (const float*)(ws + WS_ADA) + (size_t)L * 32 * ADA + 5 * D};
          pg8::gemm_phase<pg8::EpiResidB<false, true>, ChainOrder, true, true>(lds + RING_OFF, g, S, E); }
#else
          pg8::Gemm g{(const bf16*)(ws + WS_ACT), (const bf16*)(ws + WS_WD), T, D, FF}; ChainOrder S; S.init(T, D, G, blk);
          pg8::EpiResidB<false, false> E{(const void*)(ws + WS_XB), (bf16*)(ws + WS_XB), (const float*)(ws + WS_ADA) + (size_t)L * 32 * ADA + 5 * D};
          pg8::gemm_phase<pg8::EpiResidB<false, false>, ChainOrder, true, true>(lds + RING_OFF, g, S, E); }
#endif
        CHAIN_SYNC();
    } else {
        PH_REP(11) if (PH_ON(11)) { unsigned char* ws = WS_();
            norm_phase<true, true, true>((const float*)(ws + WS_XB), args.in[5] + L * D, (const float*)(ws + WS_ADA) + (size_t)L * 32 * ADA, 4 * D, 3 * D, (bf16*)(ws + WS_HB), args.in[17], args.in[18],
                             (int*)(ws + WS_PCNT), (int*)(ws + WS_TOKE), (int*)(ws + WS_TOKR), (float*)(ws + WS_TOKG), lds, blk, G); }
        GRID_BAR();
        PH_REP(12) if (PH_ON(12)) { unsigned char* ws = WS_();
            moe_gather2((const bf16*)(ws + WS_HB), ws + WS_XS, (const int*)(ws + WS_PCNT), (const int*)(ws + WS_TOKE), (const int*)(ws + WS_TOKR), (const float*)(ws + WS_TOKG),
                        (int*)(ws + WS_SLOTT), (float*)(ws + WS_SLOTG), MT, lds, blk, G); }
        GRID_BAR();
        PH_REP(13) if (PH_ON(13)) { unsigned char* ws = WS_(); const int nt0 = MT[MT_NT], nt1 = MT[MT_STRIDE + MT_NT];
          pg8::Gemm g{(const bf16*)(ws + WS_XS), (const bf16*)(ws + WS_MWGU), (nt0 + nt1) * 256, 2 * DE, D / 2, 0}; pg8::MoeOrder2 S; S.init((nt0 + nt1) * 256, 2 * DE, G, blk);
          S.tile_e0 = (const LAS unsigned char*)(MT + MT_TILE); S.tile_e1 = (const LAS unsigned char*)(MT + MT_STRIDE + MT_TILE); S.ne_tiles = 2 * DE / 256; S.nt0 = nt0; S.base1 = MAXTILES;
          pg8::EpiSwigluF8 E{ws + WS_ACTM, DE};
          pg8::gemm_phase<pg8::EpiSwigluF8, pg8::MoeOrder2, true, true>(lds + RING_OFF, g, S, E); }
        GRID_BAR();
        if (PH_ON(14)) { moe_down_main<0, L>(args, lds, MT, blk, G); moe_down_slices<0>(args, lds, MT, blk, G); moe_down_slices<1>(args, lds, MT, blk, G); }
        GRID_BAR();
        if (PH_ON(14)) moe_down_combine<0, L>(args, MT, blk, G);
        GRID_BAR();
        if (PH_ON(14)) { moe_down_main<1, L>(args, lds, MT, blk, G); moe_down_combine<1, L>(args, MT, blk, G); }
    }
}
__global__ void __launch_bounds__(NWAVES * 64, 2) mk_fwd(const Args args) {
    extern __shared__ __attribute__((aligned(16))) unsigned char lds_raw[];
    LAS unsigned char* lds = (LAS unsigned char*)lds_raw;
    volatile LAS unsigned* MISC = (volatile LAS unsigned*)(lds + MISC_OFF);
    const int G = gridDim.x, blk = blockIdx.x;
    for (int u = threadIdx.x; u < (LDS_BYTES - LDSCTL_OFF) / 4; u += NWAVES * 64) ((LAS unsigned*)(lds + LDSCTL_OFF))[u] = 0u;
    __syncthreads();
    const XcdBarrier bar = xcd_barrier_post((unsigned*)(args.ws + WS_CTL) + CW_BAR, MISC + 8);
    PH_REP(0) if (PH_ON(0)) p0_ada(args, lds, blk, G);
    PH_REP(1) if (PH_ON(1)) p0_transposes(args, lds, blk, G);
    if (PH_ON(1)) p0_spatial(args, blk, G);
    GRID_BAR();
#ifdef PROBE_BARS
    for (int i_ = 0; i_ < PROBE_BARS; ++i_) GRID_BAR();
#endif
    layer_body<0>(args, bar, lds, blk, G);
    layer_body<1>(args, bar, lds, blk, G);
}

extern "C" void kernel_launch(void* const* d_in, const int* in_sizes, int n_in, void* d_out, int out_size, void* d_ws, size_t ws_size, hipStream_t stream) {
    static int grid = 0;
    if (grid == 0) {
        if (n_in != 22 || in_sizes[0] != T * D || out_size != T * D || ws_size < WS_END) {
            fprintf(stderr, "kernel_launch: built for 22 inputs, x/out of %d floats, >= %zu bytes of workspace; got n_in %d, in0 %d, out %d, ws %zu; nothing launched\n", T * D, (size_t)WS_END, n_in, n_in > 0 ? in_sizes[0] : -1, out_size, ws_size);
            grid = -1; return; }
        int dev = 0, cus = 0, per_cu = 0;
        if (hipGetDevice(&dev) != hipSuccess || hipDeviceGetAttribute(&cus, hipDeviceAttributeMultiprocessorCount, dev) != hipSuccess) { fprintf(stderr, "kernel_launch: device query failed\n"); grid = -1; return; }
        if (hipFuncSetAttribute((const void*)mk_fwd, hipFuncAttributeMaxDynamicSharedMemorySize, LDS_BYTES) != hipSuccess) { fprintf(stderr, "kernel_launch: hipFuncSetAttribute failed\n"); grid = -1; return; }
        if (hipOccupancyMaxActiveBlocksPerMultiprocessor(&per_cu, (const void*)mk_fwd, NWAVES * 64, LDS_BYTES) != hipSuccess || per_cu < 1)
            fprintf(stderr, "kernel_launch: note: occupancy query reports %d workgroups per CU\n", per_cu);
        (void)hipGetLastError();
        grid = cus;
    }
    if (grid < 0) return;
    if (hipMemsetAsync((char*)d_ws + WS_CTL, 0, CTL_ZERO_BYTES, stream) != hipSuccess) { fprintf(stderr, "kernel_launch: memset failed\n"); return; }
    Args a{};
    for (int i = 0; i < 22; ++i) a.in[i] = (const float*)d_in[i];
    a.out = (float*)d_out; a.ws = (unsigned char*)d_ws;
    hipLaunchKernelGGL(mk_fwd, dim3(grid), dim3(NWAVES * 64), LDS_BYTES, stream, a);
    const hipError_t le = hipPeekAtLastError();
    if (le != hipSuccess) fprintf(stderr, "kernel_launch: launch failed: %s\n", hipGetErrorName(le));
}
```

```cpp
#ifndef FFN_GU_FP8
#define FFN_GU_FP8 0
#endif
#ifndef FFN_DOWN_FP8
#define FFN_DOWN_FP8 1
#endif
#include <hip/hip_runtime.h>
#include <cstdio>
#include <cstdint>
namespace pg8 {
#define PG8_LAS __attribute__((address_space(3)))
typedef unsigned short bf16_t;
typedef short bf16x8 __attribute__((ext_vector_type(8)));
typedef float f32x4 __attribute__((ext_vector_type(4)));
typedef unsigned u32x4 __attribute__((ext_vector_type(4)));
constexpr int BM = 256, BK = 64, HALF = 128, HTB = HALF * BK * 2  , STAGE_BYTES = 8 * HTB, NXCD = 8, WGM = 8;

__host__ __device__ __forceinline__ int lds_byte(int r, int c) { const int st = (r >> 4) * 2 + (c >> 5), rr = r & 15, cc = c & 31, ob = rr * 64 + cc * 2; return st * 1024 + (ob ^ (((ob >> 9) & 1) << 5)); }
__host__ __device__ __forceinline__ void stage_rc(int b, int& R, int& C) { const int st = b / 1024, sb = b % 1024, swz = sb ^ (((sb >> 9) & 1) << 5); R = (st >> 1) * 16 + swz / 64; C = (st & 1) * 32 + (swz % 64) / 2; }
__host__ __device__ __forceinline__ int perm32(int rho) { const int n = rho >> 4, i = rho & 15; return 8 * (i >> 2) + 4 * n + (i & 3); }

typedef int i32x8 __attribute__((ext_vector_type(8)));
typedef int i32x4 __attribute__((ext_vector_type(4)));
__device__ __forceinline__ i32x8 cat8(bf16x8 lo, bf16x8 hi) { const i32x4 a = __builtin_bit_cast(i32x4, lo), b = __builtin_bit_cast(i32x4, hi); return __builtin_shufflevector(a, b, 0, 1, 2, 3, 4, 5, 6, 7); }
__device__ __forceinline__ void glds16s(const void* sbase, unsigned voff, unsigned lds_dst) { unsigned keep;
    asm volatile("s_mov_b32 %0, m0\n\ts_mov_b32 m0, %3\n\ts_nop 0\n\tglobal_load_lds_dwordx4 %1, %2\n\ts_mov_b32 m0, %0" : "=&s"(keep) : "v"(voff), "s"(sbase), "s"(lds_dst) : "memory"); }
__device__ __forceinline__ void mfma_f8(f32x4& acc, const i32x8 a, const i32x8 b, const int sa, const int sb) {
    asm volatile("v_mfma_scale_f32_16x16x128_f8f6f4 %0, %1, %2, %0, %3, %4 op_sel_hi:[0,0,0]" : "+v"(acc) : "v"(a), "v"(b), "v"(sa), "v"(sb)); }
__device__ __forceinline__ void mfma_f8_z(f32x4& acc, const i32x8 a, const i32x8 b, const int sa, const int sb) {
    asm volatile("v_mfma_scale_f32_16x16x128_f8f6f4 %0, %1, %2, 0, %3, %4 op_sel_hi:[0,0,0]" : "=&v"(acc) : "v"(a), "v"(b), "v"(sa), "v"(sb)); }
__device__ __forceinline__ void mfma_bf16(f32x4& acc, const bf16x8 a, const bf16x8 b) { asm volatile("v_mfma_f32_16x16x32_bf16 %0, %1, %2, %0" : "+v"(acc) : "v"(a), "v"(b)); }
__device__ __forceinline__ void mfma_bf16_z(f32x4& acc, const bf16x8 a, const bf16x8 b) { asm volatile("v_mfma_f32_16x16x32_bf16 %0, %1, %2, 0" : "=&v"(acc) : "v"(a), "v"(b)); }
struct Unit { int pm, pn, bn, skip, kofs; };
struct Gemm { const bf16_t* A; const bf16_t* Bt; int M, N, K, ld; };

struct StaticOrder {
    int nM, nN, nwg, G, c;
    __host__ __device__ void init(int M, int N, int G_, int c_) { nM = M / BM; nN = N / BM; nwg = nM * nN; G = G_; c = c_; }
    __host__ __device__ bool next(int i, Unit& u) const {
        const long L = (long)i * G + c; if (L >= nwg) return false;
        map((int)L, u); return true;
    }
    __host__ __device__ void map(int L, Unit& u) const {
        int wgid = L; { const int q = nwg / NXCD, r = nwg % NXCD, xcd = wgid % NXCD, off = wgid / NXCD; wgid = (xcd < r ? xcd * (q + 1) : r * (q + 1) + (xcd - r) * q) + off; }
        const int nig = WGM * nN, gid = wgid / nig, fm = gid * WGM, gsz = (nM - fm) < WGM ? (nM - fm) : WGM;
        u.pm = fm + ((wgid % nig) % gsz); u.pn = (wgid % nig) / gsz; u.bn = u.pn; u.skip = 0; u.kofs = 0;
    }
    __device__ __forceinline__ void a_ready(const Unit&) const {}
    __device__ __forceinline__ void done(const Unit&) const {}
};

__device__ __forceinline__ unsigned cvt_pk_bf16(float lo, float hi) { unsigned r; asm volatile("v_cvt_pk_bf16_f32 %0, %1, %2" : "=v"(r) : "v"(lo), "v"(hi)); return r; }
typedef float f32x2 __attribute__((ext_vector_type(2)));
__device__ __forceinline__ f32x2 gelu_pk(f32x2 v) {
    const f32x2 av = __builtin_elementwise_abs(v), d = av * 0.2316418882f + 1.0f;
    f32x2 t; t.x = __builtin_amdgcn_rcpf(d.x); t.y = __builtin_amdgcn_rcpf(d.y);
    f32x2 q = t * 0.5307027145f + (-0.7265760135f); q = q * t + 0.7107068705f; q = q * t + (-0.142248368f); q = q * t + 0.127414796f; q = q * t;
    const f32x2 s = (v * v) * (-0.72134752044f);
    f32x2 e; e.x = __builtin_amdgcn_exp2f(s.x); e.y = __builtin_amdgcn_exp2f(s.y);
    const f32x2 m = v * (q * e), r = v - m;
    f32x2 o; o.x = v.x < 0.f ? m.x : r.x; o.y = v.y < 0.f ? m.y : r.y; return o;
}


__device__ __forceinline__ void store_bf16x8(bf16_t* p, const f32x4 v0, const f32x4 v1) {
    u32x4 w; w.x = cvt_pk_bf16(v0[0], v0[1]); w.y = cvt_pk_bf16(v0[2], v0[3]); w.z = cvt_pk_bf16(v1[0], v1[1]); w.w = cvt_pk_bf16(v1[2], v1[3]); *(u32x4*)p = w;
}
__device__ __forceinline__ f32x4 gelu4(const f32x4 v) { const f32x2 a = gelu_pk((f32x2){v[0], v[1]}), b = gelu_pk((f32x2){v[2], v[3]}); return (f32x4){a.x, a.y, b.x, b.y}; }
__device__ __forceinline__ float silu_mul(float g, float u) { return g * u * __builtin_amdgcn_rcpf(1.0f + __builtin_amdgcn_exp2f(-1.4426950408889634f * g)); }
typedef float f32x2 __attribute__((ext_vector_type(2)));
__device__ __forceinline__ f32x4 swiglu4(const f32x4 g, const f32x4 u) {
    const f32x2 ga = {g[0], g[1]}, gb = {g[2], g[3]}, ua = {u[0], u[1]}, ub = {u[2], u[3]};
    const f32x2 ea = {__builtin_amdgcn_exp2f(-ga.x), __builtin_amdgcn_exp2f(-ga.y)}, eb = {__builtin_amdgcn_exp2f(-gb.x), __builtin_amdgcn_exp2f(-gb.y)};
    const f32x2 da = ea + 1.0f, db = eb + 1.0f;
    const f32x2 ra = {__builtin_amdgcn_rcpf(da.x), __builtin_amdgcn_rcpf(da.y)}, rb = {__builtin_amdgcn_rcpf(db.x), __builtin_amdgcn_rcpf(db.y)};
    const f32x2 oa = (ga * ua) * ra, ob = (gb * ub) * rb;
    return (f32x4){oa.x, oa.y, ob.x, ob.y};
}

struct EpiProj {
    static constexpr bool PERM = true, AFTER_DRAIN = false, IDEMP = true; static constexpr int BMODE = 0; static constexpr bool FP8 = false;
    bf16_t* O;
    __device__ __forceinline__ void operator()(const f32x4 (&acc)[2][2][4][2], const Unit& u, int wr, int wc, int fr, int fq) const {
        if (u.skip) return;
        const int row0 = u.pm * BM + wr * 64 + fr, col0 = u.pn * BM + wc * 32 + 8 * fq; const bool act = u.pn >= 6;
#pragma unroll
        for (int ai = 0; ai < 2; ++ai)
#pragma unroll
            for (int m = 0; m < 4; ++m) { bf16_t* rowp = O + (size_t)(row0 + ai * HALF + m * 16) * 2560 + col0;
#pragma unroll
                for (int bj = 0; bj < 2; ++bj) { f32x4 v0 = acc[ai][bj][m][0], v1 = acc[ai][bj][m][1];
                    if (act) { v0 = gelu4(v0); v1 = gelu4(v1); }
                    store_bf16x8(rowp + bj * HALF, v0, v1);
#ifdef DUPSTORE
                    store_bf16x8(rowp + bj * HALF + (size_t)160 * 1024 * 1024, v0, v1);
#endif
                    } }
    }
};
struct EpiProjQK {
    static constexpr bool PERM = true, AFTER_DRAIN = false, IDEMP = true; static constexpr int BMODE = 1; static constexpr bool FP8 = false;
    bf16_t* O; const float* qg; const float* kg; float qscale; float eps;
    __device__ __forceinline__ void operator()(const f32x4 (&acc)[2][2][4][2], const Unit& u, int wr, int wc, int fr, int fq) const {
        const int row0 = u.pm * BM + wr * 64 + fr, col0 = u.pn * BM + wc * 64 + 8 * fq; const int kind = u.pn >> 1;
        if (kind < 2) {
            const float* gp = (kind == 0 ? qg : kg) + 8 * fq; const float gs = (kind == 0) ? qscale : 1.0f;
            f32x4 gv[2][2];
#pragma unroll
            for (int bj = 0; bj < 2; ++bj)
#pragma unroll
                for (int n = 0; n < 2; ++n) gv[bj][n] = *(const f32x4*)(gp + 32 * bj + 4 * n) * gs;
#pragma unroll
            for (int ai = 0; ai < 2; ++ai)
#pragma unroll
                for (int m = 0; m < 4; ++m) { float ss = 0.f;
#pragma unroll
                    for (int bj = 0; bj < 2; ++bj)
#pragma unroll
                        for (int n = 0; n < 2; ++n) { const f32x4 v = acc[ai][bj][m][n]; ss += (v[0] * v[0] + v[1] * v[1]) + (v[2] * v[2] + v[3] * v[3]); }
                    ss += __shfl_xor(ss, 16); ss += __shfl_xor(ss, 32);
                    const float rs = __builtin_amdgcn_rsqf(ss * (1.0f / 64.0f) + eps);
                    bf16_t* rowp = O + (size_t)(row0 + ai * HALF + m * 16) * 2560 + col0;
#pragma unroll
                    for (int bj = 0; bj < 2; ++bj) store_bf16x8(rowp + 32 * bj, acc[ai][bj][m][0] * rs * gv[bj][0], acc[ai][bj][m][1] * rs * gv[bj][1]); }
        } else {
#ifdef GELU_IN_PROJ
            const bool act = kind >= 3;
#else
            constexpr bool act = false;
#endif
#pragma unroll
            for (int ai = 0; ai < 2; ++ai)
#pragma unroll
                for (int m = 0; m < 4; ++m) { bf16_t* rowp = O + (size_t)(row0 + ai * HALF + m * 16) * 2560 + col0;
#pragma unroll
                    for (int bj = 0; bj < 2; ++bj) { f32x4 v0 = acc[ai][bj][m][0], v1 = acc[ai][bj][m][1];
                        if (act) { v0 = gelu4(v0); v1 = gelu4(v1); }
                        store_bf16x8(rowp + 32 * bj, v0, v1); } }
        }
    }
};
struct EpiResid {
    static constexpr bool PERM = false, AFTER_DRAIN = false, IDEMP = false; static constexpr int BMODE = 0; static constexpr bool FP8 = false;
    const float* xin; float* xout; const float* gate;
    __device__ __forceinline__ void operator()(const f32x4 (&acc)[2][2][4][2], const Unit& u, int wr, int wc, int fr, int fq) const {
        const int row0 = u.pm * BM + wr * 64 + fr, col0 = u.pn * BM + wc * 32 + 4 * fq;
        const float* gp = gate + (size_t)(u.pm >> 3) * 6144 + col0;
        f32x4 gv[2][2];
#pragma unroll
        for (int bj = 0; bj < 2; ++bj)
#pragma unroll
            for (int n = 0; n < 2; ++n) gv[bj][n] = *(const f32x4*)(gp + bj * HALF + n * 16);
#pragma unroll
        for (int ai = 0; ai < 2; ++ai) {
            f32x4 xi[4][2][2];
#pragma unroll
            for (int m = 0; m < 4; ++m) { const size_t off = (size_t)(row0 + ai * HALF + m * 16) * 1024 + col0;
#pragma unroll
                for (int bj = 0; bj < 2; ++bj)
#pragma unroll
                    for (int n = 0; n < 2; ++n) xi[m][bj][n] = *(const f32x4*)(xin + off + bj * HALF + n * 16); }
            asm volatile("" ::: "memory");
#pragma unroll
            for (int m = 0; m < 4; ++m) { const size_t off = (size_t)(row0 + ai * HALF + m * 16) * 1024 + col0;
#pragma unroll
                for (int bj = 0; bj < 2; ++bj)
#pragma unroll
                    for (int n = 0; n < 2; ++n) *(f32x4*)(xout + off + bj * HALF + n * 16) = xi[m][bj][n] + gv[bj][n] * acc[ai][bj][m][n]; }
            asm volatile("" ::: "memory");
        }
    }
};
struct EpiSwiglu {
    static constexpr bool PERM = true, AFTER_DRAIN = false, IDEMP = true; static constexpr int BMODE = 0; static constexpr bool FP8 = false;
    bf16_t* O; int ldc;
    __device__ __forceinline__ void operator()(const f32x4 (&acc)[2][2][4][2], const Unit& u, int wr, int wc, int fr, int fq) const {
        const int row0 = u.pm * BM + wr * 64 + fr, col0 = u.pn * HALF + wc * 32 + 8 * fq;
#pragma unroll
        for (int ai = 0; ai < 2; ++ai)
#pragma unroll
            for (int m = 0; m < 4; ++m) { bf16_t* rowp = O + (size_t)(row0 + ai * HALF + m * 16) * ldc + col0;
                const f32x4 g0 = acc[ai][0][m][0], g1 = acc[ai][0][m][1], u0 = acc[ai][1][m][0], u1 = acc[ai][1][m][1];
                const f32x4 r0 = swiglu4(g0, u0), r1 = swiglu4(g1, u1);
                store_bf16x8(rowp, r0, r1); }
    }
};
__device__ __forceinline__ unsigned pk4_fp8(const f32x4 v) {
    int p = 0;
    p = __builtin_amdgcn_cvt_pk_fp8_f32(__builtin_amdgcn_fmed3f(v[0], -448.f, 448.f), __builtin_amdgcn_fmed3f(v[1], -448.f, 448.f), p, false);
    p = __builtin_amdgcn_cvt_pk_fp8_f32(__builtin_amdgcn_fmed3f(v[2], -448.f, 448.f), __builtin_amdgcn_fmed3f(v[3], -448.f, 448.f), p, true);
    return (unsigned)p;
}
struct EpiSwigluF8 {
    static constexpr bool PERM = true, AFTER_DRAIN = false, IDEMP = true; static constexpr int BMODE = 0; static constexpr bool FP8 = true;
    unsigned char* O; int ldc;
    __device__ __forceinline__ void operator()(const f32x4 (&acc)[2][2][4][2], const Unit& u, int wr, int wc, int fr, int fq) const {
        const int row0 = u.pm * BM + wr * 64 + fr, col0 = u.pn * HALF + wc * 32 + 8 * fq;
#pragma unroll
        for (int ai = 0; ai < 2; ++ai)
#pragma unroll
            for (int m = 0; m < 4; ++m) { unsigned char* rowp = O + (size_t)(row0 + ai * HALF + m * 16) * ldc + col0;
                const f32x4 g0 = acc[ai][0][m][0], g1 = acc[ai][0][m][1], u0 = acc[ai][1][m][0], u1 = acc[ai][1][m][1];
                const f32x4 r0 = swiglu4(g0, u0), r1 = swiglu4(g1, u1);
                typedef unsigned u32x2 __attribute__((ext_vector_type(2)));
                u32x2 w; w.x = pk4_fp8(r0); w.y = pk4_fp8(r1); *(u32x2*)rowp = w; }
    }
};
template <bool KF8, bool OF8>
struct EpiSwigluX {
    static constexpr bool PERM = true, AFTER_DRAIN = false, IDEMP = true; static constexpr int BMODE = 0; static constexpr bool FP8 = KF8;
    unsigned char* O; int ldc;
    __device__ __forceinline__ void operator()(const f32x4 (&acc)[2][2][4][2], const Unit& u, int wr, int wc, int fr, int fq) const {
        const int row0 = u.pm * BM + wr * 64 + fr, col0 = u.pn * HALF + wc * 32 + 8 * fq;
#pragma unroll
        for (int ai = 0; ai < 2; ++ai)
#pragma unroll
            for (int m = 0; m < 4; ++m) { unsigned char* rowp = O + ((size_t)(row0 + ai * HALF + m * 16) * ldc + col0) * (OF8 ? 1 : 2);
                const f32x4 r0 = swiglu4(acc[ai][0][m][0], acc[ai][1][m][0]), r1 = swiglu4(acc[ai][0][m][1], acc[ai][1][m][1]);
                if constexpr (OF8) { typedef unsigned u32x2 __attribute__((ext_vector_type(2))); u32x2 w; w.x = pk4_fp8(r0); w.y = pk4_fp8(r1); *(u32x2*)rowp = w; }
                else store_bf16x8((bf16_t*)rowp, r0, r1); }
    }
};
struct EpiSwigluO8 {
    static constexpr bool PERM = true, AFTER_DRAIN = false, IDEMP = true; static constexpr int BMODE = 0; static constexpr bool FP8 = false;
    unsigned char* O; int ldc;
    __device__ __forceinline__ void operator()(const f32x4 (&acc)[2][2][4][2], const Unit& u, int wr, int wc, int fr, int fq) const {
        const int row0 = u.pm * BM + wr * 64 + fr, col0 = u.pn * HALF + wc * 32 + 8 * fq;
#pragma unroll
        for (int ai = 0; ai < 2; ++ai)
#pragma unroll
            for (int m = 0; m < 4; ++m) { unsigned char* rowp = O + (size_t)(row0 + ai * HALF + m * 16) * ldc + col0;
                const f32x4 r0 = swiglu4(acc[ai][0][m][0], acc[ai][1][m][0]), r1 = swiglu4(acc[ai][0][m][1], acc[ai][1][m][1]);
                typedef unsigned u32x2 __attribute__((ext_vector_type(2)));
                u32x2 w; w.x = pk4_fp8(r0); w.y = pk4_fp8(r1); *(u32x2*)rowp = w; }
    }
};
struct EpiMoeDown {
    static constexpr bool PERM = false, AFTER_DRAIN = false, IDEMP = false; static constexpr int BMODE = 0; static constexpr bool FP8 = false;
    float* x; const float* gate; const int* slot_tok; const float* slot_gate;
    __device__ __forceinline__ void operator()(const f32x4 (&acc)[2][2][4][2], const Unit& u, int wr, int wc, int fr, int fq) const {
        const int slot0 = u.pm * BM + wr * 64 + fr, col0 = u.pn * BM + wc * 32 + 4 * fq;
        int tok[2][4]; float sg[2][4];
#pragma unroll
        for (int ai = 0; ai < 2; ++ai)
#pragma unroll
            for (int m = 0; m < 4; ++m) { const int slot = slot0 + ai * HALF + m * 16; tok[ai][m] = slot_tok[slot]; sg[ai][m] = slot_gate[slot]; }
#pragma unroll
        for (int ai = 0; ai < 2; ++ai)
#pragma unroll
            for (int mp = 0; mp < 2; ++mp) {
                f32x4 gvv[2][2][2], xi[2][2][2];
#pragma unroll
                for (int q = 0; q < 2; ++q) { const int t = tok[ai][2 * mp + q], te = t < 0 ? 0 : t;
                    const float* gp = gate + (size_t)(te >> 11) * 6144 + col0; const float* xp = x + (size_t)te * 1024 + col0;
#pragma unroll
                    for (int bj = 0; bj < 2; ++bj)
#pragma unroll
                        for (int n = 0; n < 2; ++n) { gvv[q][bj][n] = *(const f32x4*)(gp + bj * HALF + n * 16); xi[q][bj][n] = *(const f32x4*)(xp + bj * HALF + n * 16); } }
                asm volatile("" ::: "memory");
#pragma unroll
                for (int q = 0; q < 2; ++q) { const int m = 2 * mp + q; const int t = tok[ai][m];
                    if (t >= 0) { float* xp = x + (size_t)t * 1024 + col0; const float g1 = sg[ai][m];
#pragma unroll
                        for (int bj = 0; bj < 2; ++bj)
#pragma unroll
                            for (int n = 0; n < 2; ++n) *(f32x4*)(xp + bj * HALF + n * 16) = xi[q][bj][n] + (gvv[q][bj][n] * g1) * acc[ai][bj][m][n]; } }
                asm volatile("" ::: "memory");
            }
    }
};
struct EpiMoeDownF8 : EpiMoeDown { static constexpr bool FP8 = true; };
struct EpiResidF8 : EpiResid { static constexpr bool FP8 = true; };
__device__ __forceinline__ void unpack_bf16x8(const u32x4 w, f32x4& a, f32x4& b) {
    a = (f32x4){__builtin_bit_cast(float, w.x << 16), __builtin_bit_cast(float, w.x & 0xffff0000u), __builtin_bit_cast(float, w.y << 16), __builtin_bit_cast(float, w.y & 0xffff0000u)};
    b = (f32x4){__builtin_bit_cast(float, w.z << 16), __builtin_bit_cast(float, w.z & 0xffff0000u), __builtin_bit_cast(float, w.w << 16), __builtin_bit_cast(float, w.w & 0xffff0000u)}; }
template <bool IN_F32, bool F8>
struct EpiResidB {
    static constexpr bool PERM = true, AFTER_DRAIN = false, IDEMP = false; static constexpr int BMODE = 0; static constexpr bool FP8 = F8;
    const void* xin; bf16_t* xout; const float* gate;
    __device__ __forceinline__ void operator()(const f32x4 (&acc)[2][2][4][2], const Unit& u, int wr, int wc, int fr, int fq) const {
        const int row0 = u.pm * BM + wr * 64 + fr, col0 = u.pn * BM + wc * 32 + 8 * fq;
        const float* gp = gate + (size_t)(u.pm >> 3) * 6144 + col0;
        f32x4 gv[2][2];
#pragma unroll
        for (int bj = 0; bj < 2; ++bj)
#pragma unroll
            for (int n = 0; n < 2; ++n) gv[bj][n] = *(const f32x4*)(gp + bj * HALF + n * 4);
        const unsigned e0 = (unsigned)row0 * 1024u + (unsigned)col0;
        if constexpr (!IN_F32) {
            u32x4 xw[2][4][2];
#define RB_EO(ai, m, bj) (e0 + (unsigned)(((ai) * HALF + (m) * 16) * 1024 + (bj) * HALF))
#define RB_LD(ai, m, bj) xw[ai][m][bj] = *(const u32x4*)((const char*)xin + (size_t)(RB_EO(ai, m, bj) * 2u))
#define RB_ST(ai, m, bj) do { f32x4 xa_, xc_; unpack_bf16x8(xw[ai][m][bj], xa_, xc_); \
                store_bf16x8((bf16_t*)((char*)xout + (size_t)(RB_EO(ai, m, bj) * 2u)), xa_ + gv[bj][0] * acc[ai][bj][m][0], xc_ + gv[bj][1] * acc[ai][bj][m][1]); } while (0)
#pragma unroll
            for (int m = 0; m < 4; ++m) { RB_LD(0, m, 0); RB_LD(0, m, 1); }
#pragma unroll
            for (int m = 0; m < 2; ++m) { RB_LD(1, m, 0); RB_LD(1, m, 1); }
            asm volatile("" ::: "memory");
#pragma unroll
            for (int m = 0; m < 2; ++m) { RB_ST(0, m, 0); RB_ST(0, m, 1); }
            asm volatile("" ::: "memory");
#pragma unroll
            for (int m = 2; m < 4; ++m) { RB_LD(1, m, 0); RB_LD(1, m, 1); }
            asm volatile("" ::: "memory");
#pragma unroll
            for (int m = 2; m < 4; ++m) { RB_ST(0, m, 0); RB_ST(0, m, 1); }
#pragma unroll
            for (int m = 0; m < 4; ++m) { RB_ST(1, m, 0); RB_ST(1, m, 1); }
            asm volatile("" ::: "memory");
#undef RB_EO
#undef RB_LD
#undef RB_ST
            return;
        }
#pragma unroll
        for (int ai = 0; ai < 2; ++ai) {
            f32x4 xa[4][2], xb2[4][2];
#pragma unroll
            for (int m = 0; m < 4; ++m)
#pragma unroll
                for (int bj = 0; bj < 2; ++bj) { const unsigned eo = e0 + (unsigned)((ai * HALF + m * 16) * 1024 + bj * HALF);
                    if (IN_F32) { xa[m][bj] = *(const f32x4*)((const char*)xin + (size_t)(eo * 4u)); xb2[m][bj] = *(const f32x4*)((const char*)xin + (size_t)(eo * 4u) + 16); }
                    else unpack_bf16x8(*(const u32x4*)((const char*)xin + (size_t)(eo * 2u)), xa[m][bj], xb2[m][bj]); }
            asm volatile("" ::: "memory");
#pragma unroll
            for (int m = 0; m < 4; ++m)
#pragma unroll
                for (int bj = 0; bj < 2; ++bj) { const unsigned eo = e0 + (unsigned)((ai * HALF + m * 16) * 1024 + bj * HALF);
                    store_bf16x8((bf16_t*)((char*)xout + (size_t)(eo * 2u)), xa[m][bj] + gv[bj][0] * acc[ai][bj][m][0], xb2[m][bj] + gv[bj][1] * acc[ai][bj][m][1]); }
            asm volatile("" ::: "memory");
        }
    }
};
template <bool OUT_F32>
struct EpiMoeDownB {
    static constexpr bool PERM = true, AFTER_DRAIN = false, IDEMP = false; static constexpr int BMODE = 0; static constexpr bool FP8 = true;
    const bf16_t* xb; bf16_t* xbo; float* xf; const bf16_t* gate16; const int* slot_tok; const float* slot_gate;
    __device__ __forceinline__ void operator()(const f32x4 (&acc)[2][2][4][2], const Unit& u, int wr, int wc, int fr, int fq) const {
        const int slot0 = u.pm * BM + wr * 64 + fr, col0 = u.pn * BM + wc * 32 + 8 * fq;
        int tok[2][4]; float sg[2][4];
#pragma unroll
        for (int ai = 0; ai < 2; ++ai)
#pragma unroll
            for (int m = 0; m < 4; ++m) { const int slot = slot0 + ai * HALF + m * 16; tok[ai][m] = slot_tok[slot]; sg[ai][m] = slot_gate[slot]; }
#pragma unroll
        for (int ai = 0; ai < 2; ++ai) {
            u32x4 gw[4][2], xw[4][2];
#pragma unroll
            for (int q = 0; q < 4; ++q) { const int t = tok[ai][q], te = t < 0 ? 0 : t;
                const bf16_t* gp = gate16 + (size_t)(te >> 11) * 1024 + col0; const bf16_t* xp = xb + (size_t)te * 1024 + col0;
#pragma unroll
                for (int bj = 0; bj < 2; ++bj) { gw[q][bj] = *(const u32x4*)(gp + bj * HALF); xw[q][bj] = *(const u32x4*)(xp + bj * HALF); } }
            asm volatile("" ::: "memory");
#pragma unroll
            for (int q = 0; q < 4; ++q) { const int t = tok[ai][q];
                if (t >= 0) { const float g1 = sg[ai][q];
#pragma unroll
                    for (int bj = 0; bj < 2; ++bj) { f32x4 ga, gc, xa, xc; unpack_bf16x8(gw[q][bj], ga, gc); unpack_bf16x8(xw[q][bj], xa, xc);
                        const f32x4 r0 = xa + (ga * g1) * acc[ai][bj][q][0], r1 = xc + (gc * g1) * acc[ai][bj][q][1];
                        if (OUT_F32) { float* op = xf + (size_t)t * 1024 + col0 + bj * HALF; *(f32x4*)op = r0; *(f32x4*)(op + 4) = r1; }
                        else store_bf16x8(xbo + (size_t)t * 1024 + col0 + bj * HALF, r0, r1); } } }
            asm volatile("" ::: "memory");
        }
    }
};
struct DupOrder : StaticOrder {
    __device__ __forceinline__ bool next(int i, Unit& u) const { if (!StaticOrder::next(i >> 1, u)) return false; u.skip = i & 1; return true; }
};
struct PanelOrder {
    int nM, nN, G, c;
    __device__ __forceinline__ void init(int M, int N, int G_, int c_) { nM = M / BM; nN = N / BM; G = G_; c = c_; }
    __device__ __forceinline__ bool next(int i, Unit& u) const { const int pi = i / nN; u.pm = c + pi * G; if (u.pm >= nM) return false; u.pn = i - pi * nN; u.bn = u.pn; u.skip = 0; u.kofs = 0; return true; }
    __device__ __forceinline__ void a_ready(const Unit&) const {}
    __device__ __forceinline__ void done(const Unit&) const {}
};
struct MoeOrder : StaticOrder {
    const PG8_LAS unsigned char* tile_e; int ne_tiles; int limit;
    __device__ __forceinline__ bool next(int i, Unit& u) const { const long L = (long)i * G + c; if (L >= limit) return false; map((int)L, u); u.bn = (int)tile_e[u.pm] * ne_tiles + u.pn; return true; }
};
struct MoeOrder2 : StaticOrder {
    const PG8_LAS unsigned char* tile_e0; const PG8_LAS unsigned char* tile_e1; int ne_tiles, nt0, base1;
    __device__ __forceinline__ bool next(int i, Unit& u) const { const long L = (long)i * G + c; if (L >= nwg) return false; map((int)L, u);
        int e; if (u.pm < nt0) e = tile_e0[u.pm]; else { const int pl = u.pm - nt0; e = tile_e1[pl]; u.pm = base1 + pl; }
        u.bn = e * ne_tiles + u.pn; return true; }
};
struct MoeOrder2L : MoeOrder2 { int limit;
    __device__ __forceinline__ bool next(int i, Unit& u) const { const long L = (long)i * G + c; if (L >= limit) return false; map((int)L, u);
        int e; if (u.pm < nt0) e = tile_e0[u.pm]; else { const int pl = u.pm - nt0; e = tile_e1[pl]; u.pm = base1 + pl; }
        u.bn = e * ne_tiles + u.pn; return true; } };
struct MoeTail2 : MoeOrder2 { int base, ntail, nsl, ksl_bytes;
    __device__ __forceinline__ bool next(int i, Unit& u) const { const int j = i * G + c; if (j >= ntail * nsl) return false; const int q = j / nsl; map(base + q, u);
        int e; if (u.pm < nt0) e = tile_e0[u.pm]; else { const int pl = u.pm - nt0; e = tile_e1[pl]; u.pm = base1 + pl; }
        u.bn = e * ne_tiles + u.pn; u.kofs = (j - q * nsl) * ksl_bytes; u.skip = j; return true; } };
struct EpiTileF32F8 {
    static constexpr bool PERM = false, AFTER_DRAIN = false, IDEMP = true; static constexpr int BMODE = 0; static constexpr bool FP8 = true;
    float* S;
    __device__ __forceinline__ void operator()(const f32x4 (&acc)[2][2][4][2], const Unit& u, int wr, int wc, int fr, int fq) const {
        float* base = S + (size_t)u.skip * 65536 + (size_t)(wr * 64 + fr) * 256 + wc * 32 + 4 * fq;
#pragma unroll
        for (int ai = 0; ai < 2; ++ai)
#pragma unroll
            for (int m = 0; m < 4; ++m)
#pragma unroll
                for (int bj = 0; bj < 2; ++bj)
#pragma unroll
                    for (int n = 0; n < 2; ++n) *(f32x4*)(base + (size_t)(ai * HALF + m * 16) * 256 + bj * HALF + n * 16) = acc[ai][bj][m][n];
    }
};
struct MoeTailOrder : StaticOrder {
    const PG8_LAS unsigned char* tile_e; int ne_tiles; int base, ntail, nsl, ksl_bytes;
    __device__ __forceinline__ bool next(int i, Unit& u) const { const int j = i * G + c; if (j >= ntail * nsl) return false; const int q = j / nsl; map(base + q, u);
        u.bn = (int)tile_e[u.pm] * ne_tiles + u.pn; u.kofs = (j - q * nsl) * ksl_bytes; return true; }
};
struct EpiMoeDownAtomic {
    static constexpr bool PERM = false, AFTER_DRAIN = false, IDEMP = false; static constexpr int BMODE = 0; static constexpr bool FP8 = false;
    float* x; const float* gate; const int* slot_tok; const float* slot_gate;
    __device__ __forceinline__ void operator()(const f32x4 (&acc)[2][2][4][2], const Unit& u, int wr, int wc, int fr, int fq) const {
        const int slot0 = u.pm * BM + wr * 64 + fr, col0 = u.pn * BM + wc * 32 + 4 * fq;
#pragma unroll
        for (int ai = 0; ai < 2; ++ai)
#pragma unroll
            for (int m = 0; m < 4; ++m) { const int slot = slot0 + ai * HALF + m * 16; const int tok = slot_tok[slot];
                if (tok >= 0) { const float sg = slot_gate[slot]; const float* gp = gate + (size_t)(tok >> 11) * 6144 + col0; float* xp = x + (size_t)tok * 1024 + col0;
#pragma unroll
                    for (int bj = 0; bj < 2; ++bj)
#pragma unroll
                        for (int n = 0; n < 2; ++n) { const f32x4 v = (*(const f32x4*)(gp + bj * HALF + n * 16) * sg) * acc[ai][bj][m][n];
#pragma unroll
                            for (int e = 0; e < 4; ++e) unsafeAtomicAdd(xp + bj * HALF + n * 16 + e, v[e]); } } }
    }
};

#ifndef EPI_TWICE
#define EPI_TWICE false
#endif
template <class Epi, class Sched, bool ALIGN_EPI = false, bool SP2 = false>
__device__ __forceinline__ void gemm_phase(PG8_LAS unsigned char* lds, const Gemm g, const Sched& S, const Epi& E) {
    int tid_o = threadIdx.x; asm volatile("" : "+v"(tid_o));
    const int tid = tid_o, wid = __builtin_amdgcn_readfirstlane(tid >> 6), lane = tid & 63, wr = wid >> 2, wc = wid & 3, fr = lane & 15, fq = lane >> 4;
    const int nt = g.K / BK, K = g.ld ? g.ld : g.K;
    unsigned voffA[2], voffB[2];
#pragma unroll
    for (int i = 0; i < 2; ++i) { int R, C; stage_rc(tid * 16 + i * 8192, R, C); const int Rb = (Epi::BMODE == 1) ? (64 * (R >> 5) + perm32(R & 31)) : (Epi::PERM ? ((R & ~31) + perm32(R & 31)) : R);
        voffA[i] = (unsigned)(R * K + C) * 2u; voffB[i] = (unsigned)(Rb * K + C) * 2u; }
    const size_t kstep = (size_t)(BK * 2);
    const size_t hstep = (size_t)HALF * K * 2;
    const size_t hstepB = (Epi::BMODE == 1) ? (size_t)32 * K * 2 : hstep;
    const size_t tstep = 2 * hstep;
    const unsigned lds0 = (unsigned)(uintptr_t)lds;
    const unsigned ldsw = (unsigned)wid * 1024u;
    const int aoff = lds_byte(wr * 64 + fr, fq * 8), boff = lds_byte(wc * 32 + fr, fq * 8);
#define PG8_SA(b, h) (((b) * 2 + (h)) * HTB)
#define PG8_SB(b, h) ((4 + (b) * 2 + (h)) * HTB)
#ifndef PG8_ASM_STAGE
#define PG8_ASM_STAGE 1
#endif
#if PG8_ASM_STAGE
#define PG8_STAGE(bufoff, gbase, voff) do { _Pragma("unroll") for (int _i = 0; _i < 2; ++_i) glds16s((const void*)(gbase), (voff)[_i], (unsigned)__builtin_amdgcn_readfirstlane((int)(lds0 + (unsigned)(bufoff) + ldsw + (unsigned)_i * 8192u))); } while (0)
#else
#define PG8_STAGE(bufoff, gbase, voff) do { _Pragma("unroll") for (int _i = 0; _i < 2; ++_i) \
        __builtin_amdgcn_global_load_lds((const unsigned*)((const char*)(gbase) + (voff)[_i]), (PG8_LAS unsigned*)(lds + (bufoff) + ldsw + _i * 8192), 16, 0, 0); } while (0)
#endif
#define PG8_LDA(dst, b, h) do { _Pragma("unroll") for (int m = 0; m < 4; ++m) _Pragma("unroll") for (int k = 0; k < 2; ++k) dst[m][k] = *(const PG8_LAS bf16x8*)(lds + PG8_SA(b, h) + aoff + m * 2048 + k * 1024); } while (0)
#define PG8_LDB(dst, b, h) do { _Pragma("unroll") for (int n = 0; n < 2; ++n) _Pragma("unroll") for (int k = 0; k < 2; ++k) dst[n][k] = *(const PG8_LAS bf16x8*)(lds + PG8_SB(b, h) + boff + n * 2048 + k * 1024); } while (0)
#define PG8_MMA(ai, bj, At, Bt) do { __builtin_amdgcn_s_setprio(1); _Pragma("unroll") for (int m = 0; m < 4; ++m) _Pragma("unroll") for (int n = 0; n < 2; ++n) { \
        if constexpr (Epi::FP8) mfma_f8(acc[ai][bj][m][n], cat8(Bt[n][0], Bt[n][1]), cat8(At[m][0], At[m][1]), 0x7a7a7a7a, 0x7f7f7f7f); \
        else { _Pragma("unroll") for (int k = 0; k < 2; ++k) acc[ai][bj][m][n] = __builtin_amdgcn_mfma_f32_16x16x32_bf16(Bt[n][k], At[m][k], acc[ai][bj][m][n], 0, 0, 0); } } \
        __builtin_amdgcn_s_setprio(0); } while (0)
#define PG8_MMA0(ai, bj, At, Bt) do { __builtin_amdgcn_s_setprio(1); _Pragma("unroll") for (int m = 0; m < 4; ++m) _Pragma("unroll") for (int n = 0; n < 2; ++n) \
        mfma_f8_z(acc[ai][bj][m][n], cat8(Bt[n][0], Bt[n][1]), cat8(At[m][0], At[m][1]), 0x7a7a7a7a, 0x7f7f7f7f); \
        __builtin_amdgcn_s_setprio(0); } while (0)
#define PG8_WAIT_V(n) asm volatile("s_waitcnt vmcnt(" #n ")" ::: "memory")
#define PG8_WAIT_L(n) asm volatile("s_waitcnt lgkmcnt(" #n ")" ::: "memory")
#define PG8_BAR __builtin_amdgcn_s_barrier()
#define PG8_SCHED __builtin_amdgcn_sched_barrier(0)
    Unit cur, nxt; int ui = 0;
    if (!S.next(0, cur)) return;
    f32x4 acc[2][2][4][2];
    if constexpr (!(SP2 && Epi::FP8))
#pragma unroll
    for (int a = 0; a < 2; ++a)
#pragma unroll
        for (int b = 0; b < 2; ++b)
#pragma unroll
            for (int m = 0; m < 4; ++m)
#pragma unroll
                for (int n = 0; n < 2; ++n) acc[a][b][m][n] = (f32x4){0.f, 0.f, 0.f, 0.f};
    bf16x8 At[4][2], B0[2][2], B1[2][2];
    const char* cA = (const char*)g.A + (size_t)cur.pm * tstep + cur.kofs; const char* cB = (const char*)g.Bt + (size_t)cur.bn * tstep + cur.kofs;
    S.a_ready(cur);
    if constexpr (SP2) {
        PG8_STAGE(PG8_SB(0, 0), cB, voffB); PG8_STAGE(PG8_SB(0, 1), cB + hstepB, voffB); PG8_STAGE(PG8_SA(0, 0), cA, voffA); PG8_STAGE(PG8_SA(0, 1), cA + hstep, voffA);
        if (wr == 1) PG8_BAR;
        PG8_WAIT_V(2); PG8_BAR;
        PG8_STAGE(PG8_SB(1, 0), cB + kstep, voffB); PG8_STAGE(PG8_SA(1, 0), cA + kstep, voffA); PG8_STAGE(PG8_SB(1, 1), cB + hstepB + kstep, voffB);
        PG8_WAIT_V(6); PG8_BAR;
    } else {
        PG8_STAGE(PG8_SB(0, 0), cB, voffB); PG8_STAGE(PG8_SA(0, 0), cA, voffA); PG8_STAGE(PG8_SB(0, 1), cB + hstepB, voffB); PG8_STAGE(PG8_SA(0, 1), cA + hstep, voffA);
        if (wr == 1) PG8_BAR;
        PG8_WAIT_V(4); PG8_BAR;
        PG8_STAGE(PG8_SB(1, 0), cB + kstep, voffB); PG8_STAGE(PG8_SA(1, 0), cA + kstep, voffA); PG8_STAGE(PG8_SB(1, 1), cB + hstepB + kstep, voffB);
        PG8_WAIT_V(6); PG8_BAR;
    }
    for (;;) {
        const bool has_next = S.next(ui + 1, nxt);
        const char* nA = has_next ? (const char*)g.A + (size_t)nxt.pm * tstep + nxt.kofs : cA; const char* nB = has_next ? (const char*)g.Bt + (size_t)nxt.bn * tstep + nxt.kofs : cB;
#pragma unroll 1
        for (int t = 0; t < nt; t += 2) {
            const bool last = (t == nt - 2);
            const char* a1 = cA + (size_t)(t + 1) * kstep;
            const char* a2 = last ? nA : cA + (size_t)(t + 2) * kstep; const char* b2 = last ? nB : cB + (size_t)(t + 2) * kstep;
            const char* a3 = a2 + kstep; const char* b3 = b2 + kstep;
            if (last && has_next) S.a_ready(nxt);
            if constexpr (SP2) {
            PG8_LDB(B0, 0, 0); PG8_LDB(B1, 0, 1); PG8_SCHED; PG8_LDA(At, 0, 0); PG8_STAGE(PG8_SA(1, 1), a1 + hstep, voffA);
            PG8_WAIT_V(8); PG8_WAIT_L(0); PG8_BAR; if (Epi::FP8 && t == 0) { PG8_MMA0(0, 0, At, B0); PG8_MMA0(0, 1, At, B1); } else { PG8_MMA(0, 0, At, B0); PG8_MMA(0, 1, At, B1); } PG8_BAR; PG8_SCHED;
            PG8_LDA(At, 0, 1); PG8_STAGE(PG8_SB(0, 0), b2, voffB); PG8_STAGE(PG8_SB(0, 1), b2 + hstepB, voffB); PG8_STAGE(PG8_SA(0, 0), a2, voffA);
            PG8_WAIT_V(8); PG8_WAIT_L(0); PG8_BAR; if (Epi::FP8 && t == 0) { PG8_MMA0(1, 0, At, B0); PG8_MMA0(1, 1, At, B1); } else { PG8_MMA(1, 0, At, B0); PG8_MMA(1, 1, At, B1); } PG8_BAR; PG8_SCHED;
            PG8_LDB(B0, 1, 0); PG8_LDB(B1, 1, 1); PG8_SCHED; PG8_LDA(At, 1, 0); PG8_STAGE(PG8_SA(0, 1), a2 + hstep, voffA);
            PG8_WAIT_V(8); PG8_WAIT_L(0); PG8_BAR; PG8_MMA(0, 0, At, B0); PG8_MMA(0, 1, At, B1); PG8_BAR; PG8_SCHED;
            PG8_LDA(At, 1, 1); PG8_STAGE(PG8_SB(1, 0), b3, voffB); PG8_STAGE(PG8_SB(1, 1), b3 + hstepB, voffB); PG8_STAGE(PG8_SA(1, 0), a3, voffA);
            PG8_WAIT_V(8); PG8_WAIT_L(0); PG8_BAR; PG8_MMA(1, 0, At, B0); PG8_MMA(1, 1, At, B1); PG8_BAR; PG8_SCHED;
            } else {
            PG8_LDB(B0, 0, 0); PG8_SCHED; PG8_LDA(At, 0, 0); PG8_STAGE(PG8_SA(1, 1), a1 + hstep, voffA);
            PG8_WAIT_L(8); PG8_BAR; PG8_WAIT_L(0); PG8_MMA(0, 0, At, B0); PG8_BAR; PG8_SCHED;
            PG8_LDB(B1, 0, 1); PG8_STAGE(PG8_SB(0, 0), b2, voffB);
            PG8_BAR; PG8_WAIT_L(0); PG8_MMA(0, 1, At, B1); PG8_BAR;
            PG8_LDA(At, 0, 1); PG8_STAGE(PG8_SA(0, 0), a2, voffA);
            PG8_BAR; PG8_WAIT_L(0); PG8_MMA(1, 0, At, B0); PG8_BAR; PG8_SCHED;
            PG8_STAGE(PG8_SB(0, 1), b2 + hstepB, voffB);
            PG8_WAIT_V(6); PG8_BAR; PG8_MMA(1, 1, At, B1); PG8_BAR;
            PG8_LDB(B0, 1, 0); PG8_SCHED; PG8_LDA(At, 1, 0); PG8_STAGE(PG8_SA(0, 1), a2 + hstep, voffA);
            PG8_WAIT_L(8); PG8_BAR; PG8_WAIT_L(0); PG8_MMA(0, 0, At, B0); PG8_BAR; PG8_SCHED;
            PG8_LDB(B1, 1, 1); PG8_STAGE(PG8_SB(1, 0), b3, voffB);
            PG8_BAR; PG8_WAIT_L(0); PG8_MMA(0, 1, At, B1); PG8_BAR;
            PG8_LDA(At, 1, 1); PG8_STAGE(PG8_SA(1, 0), a3, voffA);
            PG8_BAR; PG8_WAIT_L(0); PG8_MMA(1, 0, At, B0); PG8_BAR; PG8_SCHED;
            PG8_STAGE(PG8_SB(1, 1), b3 + hstepB, voffB);
            PG8_WAIT_V(6); PG8_BAR; PG8_MMA(1, 1, At, B1); PG8_BAR;
            }
        }
        if constexpr (ALIGN_EPI) { if (wr == 0) PG8_BAR; }
        if constexpr (Epi::FP8) asm volatile("s_nop 15\n\ts_nop 15" ::: "memory");
        if constexpr (!Epi::AFTER_DRAIN) { E(acc, cur, wr, wc, fr, fq); if constexpr (EPI_TWICE && Epi::IDEMP) { asm volatile("" ::: "memory"); E(acc, cur, wr, wc, fr, fq); } S.done(cur); }
        if (!has_next) break;
        if constexpr (!(SP2 && Epi::FP8))
#pragma unroll
        for (int a = 0; a < 2; ++a)
#pragma unroll
            for (int b = 0; b < 2; ++b)
#pragma unroll
                for (int m = 0; m < 4; ++m)
#pragma unroll
                    for (int n = 0; n < 2; ++n) acc[a][b][m][n] = (f32x4){0.f, 0.f, 0.f, 0.f};
        cur = nxt; cA = nA; cB = nB; ++ui;
        if constexpr (ALIGN_EPI) { if (wr == 1) PG8_BAR; }
    }
    PG8_WAIT_V(0);
    if constexpr (!ALIGN_EPI) { if (wr == 0) PG8_BAR; }
    PG8_BAR;
    if constexpr (Epi::AFTER_DRAIN) { E.fused(acc, cur, wr, wc, fr, fq, lds, wid, lane); S.done(cur); }
#undef PG8_SA
#undef PG8_SB
#undef PG8_STAGE
#undef PG8_LDA
#undef PG8_LDB
#undef PG8_MMA
#undef PG8_MMA0
#undef PG8_WAIT_V
#undef PG8_WAIT_L
#undef PG8_BAR
#undef PG8_SCHED
}
}

constexpr int NWAVES = 8;
constexpr int BATCH = 32, SEQ = 2048, T = BATCH * SEQ, D = 1024, NPROJ = 2560, FF = 2816, NE = 8, DE = 3584, ADA = 6 * D;
constexpr float EPS = 1e-6f;
constexpr float C2 = 0.125f * 1.4426950408889634f;
constexpr int MAXTILES = 264;
constexpr size_t MiB = 1u << 20;
constexpr size_t WS_CTL = 0, CTL_ZERO_BYTES = 1 * MiB;
constexpr size_t WS_ADA = 1 * MiB;
constexpr size_t WS_G16 = 2560 * 1024;
constexpr size_t WS_PCNT = 3 * MiB;
constexpr size_t WS_TOKE = 4 * MiB, WS_TOKR = 5 * MiB, WS_TOKG = 6 * MiB;
constexpr size_t WS_SLOTT = 7 * MiB, WS_SLOTG = 3 * MiB + 256 * 1024;
constexpr size_t WS_WIN = 8 * MiB;
constexpr size_t WS_WOUT = 18 * MiB;
constexpr size_t WS_WGU = 22 * MiB;
constexpr size_t WS_WD = 33 * MiB;
constexpr size_t WS_GW = 39 * MiB;
constexpr size_t WS_MWGU = 40 * MiB;
constexpr size_t WS_MWD = 96 * MiB;
constexpr size_t WS_XB = 124 * MiB;
constexpr size_t WS_HB = 252 * MiB;
constexpr size_t WS_BIG = 380 * MiB;
constexpr size_t WS_ACT = WS_BIG;
constexpr size_t WS_XS = WS_BIG, WS_ACTM = WS_BIG + 132 * MiB;
constexpr size_t WS_END = 1024 * MiB;
static_assert(WS_ACTM + (size_t)2 * MAXTILES * 256 * DE <= WS_END && WS_XS + (size_t)2 * MAXTILES * 256 * D <= WS_ACTM && WS_ACT + (size_t)T * FF * 2 <= WS_END && WS_BIG + (size_t)T * NPROJ * 2 <= WS_END, "d_ws map");
static_assert(WS_SLOTG + (size_t)2 * MAXTILES * 256 * 4 <= WS_TOKE && WS_SLOTT + (size_t)2 * MAXTILES * 256 * 4 <= WS_WIN && WS_WD + (size_t)D * FF * 2 <= WS_GW && WS_MWGU + (size_t)NE * 2 * DE * D <= WS_MWD
              && WS_MWD + (size_t)NE * D * DE <= WS_XB && WS_XB + (size_t)T * D * 2 <= WS_HB && WS_HB + (size_t)T * D * 2 <= WS_BIG, "d_ws map");
constexpr int CW_TMO = 0, CW_CODE = 1, CW_BAR = 4096;
constexpr int RING_OFF = 0, RING_BYTES = 131072;
constexpr int LDSCTL_OFF = RING_BYTES, MISC_OFF = LDSCTL_OFF + 320, MOE_OFF = LDSCTL_OFF + 512;
constexpr int LDS_BYTES = 147456;
constexpr int MT_TOT = 0, MT_POFF = 8, MT_NT = 20, MT_PBASE = 24, MT_TILE = 32;
constexpr int MT_STRIDE = 128;
static_assert(MT_TILE * 4 + 272 <= MT_STRIDE * 4 && MOE_OFF + 2 * MT_STRIDE * 4 <= LDS_BYTES, "LDS map");

#define GAS __attribute__((address_space(1)))
#define LAS __attribute__((address_space(3)))
typedef unsigned short bf16;
typedef unsigned v4u __attribute__((ext_vector_type(4)));
typedef unsigned v2u __attribute__((ext_vector_type(2)));
typedef float f32x4 __attribute__((ext_vector_type(4)));
typedef GAS unsigned gu32;
#define RLX_AGENT __ATOMIC_RELAXED, __HIP_MEMORY_SCOPE_AGENT
#define LDS_WAIT() asm volatile("s_waitcnt lgkmcnt(0)" ::: "memory")
#define VM_WAIT() asm volatile("s_waitcnt vmcnt(0)" ::: "memory")
__device__ __forceinline__ unsigned f2bf(float f) { unsigned u = __builtin_bit_cast(unsigned, f); return (u + 0x7fffu + ((u >> 16) & 1u)) >> 16; }
__device__ __forceinline__ unsigned pk2(float lo, float hi) { return f2bf(lo) | (f2bf(hi) << 16); }
__device__ __forceinline__ float bflo(unsigned w) { return __builtin_bit_cast(float, w << 16); }
__device__ __forceinline__ float bfhi(unsigned w) { return __builtin_bit_cast(float, w & 0xffff0000u); }
template <int CTRL, int ROW_MASK>
__device__ __forceinline__ float dpp_f(float v) {
    return __builtin_bit_cast(float, __builtin_amdgcn_update_dpp(0, __builtin_bit_cast(int, v), CTRL, ROW_MASK, 0xf, false)); }
__device__ __forceinline__ float wave_sum(float v) {
    v += dpp_f<0xB1, 0xf>(v);
    v += dpp_f<0x4E, 0xf>(v);
    v += dpp_f<0x141, 0xf>(v);
    v += dpp_f<0x140, 0xf>(v);
    v += dpp_f<0x142, 0xa>(v);
    v += dpp_f<0x143, 0xc>(v);
    return __builtin_bit_cast(float, __builtin_amdgcn_readlane(__builtin_bit_cast(int, v), 63));
}

__device__ __forceinline__ int opaque_tid() { int t = threadIdx.x; asm volatile("" : "+v"(t)); return t; }
__device__ __forceinline__ unsigned char* opaque_ptr(unsigned char* p) { size_t z = 0; asm volatile("" : "+s"(z)); return p + z; }
__device__ __forceinline__ int opaque_i(int v) { asm volatile("" : "+s"(v)); return v; }
#define PHASE_IDS() const int tid = opaque_tid(), lane = tid & 63, wave = __builtin_amdgcn_readfirstlane(tid >> 6); (void)lane; (void)wave

#define XB_TMO      128
#define XB_XCNT(j)  (256  + 64 * (j))
#define XB_XSUB(j)  (1280 + 64 * (j))
#define XB_XGEN(j)  (2304 + 64 * (j))
#define XB_TOP      3328
#define XB_TOPGEN   3392
#define XCD_BAR_WORDS 3456
#define XB_SPIN_CAP (1u << 18)

__device__ __forceinline__ unsigned xb_ld(unsigned* p)              { return __hip_atomic_load(p, __ATOMIC_RELAXED, __HIP_MEMORY_SCOPE_AGENT); }
__device__ __forceinline__ unsigned xb_add(unsigned* p, unsigned v) { return __hip_atomic_fetch_add(p, v, __ATOMIC_RELAXED, __HIP_MEMORY_SCOPE_AGENT); }
__device__ __forceinline__ unsigned xb_xcc_id() { return (unsigned)__builtin_amdgcn_s_getreg((3 << 11) | 20) & 0xFu; }
#define XB_SPIN(cond, bar) do { unsigned _sp = 0; while (cond) { __builtin_amdgcn_s_sleep(1); \
    if ((++_sp & 255u) == 0u) { if (xb_ld(&(bar)[XB_TMO])) break; if (_sp > XB_SPIN_CAP) { atomicAdd(&(bar)[XB_TMO], 1u); break; } } } } while (0)

struct XcdBarrier {
    unsigned* bar; unsigned x;
    volatile LAS unsigned* st;
};

__device__ __forceinline__ XcdBarrier xcd_barrier_post(unsigned* bar, volatile LAS unsigned* st) {
    XcdBarrier b; b.bar = bar; b.x = xb_xcc_id(); b.st = st;
    if (threadIdx.x == 0) (void)xb_add(&bar[XB_XCNT(b.x)], 1u);
    return b;
}
__device__ __forceinline__ void xcd_barrier_complete(unsigned* bar, unsigned x, unsigned& nloc, unsigned& nx) {
    const unsigned G = gridDim.x * gridDim.y * gridDim.z;
    unsigned sum, cnt, mine, sp = 0u;
    for (;;) {
        sum = 0u; cnt = 0u; mine = 0u;
#pragma unroll
        for (unsigned j = 0; j < 16; ++j) { const unsigned c = xb_ld(&bar[XB_XCNT(j)]); sum += c; cnt += (c > 0u) ? 1u : 0u; mine = (j == x) ? c : mine; }
        if (sum == G) break;
        __builtin_amdgcn_s_sleep(1);
        if ((++sp & 255u) == 0u) { if (xb_ld(&bar[XB_TMO])) break; if (sp > XB_SPIN_CAP) { atomicAdd(&bar[XB_TMO], 1u); break; } }
    }
    nloc = mine > 0u ? mine : 1u; nx = cnt > 0u ? cnt : 1u;
}

__device__ __forceinline__ void xcd_barrier(const XcdBarrier& b) {
    asm volatile("s_waitcnt vmcnt(0)" ::: "memory");
    __syncthreads();
    if (threadIdx.x == 0) {
        unsigned* bar = b.bar;
        __builtin_amdgcn_s_waitcnt(0);
        unsigned nloc = b.st[0], nx = b.st[1];
        if (nloc == 0u) { xcd_barrier_complete(bar, b.x, nloc, nx); b.st[0] = nloc; b.st[1] = nx; }
        const unsigned old = xb_add(&bar[XB_XSUB(b.x)], 1u);
        const unsigned gen = old / nloc;
        if (old + 1u == (gen + 1u) * nloc) {
            __builtin_amdgcn_fence(__ATOMIC_RELEASE, "agent");
            asm volatile("s_waitcnt vmcnt(0)" ::: "memory");
            const unsigned og = xb_add(&bar[XB_TOP], 1u);
            const unsigned tg = og / nx;
            if (og + 1u == (tg + 1u) * nx) xb_add(&bar[XB_TOPGEN], 1u);
            else XB_SPIN(xb_ld(&bar[XB_TOPGEN]) == tg, bar);
            __builtin_amdgcn_fence(__ATOMIC_ACQUIRE, "agent");
            xb_add(&bar[XB_XGEN(b.x)], 1u);
            asm volatile("s_waitcnt vmcnt(0)" ::: "memory");
        } else {
            XB_SPIN(xb_ld(&bar[XB_XGEN(b.x)]) == gen, bar);
            __builtin_amdgcn_fence(__ATOMIC_ACQUIRE, "agent");
            asm volatile("s_waitcnt vmcnt(0)" ::: "memory");
        }
    }
    __syncthreads();
}

__device__ __forceinline__ void transpose_item(const float* W, int K, int N, bf16* WT, int mode, LAS float* scr, int item, int lane) {
    const int nblk = N / 32, kb = item / nblk, nb = item % nblk, k0 = 64 * kb, n0 = 32 * nb;
#pragma unroll 8
    for (int i = 0; i < 32; ++i) { const int kk = 2 * i + (lane >> 5); scr[kk * 33 + (lane & 31)] = W[(size_t)(k0 + kk) * N + n0 + (lane & 31)]; }
    LDS_WAIT(); asm volatile("" ::: "memory");
    const int c = lane & 7; const float wsc = (mode == 1) ? 1.4426950408889634f : (mode == 2) ? 0.6931471805599453f : 1.0f;
#pragma unroll
    for (int j = 0; j < 4; ++j) { const int n = (lane >> 3) + 8 * j; const LAS float* s = scr + (8 * c) * 33 + n;
        v4u o; o.x = pk2(s[0 * 33] * wsc, s[1 * 33] * wsc); o.y = pk2(s[2 * 33] * wsc, s[3 * 33] * wsc); o.z = pk2(s[4 * 33] * wsc, s[5 * 33] * wsc); o.w = pk2(s[6 * 33] * wsc, s[7 * 33] * wsc);
        const int nc = n0 + n; const int drow = (mode == 0) ? nc : (((nc >> 7) << 8) + ((mode == 2) ? 128 : 0) + (nc & 127));
        *(GAS v4u*)(WT + (size_t)drow * K + k0 + 8 * c) = o; }
    LDS_WAIT(); asm volatile("" ::: "memory");
}
__device__ __forceinline__ void transpose_item_f8(const float* W, int K, int N, unsigned char* WT, int mode, LAS float* scr, int item, int lane) {
    const int nblk = N / 32, kb = item / nblk, nb = item % nblk, k0 = 64 * kb, n0 = 32 * nb;
#pragma unroll 8
    for (int i = 0; i < 32; ++i) { const int kk = 2 * i + (lane >> 5); scr[kk * 33 + (lane & 31)] = W[(size_t)(k0 + kk) * N + n0 + (lane & 31)]; }
    LDS_WAIT(); asm volatile("" ::: "memory");
    const int c = lane & 7; const float wsc = (mode == 1) ? 1.4426950408889634f : (mode == 2) ? 0.6931471805599453f : 1.0f;
#pragma unroll
    for (int j = 0; j < 4; ++j) { const int n = (lane >> 3) + 8 * j; const LAS float* s = scr + (8 * c) * 33 + n;
        v2u o; o.x = pg8::pk4_fp8((f32x4){s[0 * 33], s[1 * 33], s[2 * 33], s[3 * 33]} * (32.0f * wsc)); o.y = pg8::pk4_fp8((f32x4){s[4 * 33], s[5 * 33], s[6 * 33], s[7 * 33]} * (32.0f * wsc));
        const int nc = n0 + n; const int drow = (mode == 0) ? nc : (((nc >> 7) << 8) + ((mode == 2) ? 128 : 0) + (nc & 127));
        *(GAS v2u*)(WT + (size_t)drow * K + k0 + 8 * c) = o; }
    LDS_WAIT(); asm volatile("" ::: "memory");
}
struct Args { const float* in[22]; float* out; unsigned char* ws; };
__device__ __forceinline__ void p0_transposes(const Args& P, LAS unsigned char* lds, int blk, int G) {
    PHASE_IDS();
    LAS float* scr = (LAS float*)(lds + RING_OFF + wave * 16384);
    const int gw = blk * NWAVES + wave, NGW = G * NWAVES;
    bf16* Win_t = (bf16*)(P.ws + WS_WIN); bf16* Wout_t = (bf16*)(P.ws + WS_WOUT); bf16* Wgu_t = (bf16*)(P.ws + WS_WGU); bf16* Wd_t = (bf16*)(P.ws + WS_WD);
    unsigned char* MWgu8 = P.ws + WS_MWGU; unsigned char* MWd8 = P.ws + WS_MWD;
    constexpr int I_IN = (D / 64) * (NPROJ / 32), I_OUT = (D / 64) * (D / 32), I_GU = (D / 64) * (FF / 32), I_DN = (FF / 64) * (D / 32), I_MGU = (D / 64) * (DE / 32), I_MDN = (DE / 64) * (D / 32);
    constexpr int NITEMS = 2 * I_IN + 2 * I_OUT + 2 * I_GU + I_DN + 16 * I_MGU + 8 * I_MDN;
    for (int it = gw; it < NITEMS; it += NGW) {
        int r = it;
        if (r < 2 * I_IN) { const int l = r / I_IN; transpose_item(P.in[6] + (size_t)l * D * NPROJ, D, NPROJ, Win_t + (size_t)l * NPROJ * D, 0, scr, r % I_IN, lane); continue; } r -= 2 * I_IN;
        if (r < 2 * I_OUT) { const int l = r / I_OUT; transpose_item(P.in[13] + (size_t)l * D * D, D, D, Wout_t + (size_t)l * D * D, 0, scr, r % I_OUT, lane); continue; } r -= 2 * I_OUT;
#ifdef FFN_FP8
        if (r < I_GU) { transpose_item_f8(P.in[14], D, FF, (unsigned char*)Wgu_t, 1, scr, r, lane); continue; } r -= I_GU;
        if (r < I_GU) { transpose_item_f8(P.in[15], D, FF, (unsigned char*)Wgu_t, 2, scr, r, lane); continue; } r -= I_GU;
        if (r < I_DN) { transpose_item_f8(P.in[16], FF, D, (unsigned char*)Wd_t, 0, scr, r, lane); continue; } r -= I_DN;
#else
#if FFN_GU_FP8
        if (r < I_GU) { transpose_item_f8(P.in[14], D, FF, (unsigned char*)Wgu_t, 1, scr, r, lane); continue; } r -= I_GU;
        if (r < I_GU) { transpose_item_f8(P.in[15], D, FF, (unsigned char*)Wgu_t, 2, scr, r, lane); continue; } r -= I_GU;
#else
        if (r < I_GU) { transpose_item(P.in[14], D, FF, Wgu_t, 1, scr, r, lane); continue; } r -= I_GU;
        if (r < I_GU) { transpose_item(P.in[15], D, FF, Wgu_t, 2, scr, r, lane); continue; } r -= I_GU;
#endif
#if FFN_DOWN_FP8
        if (r < I_DN) { transpose_item_f8(P.in[16], FF, D, (unsigned char*)Wd_t, 0, scr, r, lane); continue; } r -= I_DN;
#else
        if (r < I_DN) { transpose_item(P.in[16], FF, D, Wd_t, 0, scr, r, lane); continue; } r -= I_DN;
#endif
#endif
        if (r < 8 * I_MGU) { const int e = r / I_MGU; transpose_item_f8(P.in[19] + (size_t)e * D * DE, D, DE, MWgu8 + (size_t)e * 2 * DE * D, 1, scr, r % I_MGU, lane); continue; } r -= 8 * I_MGU;
        if (r < 8 * I_MGU) { const int e = r / I_MGU; transpose_item_f8(P.in[20] + (size_t)e * D * DE, D, DE, MWgu8 + (size_t)e * 2 * DE * D, 2, scr, r % I_MGU, lane); continue; } r -= 8 * I_MGU;
        { const int e = r / I_MDN; transpose_item_f8(P.in[21] + (size_t)e * DE * D, DE, D, MWd8 + (size_t)e * D * DE, 0, scr, r % I_MDN, lane); }
    }
}
__device__ __forceinline__ void p0_ada(const Args& P, LAS unsigned char* lds, int blk, int G) {
    PHASE_IDS();
    LAS float* ca = (LAS float*)(lds + RING_OFF);
    const float* c = P.in[1]; const float* ada_w = P.in[2]; const float* ada_b = P.in[3]; float* ada = (float*)(P.ws + WS_ADA);
    for (int u = blk; u < 192; u += G) {
        const int l = u / 96, col0 = (u % 96) * 64;
        __syncthreads();
        for (int idx = tid; idx < 32768; idx += NWAVES * 64) { const int b = idx & 31, k = idx >> 5; const float v = c[b * 1024 + k]; ca[idx] = v / (1.0f + expf(-v)); }
        __syncthreads();
        float acc[32];
#pragma unroll
        for (int b = 0; b < 32; ++b) acc[b] = 0.f;
        const float* wp = ada_w + ((size_t)l * 1024 + wave * 128) * ADA + col0 + lane;
        for (int kk = 0; kk < 128; ++kk) { const float wv = wp[(size_t)kk * ADA]; const LAS f32x4* cp = (const LAS f32x4*)(ca + (wave * 128 + kk) * 32);
#pragma unroll
            for (int q = 0; q < 8; ++q) { const f32x4 cv = cp[q]; acc[4 * q] += cv.x * wv; acc[4 * q + 1] += cv.y * wv; acc[4 * q + 2] += cv.z * wv; acc[4 * q + 3] += cv.w * wv; } }
        __syncthreads();
#pragma unroll
        for (int b = 0; b < 32; ++b) ca[(wave * 32 + b) * 64 + lane] = acc[b];
        __syncthreads();
#pragma unroll
        for (int o = 0; o < 4; ++o) { const int idx = tid + 512 * o, b = idx >> 6, ln = idx & 63; float s = 0.f;
#pragma unroll
            for (int w = 0; w < 8; ++w) s += ca[(w * 32 + b) * 64 + ln];
            const float av = s + ada_b[l * ADA + col0 + ln];
            ada[((size_t)l * 32 + b) * ADA + col0 + ln] = av;
            if (l == 1 && col0 >= 5 * D) ((bf16*)(P.ws + WS_G16))[b * D + col0 + ln - 5 * D] = (bf16)f2bf(av); }
    }
    __syncthreads();
}
template <bool ROUTE, bool OUT8 = false, bool XBF = false>
__device__ __forceinline__ void norm_phase(const float* xsrc, const float* gvec, const float* ada_l, int sc_off, int sh_off, bf16* HB,
                                           const float* rw, const float* rb, int* pcnt, int* tok_e, int* tok_rank, float* tok_gate,
                                           LAS unsigned char* lds, int blk, int G) {
    PHASE_IDS();
    LAS int* pe = (LAS int*)(lds + RING_OFF); LAS float* pg = (LAS float*)(lds + RING_OFF + 2048); LAS int* wcnt = (LAS int*)(lds + RING_OFF + 4096);
    const LAS f32x4* rwl = (const LAS f32x4*)(lds + RING_OFF + 8192);
    f32x4 rwr[16];
    if constexpr (ROUTE) {
#pragma unroll
        for (int j = 0; j < 4; ++j)
#pragma unroll
            for (int i = 0; i < 4; ++i) rwr[j * 4 + i] = *(const GAS f32x4*)(rw + (size_t)(256 * j + 4 * lane + i) * 8);
        LAS float* wl = (LAS float*)(lds + RING_OFF + 8192);
        for (int idx = tid; idx < D * 8; idx += NWAVES * 64) { const int col = idx >> 3, e = idx & 7; wl[((((col >> 8) * 4 + (col & 3)) * 2 + (e >> 2)) * 64 + ((col & 255) >> 2)) * 4 + (e & 3)] = rw[idx]; }
        __syncthreads();
    }
    for (int p = blk; p < T / 256; p += G) {
        const int b = p >> 3;
        f32x4 mod[4], sh[4];
#pragma unroll
        for (int j = 0; j < 4; ++j) { const int col = 4 * lane + 256 * j; const f32x4 g4 = *(const f32x4*)(gvec + col); const f32x4 sc4 = *(const f32x4*)(ada_l + (size_t)b * ADA + sc_off + col);
            sh[j] = *(const f32x4*)(ada_l + (size_t)b * ADA + sh_off + col); mod[j] = g4 * (1.0f + sc4); }
        float rbv[8];
        if constexpr (ROUTE) {
#pragma unroll
            for (int e = 0; e < 8; ++e) rbv[e] = rb[e];
        }
        const int skew = (p * 5) & 31;
        constexpr int NAH = 4;
        f32x4 vbx[NAH][4]; v2u vbb[NAH][4];
#pragma unroll
        for (int q = 0; q < NAH; ++q) {
            if constexpr (XBF) { const GAS v2u* xr0 = (const GAS v2u*)((const bf16*)xsrc + (size_t)(p * 256 + ((q + skew) & 31) * 8 + wave) * D) + lane;
#pragma unroll
              for (int j = 0; j < 4; ++j) vbb[q][j] = xr0[64 * j]; }
            else { const GAS f32x4* xr0 = (const GAS f32x4*)(xsrc + (size_t)(p * 256 + ((q + skew) & 31) * 8 + wave) * D) + lane;
#pragma unroll
              for (int j = 0; j < 4; ++j) vbx[q][j] = xr0[64 * j]; } }
        for (int rr0 = 0; rr0 < 32; rr0 += NAH)
#pragma unroll
        for (int q = 0; q < NAH; ++q) {
            const int rr = rr0 + q;
            const int rs_ = (rr + skew) & 31, row = p * 256 + rs_ * 8 + wave;
            f32x4 v[4]; float ss = 0.f;
#pragma unroll
            for (int j = 0; j < 4; ++j) { if constexpr (XBF) v[j] = (f32x4){bflo(vbb[q][j].x), bfhi(vbb[q][j].x), bflo(vbb[q][j].y), bfhi(vbb[q][j].y)}; else v[j] = vbx[q][j]; }
            if (rr + NAH < 32) {
                if constexpr (XBF) { const GAS v2u* xr = (const GAS v2u*)((const bf16*)xsrc + (size_t)(p * 256 + ((rr + NAH + skew) & 31) * 8 + wave) * D) + lane;
#pragma unroll
                    for (int j = 0; j < 4; ++j) vbb[q][j] = xr[64 * j]; }
                else { const GAS f32x4* xr = (const GAS f32x4*)(xsrc + (size_t)(p * 256 + ((rr + NAH + skew) & 31) * 8 + wave) * D) + lane;
#pragma unroll
                    for (int j = 0; j < 4; ++j) vbx[q][j] = xr[64 * j]; } }
#pragma unroll
            for (int j = 0; j < 4; ++j) ss += (v[j].x * v[j].x + v[j].y * v[j].y) + (v[j].z * v[j].z + v[j].w * v[j].w);
            const float rs = 1.0f / sqrtf(wave_sum(ss) * (1.0f / D) + EPS);
            GAS unsigned long long* o8 = (GAS unsigned long long*)(HB + (size_t)row * D) + lane;
#pragma unroll
            for (int j = 0; j < 4; ++j) { v[j] = v[j] * rs * mod[j] + sh[j];
                if constexpr (OUT8) *(GAS unsigned*)((unsigned char*)HB + (size_t)row * D + 4 * lane + 256 * j) = pg8::pk4_fp8(v[j]);
                else o8[64 * j] = (unsigned long long)pk2(v[j].x, v[j].y) | ((unsigned long long)pk2(v[j].z, v[j].w) << 32); }
            if constexpr (ROUTE) {
                float lg[8];
#pragma unroll
                for (int e = 0; e < 8; ++e) lg[e] = 0.f;
#pragma unroll
                for (int j = 0; j < 4; ++j)
#pragma unroll
                    for (int i = 0; i < 4; ++i) { const float y = v[j][i]; const f32x4 r0 = rwr[j * 4 + i], r1 = rwl[((j * 4 + i) * 2 + 1) * 64 + lane];
#pragma unroll
                        for (int e = 0; e < 4; ++e) { lg[e] += y * r0[e]; lg[4 + e] += y * r1[e]; } }
#pragma unroll
                for (int e = 0; e < 8; ++e) lg[e] = wave_sum(lg[e]) + rbv[e];
                int e1 = 0; float l1 = lg[0];
#pragma unroll
                for (int e = 1; e < 8; ++e) if (lg[e] > l1) { l1 = lg[e]; e1 = e; }
                int e2 = 0; float l2 = -INFINITY;
#pragma unroll
                for (int e = 0; e < 8; ++e) if (e != e1 && lg[e] > l2) { l2 = lg[e]; e2 = e; }
                const float g1 = 1.0f / (1.0f + expf(l2 - l1));
                if (lane == 0) { const int i = rs_ * 8 + wave; pe[i] = e1; pe[256 + i] = e2; pg[i] = g1; pg[256 + i] = 1.0f - g1; }
            }
        }
        if constexpr (ROUTE) {
            __syncthreads();
            int lr[2] = {0, 0};
            if (tid < 256) {
#pragma unroll
                for (int k = 0; k < 2; ++k) { const int e = pe[k * 256 + tid];
#pragma unroll
                    for (int ee = 0; ee < 8; ++ee) { const unsigned long long m = __ballot(e == ee); if (e == ee) lr[k] = __popcll(m & ((1ull << lane) - 1ull)); if (lane == 0) wcnt[(k * 4 + wave) * 8 + ee] = __popcll(m); } }
            }
            __syncthreads();
            if (tid < 256) { const int t = p * 256 + tid;
#pragma unroll
                for (int k = 0; k < 2; ++k) { const int e = pe[k * 256 + tid]; int base = 0;
#pragma unroll
                    for (int w2 = 0; w2 < 4; ++w2) if (w2 < wave) base += wcnt[(k * 4 + w2) * 8 + e];
                    tok_e[t * 2 + k] = e; tok_rank[t * 2 + k] = base + lr[k]; tok_gate[t * 2 + k] = pg[k * 256 + tid]; } }
            if (tid < 16) { const int k = tid >> 3, ee = tid & 7; pcnt[p * 16 + tid] = wcnt[(k * 4 + 0) * 8 + ee] + wcnt[(k * 4 + 1) * 8 + ee] + wcnt[(k * 4 + 2) * 8 + ee] + wcnt[(k * 4 + 3) * 8 + ee]; }
            __syncthreads();
        }
    }
}
__device__ __forceinline__ void qknorm_phase(bf16* PROJ, const float* qg, const float* kg, int blk, int G) {
    PHASE_IDS();
    const int gw = blk * NWAVES + wave, NGW = G * NWAVES;
    float gq[8], gk[8];
#pragma unroll
    for (int i = 0; i < 8; ++i) { gq[i] = qg[(lane & 7) * 8 + i] * C2; gk[i] = kg[(lane & 7) * 8 + i]; }
    for (int it = gw; it < 2 * T; it += NGW) {
        const int row = it >> 1, which = it & 1;
        GAS v4u* p = (GAS v4u*)(PROJ + (size_t)row * NPROJ + which * 512 + lane * 8);
        const v4u raw = *p; float v[8];
#pragma unroll
        for (int i = 0; i < 4; ++i) { v[2 * i] = bflo(raw[i]); v[2 * i + 1] = bfhi(raw[i]); }
        float ss = 0.f;
#pragma unroll
        for (int i = 0; i < 8; ++i) ss += v[i] * v[i];
        ss += __shfl_xor(ss, 1); ss += __shfl_xor(ss, 2); ss += __shfl_xor(ss, 4);
        const float rs = 1.0f / sqrtf(ss * (1.0f / 64.0f) + EPS);
        v4u o;
#pragma unroll
        for (int i = 0; i < 4; ++i) { const float a = v[2 * i] * rs * (which ? gk[2 * i] : gq[2 * i]), c = v[2 * i + 1] * rs * (which ? gk[2 * i + 1] : gq[2 * i + 1]); o[i] = pk2(a, c); }
        *p = o;
    }
}
__device__ __forceinline__ void attn_simple(const bf16* PROJ, bf16* MIX, LAS unsigned char* lds, int blk, int G) {
    PHASE_IDS();
    LAS float* Ks = (LAS float*)(lds + RING_OFF); LAS float* Vs = Ks + 64 * 64;
    for (int i = 0;; ++i) {
        const int u = i * G + blk; if (u >= BATCH * 8 * 4) break;
        const int bh = u >> 2, qb = ((u & 3) + i) & 3, b = bh >> 3, h = bh & 7;
        const int tq = qb * 512 + tid; const size_t rowq = (size_t)b * SEQ + tq;
        float q[64], o[64];
        { const GAS v4u* qp = (const GAS v4u*)(PROJ + rowq * NPROJ + h * 64);
#pragma unroll
          for (int c = 0; c < 8; ++c) { const v4u w = qp[c];
#pragma unroll
              for (int e = 0; e < 4; ++e) { q[8 * c + 2 * e] = bflo(w[e]); q[8 * c + 2 * e + 1] = bfhi(w[e]); } } }
#pragma unroll
        for (int d = 0; d < 64; ++d) o[d] = 0.f;
        float carry = 0.f;
        const int wq_max = qb * 512 + wave * 64 + 63;
        for (int kt = (qb * 512 + 511) >> 6; kt >= 0; --kt) {
            __syncthreads();
            { const size_t krow = (size_t)b * SEQ + kt * 64 + (tid >> 3); const int d8 = (tid & 7) * 8;
              const v4u kr = *(const GAS v4u*)(PROJ + krow * NPROJ + 512 + h * 64 + d8); const v4u vr = *(const GAS v4u*)(PROJ + krow * NPROJ + 1024 + h * 64 + d8);
              LAS float* kd = Ks + (tid >> 3) * 64 + d8; LAS float* vd = Vs + (tid >> 3) * 64 + d8;
#pragma unroll
              for (int e = 0; e < 4; ++e) { kd[2 * e] = bflo(kr[e]); kd[2 * e + 1] = bfhi(kr[e]); vd[2 * e] = bflo(vr[e]); vd[2 * e + 1] = bfhi(vr[e]); } }
            __syncthreads();
            if (kt * 64 < wq_max) {
                for (int j = 63; j >= 0; --j) {
                    const int key = kt * 64 + j;
                    const LAS f32x4* kp = (const LAS f32x4*)(Ks + j * 64); float z = 0.f;
#pragma unroll
                    for (int d4 = 0; d4 < 16; ++d4) { const f32x4 kv = kp[d4]; z += q[4 * d4] * kv.x + q[4 * d4 + 1] * kv.y + q[4 * d4 + 2] * kv.z + q[4 * d4 + 3] * kv.w; }
                    const bool valid = key < tq;
                    const float sp = fmaxf(z, 0.f) + __builtin_amdgcn_logf(1.0f + __builtin_amdgcn_exp2f(-fabsf(z)));
                    const float L = valid ? -sp : 0.f;
                    const float w = valid ? __builtin_amdgcn_exp2f(z + L + carry) : 0.f;
                    carry += L;
                    const LAS f32x4* vp = (const LAS f32x4*)(Vs + j * 64);
#pragma unroll
                    for (int d4 = 0; d4 < 16; ++d4) { const f32x4 vv = vp[d4]; o[4 * d4] += w * vv.x; o[4 * d4 + 1] += w * vv.y; o[4 * d4 + 2] += w * vv.z; o[4 * d4 + 3] += w * vv.w; }
                }
            }
        }
        { GAS v4u* op = (GAS v4u*)(MIX + rowq * D + h * 64);
#pragma unroll
          for (int c = 0; c < 8; ++c) { v4u w;
#pragma unroll
              for (int e = 0; e < 4; ++e) w[e] = pk2(o[8 * c + 2 * e], o[8 * c + 2 * e + 1]);
              op[c] = w; } }
    }
    __syncthreads();
}
namespace sba {
typedef _Float16 f16x8 __attribute__((ext_vector_type(8)));
typedef _Float16 f16x2 __attribute__((ext_vector_type(2)));
typedef short bf16x8 __attribute__((ext_vector_type(8)));
typedef short s16x4 __attribute__((ext_vector_type(4)));
typedef float f32x16 __attribute__((ext_vector_type(16)));
typedef float f32x2_t __attribute__((ext_vector_type(2)));
typedef __bf16 bf16x2_t __attribute__((ext_vector_type(2)));
typedef unsigned u32x4 __attribute__((ext_vector_type(4)));
constexpr int SLOTB = 8192, NSLOT = 5, LDS_K = 0, LDS_V = NSLOT * SLOTB, LDS_BYTES_ATT = 2 * NSLOT * SLOTB;
constexpr float SBA_DEAD = -160.0f;
__device__ __forceinline__ int crow(int r, int hi) { return (r & 3) + 8 * (r >> 2) + 4 * hi; }
__device__ __forceinline__ unsigned cvtpk_bf16(float lo, float hi) { f32x2_t v = {lo, hi}; bf16x2_t b = __builtin_convertvector(v, bf16x2_t); return __builtin_bit_cast(unsigned, b); }
__device__ __forceinline__ unsigned cvtpk_f16(float lo, float hi) { f32x2_t v = {lo, hi}; f16x2 b = __builtin_convertvector(v, f16x2); return __builtin_bit_cast(unsigned, b); }
__device__ __forceinline__ s16x4 vtr(const LAS unsigned char* p) { return __builtin_bit_cast(s16x4, __builtin_amdgcn_ds_read_tr16_b64_v4i16((LAS s16x4*)p)); }

template <int MODE>
__device__ __forceinline__ void tile64(f32x16 (&oT)[2], float& carry, const bf16x8 (&qr)[4], const f16x8 (&tri)[2], const LAS unsigned char* Kslot, const LAS unsigned char* Vslot, int r32, int hi, int lane) {
    constexpr bool HAS1 = (MODE != 2), DIAG1 = (MODE == 1), DIAG0 = (MODE == 2);
    f32x16 z1, z0;
#pragma unroll
    for (int i = 0; i < 16; ++i) { z1[i] = 0.f; z0[i] = 0.f; }
#pragma unroll
    for (int d0 = 0; d0 < 4; ++d0) { const LAS unsigned char* kp = Kslot + (2 * d0 + hi) * 1024 + r32 * 16;
        if (HAS1) { const bf16x8 kf1 = *(const LAS bf16x8*)(kp + 512); z1 = __builtin_amdgcn_mfma_f32_32x32x16_bf16(kf1, qr[d0], z1, 0, 0, 0); }
        const bf16x8 kf0 = *(const LAS bf16x8*)kp; z0 = __builtin_amdgcn_mfma_f32_32x32x16_bf16(kf0, qr[d0], z0, 0, 0, 0); }
    float lg1[16], lg0[16];
#pragma unroll
    for (int i = 0; i < 16; ++i) {
        if (HAS1) { z1[i] = __builtin_amdgcn_fmed3f(z1[i], -3.0e38f, 126.0f); lg1[i] = __builtin_amdgcn_logf(1.0f + __builtin_amdgcn_exp2f(z1[i]));
            if (DIAG1) { const bool valid = crow(i, hi) < r32; lg1[i] = valid ? lg1[i] : 0.f; z1[i] = valid ? z1[i] : -1.0e30f; } }
        z0[i] = __builtin_amdgcn_fmed3f(z0[i], -3.0e38f, 126.0f); lg0[i] = __builtin_amdgcn_logf(1.0f + __builtin_amdgcn_exp2f(z0[i]));
        if (DIAG0) { const bool valid = crow(i, hi) < r32; lg0[i] = valid ? lg0[i] : 0.f; z0[i] = valid ? z0[i] : -1.0e30f; } }
    const float z1r0 = z1[0], z0r0 = z0[0];
    f32x16 D1 = z1, D0 = z0;
#pragma unroll
    for (int s = 0; s < 2; ++s) {
        if (HAS1) { u32x4 w;
#pragma unroll
            for (int j = 0; j < 4; ++j) w[j] = cvtpk_f16(lg1[8 * s + 2 * j], lg1[8 * s + 2 * j + 1]);
            D1 = __builtin_amdgcn_mfma_f32_32x32x16_f16(tri[s], __builtin_bit_cast(f16x8, w), D1, 0, 0, 0); }
        { u32x4 w;
#pragma unroll
            for (int j = 0; j < 4; ++j) w[j] = cvtpk_f16(lg0[8 * s + 2 * j], lg0[8 * s + 2 * j + 1]);
            D0 = __builtin_amdgcn_mfma_f32_32x32x16_f16(tri[s], __builtin_bit_cast(f16x8, w), D0, 0, 0, 0); } }
    float c0 = carry;
    if (HAS1) { const float t1 = D1[0] - z1r0; const auto rr = __builtin_amdgcn_permlane32_swap(__float_as_uint(t1), __float_as_uint(t1), false, false); c0 = carry + __uint_as_float(rr[0]); }
    const float t0 = D0[0] - z0r0; const auto rr0 = __builtin_amdgcn_permlane32_swap(__float_as_uint(t0), __float_as_uint(t0), false, false);
    float P1[16], P0[16];
#pragma unroll
    for (int i = 0; i < 16; ++i) { if (HAS1) P1[i] = __builtin_amdgcn_exp2f(D1[i] + carry); P0[i] = __builtin_amdgcn_exp2f(D0[i] + c0); }
    carry = c0 + __uint_as_float(rr0[0]);
#pragma unroll
    for (int ks = 3; ks >= 0; --ks) {
        if (ks >= 2 && !HAS1) continue;
        u32x4 w;
#pragma unroll
        for (int j = 0; j < 4; ++j) { const int e = 8 * (ks & 1) + 2 * j; w[j] = (ks >= 2) ? cvtpk_bf16(P1[e], P1[e + 1]) : cvtpk_bf16(P0[e], P0[e + 1]); }
        const bf16x8 pf = __builtin_bit_cast(bf16x8, w);
#pragma unroll
        for (int d0 = 0; d0 < 2; ++d0) { const LAS unsigned char* vp = Vslot + d0 * 4096 + ks * 1024 + ((lane >> 4) & 1) * 32 + (lane & 3) * 8 + (4 * hi + ((lane & 15) >> 2)) * 64;
            const s16x4 lo = vtr(vp), hh = vtr(vp + 512);
            const bf16x8 vf = (bf16x8){lo[0], lo[1], lo[2], lo[3], hh[0], hh[1], hh[2], hh[3]};
            oT[d0] = __builtin_amdgcn_mfma_f32_32x32x16_bf16(vf, pf, oT[d0], 0, 0, 0); } }
}
__device__ __forceinline__ void glds16(const void* gsrc, unsigned lds_dst) { unsigned keep;
    asm volatile("s_mov_b32 %0, m0\n\ts_mov_b32 m0, %2\n\ts_nop 0\n\tglobal_load_lds_dwordx4 %1, off\n\ts_mov_b32 m0, %0" : "=&s"(keep) : "v"(gsrc), "s"(lds_dst) : "memory"); }
#define SBA_DMA(t_, sl_) do { \
    glds16(ksrc + (size_t)(t_) * 64 * NPROJ, (unsigned)__builtin_amdgcn_readfirstlane(lds0 + LDS_K + (sl_) * SLOTB + wave * 1024)); \
    glds16(vsrc + (size_t)(t_) * 64 * NPROJ, (unsigned)__builtin_amdgcn_readfirstlane(lds0 + LDS_V + (sl_) * SLOTB + wave * 1024)); } while (0)
__device__ __forceinline__ void attn_phase(const bf16* PROJ, bf16* MIX, LAS unsigned char* lds, int blk, int G) {
    PHASE_IDS();
    const int r32 = lane & 31, hi = lane >> 5;
    const unsigned lds0 = (unsigned)(uintptr_t)lds;
    LAS unsigned* flg = (LAS unsigned*)(lds + LDS_BYTES_ATT);
    f16x8 tri[2];
#pragma unroll
    for (int s = 0; s < 2; ++s)
#pragma unroll
        for (int j = 0; j < 8; ++j) tri[s][j] = (16 * s + 8 * (j >> 2) + 4 * hi + (j & 3) >= r32) ? (_Float16)(-1.0f) : (_Float16)0.0f;
    int s0 = 0, s1 = 1, s2 = 2;
    int p0 = 3, p1 = 4;
    for (int bh = blk; bh < BATCH * 8; bh += G) {
        const int b = bh >> 3, h = bh & 7;
        const bf16* Kh = PROJ + (size_t)b * SEQ * NPROJ + 512 + h * 64; const bf16* Vh = PROJ + (size_t)b * SEQ * NPROJ + 1024 + h * 64;
        const bf16* ksrc = Kh + (size_t)lane * NPROJ + wave * 8;
        const bf16* vsrc = Vh + (size_t)(16 * (wave & 3) + (lane >> 2)) * NPROJ + (wave >> 2) * 32 + (lane & 3) * 8;
        SBA_DMA(3, s0); SBA_DMA(2, s1);
        bf16x8 qr[4], qn[4];
        { const bf16* qp = PROJ + ((size_t)b * SEQ + wave * 32 + r32) * NPROJ + h * 64 + hi * 8;
#pragma unroll
          for (int d0 = 0; d0 < 4; ++d0) qr[d0] = *(const GAS bf16x8*)(qp + d0 * 16); }
        asm volatile("" : "+v"(qr[0]), "+v"(qr[1]), "+v"(qr[2]), "+v"(qr[3]));
        for (int qb = 0; qb < SEQ / 256; ++qb) {
            const int q0w = qb * 256 + wave * 32, NT = 4 * (qb + 1);
            f32x16 oT[2];
#pragma unroll
            for (int i = 0; i < 16; ++i) { oT[0][i] = 0.f; oT[1][i] = 0.f; }
            float carry = 0.f;
            bool mydone = false;
            for (int t = NT - 1; t >= 0; --t) {
                if (t == NT - 1 && qb > 0) asm volatile("s_waitcnt lgkmcnt(0)\n\ts_barrier" ::: "memory");
                else if (t >= 1) asm volatile("s_waitcnt vmcnt(2) lgkmcnt(0)\n\ts_barrier" ::: "memory"); else asm volatile("s_waitcnt vmcnt(0) lgkmcnt(0)\n\ts_barrier" ::: "memory");
                if (t < NT - 1) { const LAS u32x4* fp = (const LAS u32x4*)(flg + ((t + 1) & 1) * 8); const u32x4 fa = fp[0], fb = fp[1];
                    const unsigned all8 = (fa.x & fa.y & fa.z & fa.w) & (fb.x & fb.y & fb.z & fb.w);
                    if (__builtin_amdgcn_readfirstlane((int)all8) != 0) break; }
                if (t == NT - 1 && qb + 1 < SEQ / 256) {
                    SBA_DMA(NT + 3, p0); SBA_DMA(NT + 2, p1);
                    const bf16* qp = PROJ + ((size_t)b * SEQ + q0w + 256 + r32) * NPROJ + h * 64 + hi * 8;
#pragma unroll
                    for (int d0 = 0; d0 < 4; ++d0) qn[d0] = *(const GAS bf16x8*)(qp + d0 * 16); }
                if (t >= 2) SBA_DMA(t - 2, s2);
                const LAS unsigned char* Kslot = lds + LDS_K + s0 * SLOTB; const LAS unsigned char* Vslot = lds + LDS_V + s0 * SLOTB;
                const int khi = 64 * t + 32;
                if (!mydone) {
                    if (khi < q0w) tile64<0>(oT, carry, qr, tri, Kslot, Vslot, r32, hi, lane);
                    else if (khi == q0w) tile64<1>(oT, carry, qr, tri, Kslot, Vslot, r32, hi, lane);
                    else if (khi == q0w + 32) tile64<2>(oT, carry, qr, tri, Kslot, Vslot, r32, hi, lane);
                    mydone = __all(carry < SBA_DEAD) != 0;
                }
                if (lane == 0) flg[(t & 1) * 8 + wave] = mydone ? 1u : 0u;
                { const int tmp = s0; s0 = s1; s1 = s2; s2 = tmp; }
            }
            { bf16* op = MIX + ((size_t)b * SEQ + q0w + r32) * D + h * 64 + 4 * hi;
#pragma unroll
              for (int d0 = 0; d0 < 2; ++d0)
#pragma unroll
                  for (int g = 0; g < 4; ++g) { v2u w; w.x = cvtpk_bf16(oT[d0][4 * g], oT[d0][4 * g + 1]); w.y = cvtpk_bf16(oT[d0][4 * g + 2], oT[d0][4 * g + 3]);
                      *(GAS v2u*)(op + 32 * d0 + 8 * g) = w; } }
            if (qb + 1 < SEQ / 256) {
                asm volatile("" : "+v"(qn[0]), "+v"(qn[1]), "+v"(qn[2]), "+v"(qn[3]));
#pragma unroll
                for (int d0 = 0; d0 < 4; ++d0) qr[d0] = qn[d0];
                const int o0 = s0, o1 = s1; s0 = p0; s1 = p1; p0 = o0; p1 = o1;
            }
        }
    }
    asm volatile("s_waitcnt vmcnt(0) lgkmcnt(0)" ::: "memory");
    __syncthreads();
}
#undef SBA_DMA
}
__device__ __forceinline__ void gmlp_simple(const bf16* PROJ, bf16* MIX, const float* lng, const float* lnb, const float* Wsp, const float* bsp,
                                            LAS unsigned char* lds, int blk, int G) {
    PHASE_IDS();
    LAS float* stats = (LAS float*)(lds + RING_OFF); LAS float* vln = stats + 256; LAS float* Wt = vln + 128 * 64;
    for (int u = blk; u < BATCH * 16; u += G) {
        const size_t row0 = (size_t)(u >> 4) * SEQ + (u & 15) * 128;
        __syncthreads();
        for (int tt = 0; tt < 16; ++tt) { const int tok = wave * 16 + tt;
            const v4u raw = *(const GAS v4u*)(PROJ + (row0 + tok) * NPROJ + 2048 + lane * 8); float v[8]; float s = 0.f;
#pragma unroll
            for (int i = 0; i < 4; ++i) { v[2 * i] = bflo(raw[i]); v[2 * i + 1] = bfhi(raw[i]); s += v[2 * i] + v[2 * i + 1]; }
            const float mean = wave_sum(s) * (1.0f / 512.0f); float s2 = 0.f;
#pragma unroll
            for (int i = 0; i < 8; ++i) { const float d = v[i] - mean; s2 += d * d; }
            const float rstd = 1.0f / sqrtf(wave_sum(s2) * (1.0f / 512.0f) + EPS);
            if (lane == 0) { stats[2 * tok] = mean; stats[2 * tok + 1] = rstd; } }
        for (int g = 0; g < 8; ++g) {
            __syncthreads();
            { const int tok = tid >> 2, cb = (tid & 3) * 16; const GAS v4u* vp = (const GAS v4u*)(PROJ + (row0 + tok) * NPROJ + 2048 + g * 64 + cb);
              const float mean = stats[2 * tok], rstd = stats[2 * tok + 1];
#pragma unroll
              for (int hh = 0; hh < 2; ++hh) { const v4u raw = vp[hh];
#pragma unroll
                  for (int e = 0; e < 4; ++e) { const int c = g * 64 + cb + hh * 8 + 2 * e;
                      vln[tok * 64 + cb + hh * 8 + 2 * e] = (bflo(raw[e]) - mean) * rstd * lng[c] + lnb[c];
                      vln[tok * 64 + cb + hh * 8 + 2 * e + 1] = (bfhi(raw[e]) - mean) * rstd * lng[c + 1] + lnb[c + 1]; } } }
            { const int i = tid & 127, jq = tid >> 7;
#pragma unroll
              for (int jj = 0; jj < 8; ++jj) { const int j4 = (jq * 8 + jj) * 4; f32x4 w = *(const f32x4*)(Wsp + ((size_t)g * 128 + i) * 128 + j4);
                  if (i < 64 && j4 >= 64) w = (f32x4){0.f, 0.f, 0.f, 0.f};
                  Wt[(j4 + 0) * 132 + i] = w.x; Wt[(j4 + 1) * 132 + i] = w.y; Wt[(j4 + 2) * 132 + i] = w.z; Wt[(j4 + 3) * 132 + i] = w.w; } }
            __syncthreads();
            const int tc = tid & 15, ti = tid >> 4; float acc[4][4];
#pragma unroll
            for (int r = 0; r < 4; ++r)
#pragma unroll
                for (int c = 0; c < 4; ++c) acc[r][c] = 0.f;
            const int jmax = (wave < 4) ? 64 : 128;
            for (int j = 0; j < jmax; ++j) { const f32x4 a = *(const LAS f32x4*)(vln + j * 64 + 4 * tc); const f32x4 w = *(const LAS f32x4*)(Wt + j * 132 + 4 * ti);
#pragma unroll
                for (int r = 0; r < 4; ++r)
#pragma unroll
                    for (int c = 0; c < 4; ++c) acc[r][c] += w[r] * a[c]; }
#pragma unroll
            for (int r = 0; r < 4; ++r) { const int i = 4 * ti + r; const float bias = bsp[g * 128 + i];
                const v2u ur = *(const GAS v2u*)(PROJ + (row0 + i) * NPROJ + 1536 + g * 64 + 4 * tc);
                v2u o; o.x = pk2((acc[r][0] + bias) * bflo(ur.x), (acc[r][1] + bias) * bfhi(ur.x)); o.y = pk2((acc[r][2] + bias) * bflo(ur.y), (acc[r][3] + bias) * bfhi(ur.y));
                *(GAS v2u*)(MIX + (row0 + i) * D + 512 + g * 64 + 4 * tc) = o; }
        }
    }
    __syncthreads();
}
__device__ __forceinline__ void p0_spatial(const Args& P, int blk, int G) {
    PHASE_IDS();
    bf16* GW = (bf16*)(P.ws + WS_GW); const float* W = P.in[11];
    for (int idx = blk * (NWAVES * 64) + tid; idx < 2 * 8 * 128 * 128; idx += G * NWAVES * 64) {
        const int p = idx & 127, i = (idx >> 7) & 127, ks = p >> 4, hh = (p >> 3) & 1, jj = p & 7, j = 16 * ks + 8 * (jj >> 2) + 4 * hh + (jj & 3);
        const float w = ((j >> 6) <= (i >> 6)) ? W[(size_t)(idx & ~127) + j] : 0.f;
        GW[idx] = (bf16)f2bf(w); }
}
__device__ __forceinline__ void gmlp_phase(const bf16* PROJ, bf16* MIX, const float* lng, const float* lnb, const bf16* GW, const float* bsp, LAS unsigned char* lds, int blk, int G) {
    PHASE_IDS();
    typedef short bf16x8 __attribute__((ext_vector_type(8))); typedef float f32x16 __attribute__((ext_vector_type(16)));
    const int r32 = lane & 31, hi = lane >> 5, mi = wave >> 1, ci = wave & 1;
    for (int u = blk; u < BATCH * 16; u += G) {
        const size_t row0 = (size_t)(u >> 4) * SEQ + (u & 15) * 128;
        float gam[8], bet[8];
#pragma unroll
        for (int i = 0; i < 8; ++i) { gam[i] = lng[lane * 8 + i]; bet[i] = lnb[lane * 8 + i]; }
        __syncthreads();
        v4u rawn[4];
#pragma unroll
        for (int q = 0; q < 4; ++q) rawn[q] = *(const GAS v4u*)(PROJ + (row0 + wave * 16 + q) * NPROJ + 2048 + lane * 8);
#pragma unroll 1
        for (int tb = 0; tb < 16; tb += 4) {
            v4u raw4[4];
#pragma unroll
            for (int q = 0; q < 4; ++q) raw4[q] = rawn[q];
            if (tb + 4 < 16) {
#pragma unroll
                for (int q = 0; q < 4; ++q) rawn[q] = *(const GAS v4u*)(PROJ + (row0 + wave * 16 + tb + 4 + q) * NPROJ + 2048 + lane * 8); }
#pragma unroll
            for (int q = 0; q < 4; ++q) { const int tt = tb + q; const v4u raw = raw4[q]; float v[8]; float s = 0.f;
#pragma unroll
                for (int i = 0; i < 4; ++i) {
#ifdef GELU_IN_PROJ
                    v[2 * i] = bflo(raw[i]); v[2 * i + 1] = bfhi(raw[i]);
#else
                    const pg8::f32x2 ge = pg8::gelu_pk((pg8::f32x2){bflo(raw[i]), bfhi(raw[i])}); v[2 * i] = ge.x; v[2 * i + 1] = ge.y;
#endif
                    s += v[2 * i] + v[2 * i + 1]; }
                const float mean = wave_sum(s) * (1.0f / 512.0f); float s2 = 0.f;
#pragma unroll
                for (int i = 0; i < 8; ++i) { v[i] -= mean; s2 += v[i] * v[i]; }
                const float rstd = 1.0f / sqrtf(wave_sum(s2) * (1.0f / 512.0f) + EPS);
                v4u o;
#pragma unroll
                for (int i = 0; i < 4; ++i) o[i] = pk2(v[2 * i] * rstd * gam[2 * i] + bet[2 * i], v[2 * i + 1] * rstd * gam[2 * i + 1] + bet[2 * i + 1]);
                *(LAS v4u*)(lds + RING_OFF + (((lane >> 3) * 2 + ((lane >> 2) & 1)) * 8 + wave) * 1024 + tt * 64 + (lane & 3) * 16) = o; } }
        __syncthreads();
        const int nks = (mi < 2) ? 4 : 8;
        const LAS unsigned char* vb = lds + RING_OFF + ((lane >> 4) & 1) * 32 + (lane & 3) * 8 + (4 * hi + ((lane & 15) >> 2)) * 64;
        const int tokr = mi * 32 + r32;
        bf16x8 wfA[8], wfB[8]; v2u urA[4], urB[4]; float biasA = 0.f, biasB = 0.f;
#define GM_LOAD(g_, W_, U_, B_) do { const bf16* wrow_ = GW + ((size_t)(g_) * 128 + mi * 32 + r32) * 128 + hi * 8; \
            _Pragma("unroll") for (int ks = 0; ks < 8; ++ks) W_[ks] = *(const GAS bf16x8*)(wrow_ + ks * 16);     \
            const bf16* up_ = PROJ + (row0 + tokr) * NPROJ + 1536 + (g_) * 64 + ci * 32 + 4 * hi; \
            _Pragma("unroll") for (int gg = 0; gg < 4; ++gg) U_[gg] = *(const GAS v2u*)(up_ + 8 * gg); \
            B_ = bsp[(g_) * 128 + tokr]; } while (0)
#define GM_COMP(g_, W_, U_, B_) do { f32x16 acc; _Pragma("unroll") for (int i = 0; i < 16; ++i) acc[i] = 0.f; \
            _Pragma("unroll") for (int ks = 0; ks < 8; ++ks) if (ks < nks) { const LAS unsigned char* vp = vb + (((g_) * 2 + ci) * 8 + ks) * 1024; \
                const sba::s16x4 lo = sba::vtr(vp), hh = sba::vtr(vp + 512); const bf16x8 vf = (bf16x8){lo[0], lo[1], lo[2], lo[3], hh[0], hh[1], hh[2], hh[3]}; \
                acc = __builtin_amdgcn_mfma_f32_32x32x16_bf16(vf, W_[ks], acc, 0, 0, 0); } \
            bf16* op = MIX + (row0 + tokr) * D + 512 + (g_) * 64 + ci * 32 + 4 * hi; \
            _Pragma("unroll") for (int gg = 0; gg < 4; ++gg) { const v2u ur = U_[gg]; \
                const pg8::f32x2 ga = pg8::gelu_pk((pg8::f32x2){bflo(ur.x), bfhi(ur.x)}), gb = pg8::gelu_pk((pg8::f32x2){bflo(ur.y), bfhi(ur.y)}); \
                v2u o; o.x = pk2((acc[4 * gg] + B_) * ga.x, (acc[4 * gg + 1] + B_) * ga.y); o.y = pk2((acc[4 * gg + 2] + B_) * gb.x, (acc[4 * gg + 3] + B_) * gb.y); \
                *(GAS v2u*)(op + 8 * gg) = o; } } while (0)
        GM_LOAD(0, wfA, urA, biasA);
#pragma unroll 1
        for (int g = 0; g < 8; g += 2) {
            GM_LOAD(g + 1, wfB, urB, biasB);
            GM_COMP(g, wfA, urA, biasA);
            { const int g2 = (g + 2 < 8) ? g + 2 : 0; GM_LOAD(g2, wfA, urA, biasA); }
            GM_COMP(g + 1, wfB, urB, biasB);
        }
#undef GM_LOAD
#undef GM_COMP
    }
    __syncthreads();
}
__device__ __forceinline__ void moe_tables(const int* pcnt, LAS int* MT, LAS int* stage  , int p, int tid, bool first) {
    __syncthreads();
    if (first) { for (int i = tid; i < 4096; i += NWAVES * 64) stage[i] = pcnt[i]; }
    __syncthreads();
    if (tid < 16) { LAS int* M = MT + (tid >> 3) * MT_STRIDE; const int ee = tid & 7; int sacc = 0, pb = 0;
#pragma unroll 16
        for (int q = 0; q < 256; ++q) { if (q == p) pb = sacc; sacc += stage[q * 16 + tid]; }
        M[MT_TOT + ee] = sacc; M[MT_PBASE + ee] = pb; }
    __syncthreads();
    if (first) {
        if (tid == 0 || tid == 64) { LAS int* M = MT + (tid >> 6) * MT_STRIDE; int o = 0;
            for (int e = 0; e < 8; ++e) { M[MT_POFF + e] = o; o += ((M[MT_TOT + e] + 255) >> 8) << 8; }
            M[MT_POFF + 8] = o; M[MT_NT] = o >> 8; }
        __syncthreads();
#pragma unroll
        for (int k = 0; k < 2; ++k) { LAS int* M = MT + k * MT_STRIDE; LAS unsigned char* tile_e = (LAS unsigned char*)(M + MT_TILE); const int nt = M[MT_NT];
            for (int t = tid; t < nt; t += NWAVES * 64) { const int r = t * 256; int e = 0;
#pragma unroll
                for (int ee = 1; ee < 8; ++ee) if (r >= M[MT_POFF + ee]) e = ee;
                tile_e[t] = (unsigned char)e; } }
        __syncthreads();
    }
}
__device__ __forceinline__ void moe_gather2(const bf16* HB, unsigned char* XS, const int* pcnt, const int* tok_e, const int* tok_rank, const float* tok_gate, int* slot_tok, float* slot_gate,
                                            LAS int* MT, LAS unsigned char* lds, int blk, int G) {
    PHASE_IDS();
    LAS int* stage = (LAS int*)(lds + RING_OFF);
    moe_tables(pcnt, MT, stage, blk < T / 256 ? blk : 0, tid, true);
    if (blk == 0) {
        for (int k = 0; k < 2; ++k) { LAS int* M = MT + k * MT_STRIDE;
            for (int e = 0; e < 8; ++e) for (int s = M[MT_POFF + e] + M[MT_TOT + e] + tid; s < M[MT_POFF + e + 1]; s += NWAVES * 64) slot_tok[k * MAXTILES * 256 + s] = -1; }
    }
    for (int p = blk; p < T / 256; p += G) {
        if (p != blk) moe_tables(pcnt, MT, stage, p, tid, false);
        int myslot;
        { const int tj = p * 256 + wave * 32 + (lane >> 1), kj = lane & 1; const LAS int* M = MT + kj * MT_STRIDE;
          const int e = tok_e[tj * 2 + kj]; const int rk = tok_rank[tj * 2 + kj]; const float gt = tok_gate[tj * 2 + kj];
          myslot = kj * MAXTILES * 256 + M[MT_POFF + e] + M[MT_PBASE + e] + rk;
          slot_tok[myslot] = tj; slot_gate[myslot] = gt; }
#pragma unroll
        for (int r0 = 0; r0 < 32; r0 += 16) {
            v4u rowv[16];
#pragma unroll
            for (int q = 0; q < 16; ++q) rowv[q] = ((const GAS v4u*)((const unsigned char*)HB + (size_t)(p * 256 + wave * 32 + r0 + q) * D))[lane];
#pragma unroll
            for (int q = 0; q < 16; ++q) { const int sa = __shfl(myslot, 2 * (r0 + q)), sb = __shfl(myslot, 2 * (r0 + q) + 1);
                ((GAS v4u*)(XS + (size_t)sa * D))[lane] = rowv[q]; ((GAS v4u*)(XS + (size_t)sb * D))[lane] = rowv[q]; }
        }
    }
    __syncthreads();
}

template <bool OUT_F32>
__device__ __forceinline__ void moe_tail_combine(int k, const float* S, const bf16* xb, bf16* xbo, float* xf, const float* gate, const int* slot_tok, const float* slot_gate, LAS int* MT, int nsl, int blk, int G) {
    PHASE_IDS();
    const int ntk = MT[k * MT_STRIDE + MT_NT]; const int nwg = ntk * (D / 256); int full = (nwg / G) * G, ntail = nwg - full;
    if (ntail > 32) { full = nwg; ntail = 0; }
    pg8::StaticOrder SO; SO.init(ntk * 256, D, G, 0);
    const int gw = blk * NWAVES + wave, NGW = G * NWAVES;
    for (int idx = gw; idx < ntail * 256; idx += NGW) { const int q = idx >> 8, r = idx & 255;
        pg8::Unit u; SO.map(full + q, u); const int pmr = k * MAXTILES + u.pm;
        const int slot = pmr * 256 + r; const int tok = slot_tok[slot];
        if (tok < 0) continue;
        const float sg = slot_gate[slot]; const int col = u.pn * 256 + 4 * lane;
        f32x4 a = (f32x4){0.f, 0.f, 0.f, 0.f};
        for (int sl = 0; sl < nsl; ++sl) a += *(const f32x4*)(S + ((size_t)(q * nsl + sl) * 256 + r) * 256 + 4 * lane);
        const f32x4 g4 = *(const f32x4*)(gate + (size_t)(tok >> 11) * ADA + col);
        const v2u xw = *(const GAS v2u*)(xb + (size_t)tok * D + col);
        const f32x4 r4 = (f32x4){bflo(xw.x), bfhi(xw.x), bflo(xw.y), bfhi(xw.y)} + (g4 * sg) * a;
        if (OUT_F32) *(f32x4*)(xf + (size_t)tok * D + col) = r4;
        else { v2u o; o.x = pk2(r4[0], r4[1]); o.y = pk2(r4[2], r4[3]); *(GAS v2u*)(xbo + (size_t)tok * D + col) = o; } }
}

#ifndef SKIPMASK
#define SKIPMASK 0u
#endif
#define PH_ON(x) (((SKIPMASK) & (1u << (x))) == 0u)
#ifndef DBLMASK
#define DBLMASK 0u
#endif
#define PH_REP(x) for (int rep_ = 0; rep_ < ((((DBLMASK) >> (x)) & 1u) ? 2 : 1); ++rep_)
#define GRID_BAR() xcd_barrier(bar)
#define WS_() opaque_ptr(args.ws)
#define WG_SYNC() do { asm volatile("s_waitcnt vmcnt(0) lgkmcnt(0)" ::: "memory"); __syncthreads(); } while (0)
#ifndef PANEL_ORDER
typedef pg8::StaticOrder ChainOrder;
#define CHAIN_SYNC() GRID_BAR()
#else
typedef pg8::PanelOrder ChainOrder;
#define CHAIN_SYNC() WG_SYNC()
#endif
constexpr int MOE_NSL = 7, MOE_KSL = (DE / 2) / MOE_NSL;
__device__ __forceinline__ void moe_tail_split(int ntk, int G, int& full, int& ntail) { const int nwg = ntk * (D / 256); full = (nwg / G) * G; ntail = nwg - full; if (ntail > 32) { full = nwg; ntail = 0; } }
template <int K, int L>
__device__ __forceinline__ void moe_down_main(const Args& args, LAS unsigned char* lds, LAS int* MT, int blk, int G) {
    unsigned char* ws = WS_(); const int ntk = MT[K * MT_STRIDE + MT_NT]; int full, ntail; moe_tail_split(ntk, G, full, ntail);
    pg8::Gemm g{(const bf16*)(ws + WS_ACTM), (const bf16*)(ws + WS_MWD), ntk * 256, D, DE / 2, 0}; pg8::MoeOrder2L S; S.init(ntk * 256, D, G, blk);
    S.tile_e0 = (const LAS unsigned char*)(MT + MT_TILE); S.tile_e1 = (const LAS unsigned char*)(MT + MT_STRIDE + MT_TILE); S.ne_tiles = D / 256; S.nt0 = (K == 0) ? ntk : 0; S.base1 = MAXTILES; S.limit = full;
    pg8::EpiMoeDownB<(K == 1)> E{(const bf16*)(ws + WS_XB), (bf16*)(ws + WS_XB), args.out, (const bf16*)(ws + WS_G16), (const int*)(ws + WS_SLOTT), (const float*)(ws + WS_SLOTG)};
    pg8::gemm_phase<pg8::EpiMoeDownB<(K == 1)>, pg8::MoeOrder2L, true, true>(lds + RING_OFF, g, S, E);
}
template <int K>
__device__ __forceinline__ void moe_down_slices(const Args& args, LAS unsigned char* lds, LAS int* MT, int blk, int G) {
    unsigned char* ws2 = WS_(); const int ntk = MT[K * MT_STRIDE + MT_NT]; int full, ntail; moe_tail_split(ntk, G, full, ntail);
    if (ntail > 0) {
        pg8::Gemm g{(const bf16*)(ws2 + WS_ACTM), (const bf16*)(ws2 + WS_MWD), ntk * 256, D, MOE_KSL, DE / 2}; pg8::MoeTail2 S; S.init(ntk * 256, D, G, blk);
        S.tile_e0 = (const LAS unsigned char*)(MT + MT_TILE); S.tile_e1 = (const LAS unsigned char*)(MT + MT_STRIDE + MT_TILE); S.ne_tiles = D / 256; S.nt0 = (K == 0) ? ntk : 0; S.base1 = MAXTILES;
        S.base = full; S.ntail = ntail; S.nsl = MOE_NSL; S.ksl_bytes = MOE_KSL * 2;
        pg8::EpiTileF32F8 E{(float*)(ws2 + WS_XS) + (size_t)K * 32 * MOE_NSL * 65536};
        pg8::gemm_phase<pg8::EpiTileF32F8, pg8::MoeTail2, true, true>(lds + RING_OFF, g, S, E); }
}
template <int K, int L>
__device__ __forceinline__ void moe_down_combine(const Args& args, LAS int* MT, int blk, int G) {
    unsigned char* ws = WS_();
    moe_tail_combine<(K == 1)>(K, (const float*)(ws + WS_XS) + (size_t)K * 32 * MOE_NSL * 65536, (const bf16*)(ws + WS_XB), (bf16*)(ws + WS_XB), args.out,
                               (const float*)(ws + WS_ADA) + (size_t)L * 32 * ADA + 5 * D, (const int*)(ws + WS_SLOTT), (const float*)(ws + WS_SLOTG), MT, MOE_NSL, blk, G);
}
#define WS_() opaque_ptr(args.ws)
#define WG_SYNC() do { asm volatile("s_waitcnt vmcnt(0) lgkmcnt(0)" ::: "memory"); __syncthreads(); } while (0)
#ifndef PANEL_ORDER
typedef pg8::StaticOrder ChainOrder;
#define CHAIN_SYNC() GRID_BAR()
#else
typedef pg8::PanelOrder ChainOrder;
#define CHAIN_SYNC() WG_SYNC()
#endif
template <int K, int L>
__device__ __forceinline__ void moe_down_half(const Args& args, const XcdBarrier& bar, LAS unsigned char* lds, LAS int* MT, int blk, int G) {
    constexpr int NSL = 7, KSL = (DE / 2) / NSL;
    if (PH_ON(14)) { unsigned char* ws = WS_(); const int ntk = MT[K * MT_STRIDE + MT_NT];
      const int nwg = ntk * (D / 256); int full = (nwg / G) * G, ntail = nwg - full;
      if (ntail > 32) { full = nwg; ntail = 0; }
      { pg8::Gemm g{(const bf16*)(ws + WS_ACTM), (const bf16*)(ws + WS_MWD), ntk * 256, D, DE / 2, 0}; pg8::MoeOrder2L S; S.init(ntk * 256, D, G, blk);
        S.tile_e0 = (const LAS unsigned char*)(MT + MT_TILE); S.tile_e1 = (const LAS unsigned char*)(MT + MT_STRIDE + MT_TILE); S.ne_tiles = D / 256; S.nt0 = (K == 0) ? ntk : 0; S.base1 = MAXTILES; S.limit = full;
        pg8::EpiMoeDownB<(K == 1)> E{(const bf16*)(ws + WS_XB), (bf16*)(ws + WS_XB), args.out, (const bf16*)(ws + WS_G16), (const int*)(ws + WS_SLOTT), (const float*)(ws + WS_SLOTG)};
        pg8::gemm_phase<pg8::EpiMoeDownB<(K == 1)>, pg8::MoeOrder2L, true, true>(lds + RING_OFF, g, S, E); }
      if (ntail > 0) { unsigned char* ws2 = WS_();
        pg8::Gemm g{(const bf16*)(ws2 + WS_ACTM), (const bf16*)(ws2 + WS_MWD), ntk * 256, D, KSL, DE / 2}; pg8::MoeTail2 S; S.init(ntk * 256, D, G, blk);
        S.tile_e0 = (const LAS unsigned char*)(MT + MT_TILE); S.tile_e1 = (const LAS unsigned char*)(MT + MT_STRIDE + MT_TILE); S.ne_tiles = D / 256; S.nt0 = (K == 0) ? ntk : 0; S.base1 = MAXTILES;
        S.base = full; S.ntail = ntail; S.nsl = NSL; S.ksl_bytes = KSL * 2;
        pg8::EpiTileF32F8 E{(float*)(ws2 + WS_XS) + (size_t)K * 32 * NSL * 65536};
        pg8::gemm_phase<pg8::EpiTileF32F8, pg8::MoeTail2, true, true>(lds + RING_OFF, g, S, E); } }
    GRID_BAR();
    if (PH_ON(14)) { unsigned char* ws = WS_();
      moe_tail_combine<(K == 1)>(K, (const float*)(ws + WS_XS) + (size_t)K * 32 * NSL * 65536, (const bf16*)(ws + WS_XB), (bf16*)(ws + WS_XB), args.out,
                                 (const float*)(ws + WS_ADA) + (size_t)L * 32 * ADA + 5 * D, (const int*)(ws + WS_SLOTT), (const float*)(ws + WS_SLOTG), MT, NSL, blk, G); }
}
template <int L>
__device__ __forceinline__ void layer_body(const Args& args, const XcdBarrier& bar, LAS unsigned char* lds, int blk, int G) {
    LAS int* MT = (LAS int*)(lds + MOE_OFF);
    PH_REP(2) if (PH_ON(2)) { unsigned char* ws = WS_();
        if constexpr (L == 0) norm_phase<false>(args.in[0], args.in[4] + L * D, (const float*)(ws + WS_ADA) + (size_t)L * 32 * ADA, 1 * D, 0 * D, (bf16*)(ws + WS_HB),
                          nullptr, nullptr, nullptr, nullptr, nullptr, nullptr, lds, blk, G);
        else norm_phase<false, false, true>((const float*)(ws + WS_XB), args.in[4] + L * D, (const float*)(ws + WS_ADA) + (size_t)L * 32 * ADA, 1 * D, 0 * D, (bf16*)(ws + WS_HB),
                          nullptr, nullptr, nullptr, nullptr, nullptr, nullptr, lds, blk, G); }
    CHAIN_SYNC();
    PH_REP(3) if (PH_ON(3)) { unsigned char* ws = WS_();
      pg8::Gemm g{(const bf16*)(ws + WS_HB), (const bf16*)(ws + WS_WIN) + (size_t)L * NPROJ * D, T, NPROJ, D}; ChainOrder S; S.init(T, NPROJ, G, blk);
      pg8::EpiProjQK E{(bf16*)(ws + WS_BIG), args.in[7] + L * 64, args.in[8] + L * 64, C2, EPS};
      pg8::gemm_phase<pg8::EpiProjQK, ChainOrder, true, true>(lds + RING_OFF, g, S, E); }
    GRID_BAR();
    PH_REP(5) if (PH_ON(5)) { unsigned char* ws = WS_();
        sba::attn_phase((const bf16*)(ws + WS_BIG), (bf16*)(ws + WS_HB), lds, blk, G); }
    PH_REP(6) if (PH_ON(6)) { unsigned char* ws = WS_();
        gmlp_phase((const bf16*)(ws + WS_BIG), (bf16*)(ws + WS_HB), args.in[9] + L * 512, args.in[10] + L * 512, (const bf16*)(ws + WS_GW) + (size_t)L * 8 * 128 * 128, args.in[12] + L * 8 * 128, lds, blk, G); }
    GRID_BAR();
    if (PH_ON(7)) { unsigned char* ws = WS_();
      pg8::Gemm g{(const bf16*)(ws + WS_HB), (const bf16*)(ws + WS_WOUT) + (size_t)L * D * D, T, D, D}; ChainOrder S; S.init(T, D, G, blk);
      if constexpr (L == 0) { pg8::EpiResidB<true, false> E{(const void*)args.in[0], (bf16*)(ws + WS_XB), (const float*)(ws + WS_ADA) + (size_t)L * 32 * ADA + 2 * D};
        pg8::gemm_phase<pg8::EpiResidB<true, false>, ChainOrder, true, true>(lds + RING_OFF, g, S, E); }
      else { pg8::EpiResidB<false, false> E{(const void*)(ws + WS_XB), (bf16*)(ws + WS_XB), (const float*)(ws + WS_ADA) + (size_t)L * 32 * ADA + 2 * D};
        pg8::gemm_phase<pg8::EpiResidB<false, false>, ChainOrder, true, true>(lds + RING_OFF, g, S, E); } }
    CHAIN_SYNC();
    if constexpr (L == 0) {
        if (PH_ON(8)) { unsigned char* ws = WS_();
            norm_phase<false, (FFN_GU_FP8 != 0), true>((const float*)(ws + WS_XB), args.in[5] + L * D, (const float*)(ws + WS_ADA) + (size_t)L * 32 * ADA, 4 * D, 3 * D, (bf16*)(ws + WS_HB),
                              nullptr, nullptr, nullptr, nullptr, nullptr, nullptr, lds, blk, G); }
        CHAIN_SYNC();
        PH_REP(9) if (PH_ON(9)) { unsigned char* ws = WS_();
#if FFN_GU_FP8
          pg8::Gemm g{(const bf16*)(ws + WS_HB), (const bf16*)(ws + WS_WGU), T, 2 * FF, D / 2, 0}; ChainOrder S; S.init(T, 2 * FF, G, blk);
          typedef pg8::EpiSwigluX<true, (FFN_DOWN_FP8 != 0)> EpiGU; EpiGU E{ws + WS_ACT, FF};
          pg8::gemm_phase<EpiGU, ChainOrder, true, true>(lds + RING_OFF, g, S, E); }
#elif FFN_DOWN_FP8
          pg8::Gemm g{(const bf16*)(ws + WS_HB), (const bf16*)(ws + WS_WGU), T, 2 * FF, D}; ChainOrder S; S.init(T, 2 * FF, G, blk);
          pg8::EpiSwigluO8 E{ws + WS_ACT, FF};
          pg8::gemm_phase<pg8::EpiSwigluO8, ChainOrder, true, true>(lds + RING_OFF, g, S, E); }
#else
          pg8::Gemm g{(const bf16*)(ws + WS_HB), (const bf16*)(ws + WS_WGU), T, 2 * FF, D}; ChainOrder S; S.init(T, 2 * FF, G, blk);
          pg8::EpiSwiglu E{(bf16*)(ws + WS_ACT), FF};
          pg8::gemm_phase<pg8::EpiSwiglu, ChainOrder, true, true>(lds + RING_OFF, g, S, E); }
#endif
        CHAIN_SYNC();
        if (PH_ON(10)) { unsigned char* ws = WS_();
#if FFN_DOWN_FP8
          pg8::Gemm g{(const bf16*)(ws + WS_ACT), (const bf16*)(ws + WS_WD), T, D, FF / 2, 0}; ChainOrder S; S.init(T, D, G, blk);
          pg8::EpiResidB<false, true> E{(const void*)(ws + WS_XB), (bf16*)(ws + WS_XB), (const float*)(ws + WS_ADA) + (size_t)L * 32 * ADA + 5 * D};
          pg8::gemm_phase<pg8::EpiResidB<false, true>, ChainOrder, true, true>(lds + RING_OFF, g, S, E); }
#else
          pg8::Gemm g{(const bf16*)(ws + WS_ACT), (const bf16*)(ws + WS_WD), T, D, FF}; ChainOrder S; S.init(T, D, G, blk);
          pg8::EpiResidB<false, false> E{(const void*)(ws + WS_XB), (bf16*)(ws + WS_XB), (const float*)(ws + WS_ADA) + (size_t)L * 32 * ADA + 5 * D};
          pg8::gemm_phase<pg8::EpiResidB<false, false>, ChainOrder, true, true>(lds + RING_OFF, g, S, E); }
#endif
        CHAIN_SYNC();
    } else {
        PH_REP(11) if (PH_ON(11)) { unsigned char* ws = WS_();
            norm_phase<true, true, true>((const float*)(ws + WS_XB), args.in[5] + L * D, (const float*)(ws + WS_ADA) + (size_t)L * 32 * ADA, 4 * D, 3 * D, (bf16*)(ws + WS_HB), args.in[17], args.in[18],
                             (int*)(ws + WS_PCNT), (int*)(ws + WS_TOKE), (int*)(ws + WS_TOKR), (float*)(ws + WS_TOKG), lds, blk, G); }
        GRID_BAR();
        PH_REP(12) if (PH_ON(12)) { unsigned char* ws = WS_();
            moe_gather2((const bf16*)(ws + WS_HB), ws + WS_XS, (const int*)(ws + WS_PCNT), (const int*)(ws + WS_TOKE), (const int*)(ws + WS_TOKR), (const float*)(ws + WS_TOKG),
                        (int*)(ws + WS_SLOTT), (float*)(ws + WS_SLOTG), MT, lds, blk, G); }
        GRID_BAR();
        PH_REP(13) if (PH_ON(13)) { unsigned char* ws = WS_(); const int nt0 = MT[MT_NT], nt1 = MT[MT_STRIDE + MT_NT];
          pg8::Gemm g{(const bf16*)(ws + WS_XS), (const bf16*)(ws + WS_MWGU), (nt0 + nt1) * 256, 2 * DE, D / 2, 0}; pg8::MoeOrder2 S; S.init((nt0 + nt1) * 256, 2 * DE, G, blk);
          S.tile_e0 = (const LAS unsigned char*)(MT + MT_TILE); S.tile_e1 = (const LAS unsigned char*)(MT + MT_STRIDE + MT_TILE); S.ne_tiles = 2 * DE / 256; S.nt0 = nt0; S.base1 = MAXTILES;
          pg8::EpiSwigluF8 E{ws + WS_ACTM, DE};
          pg8::gemm_phase<pg8::EpiSwigluF8, pg8::MoeOrder2, true, true>(lds + RING_OFF, g, S, E); }
        GRID_BAR();
        if (PH_ON(14)) { moe_down_main<0, L>(args, lds, MT, blk, G); moe_down_slices<0>(args, lds, MT, blk, G); moe_down_slices<1>(args, lds, MT, blk, G); }
        GRID_BAR();
        if (PH_ON(14)) moe_down_combine<0, L>(args, MT, blk, G);
        GRID_BAR();
        if (PH_ON(14)) { moe_down_main<1, L>(args, lds, MT, blk, G); moe_down_combine<1, L>(args, MT, blk, G); }
    }
}
__global__ void __launch_bounds__(NWAVES * 64, 2) mk_fwd(const Args args) {
    extern __shared__ __attribute__((aligned(16))) unsigned char lds_raw[];
    LAS unsigned char* lds = (LAS unsigned char*)lds_raw;
    volatile LAS unsigned* MISC = (volatile LAS unsigned*)(lds + MISC_OFF);
    const int G = gridDim.x, blk = blockIdx.x;
    for (int u = threadIdx.x; u < (LDS_BYTES - LDSCTL_OFF) / 4; u += NWAVES * 64) ((LAS unsigned*)(lds + LDSCTL_OFF))[u] = 0u;
    __syncthreads();
    const XcdBarrier bar = xcd_barrier_post((unsigned*)(args.ws + WS_CTL) + CW_BAR, MISC + 8);
    PH_REP(0) if (PH_ON(0)) p0_ada(args, lds, blk, G);
    PH_REP(1) if (PH_ON(1)) p0_transposes(args, lds, blk, G);
    if (PH_ON(1)) p0_spatial(args, blk, G);
    GRID_BAR();
#ifdef PROBE_BARS
    for (int i_ = 0; i_ < PROBE_BARS; ++i_) GRID_BAR();
#endif
    layer_body<0>(args, bar, lds, blk, G);
    layer_body<1>(args, bar, lds, blk, G);
}

extern "C" void kernel_launch(void* const* d_in, const int* in_sizes, int n_in, void* d_out, int out_size, void* d_ws, size_t ws_size, hipStream_t stream) {
    static int grid = 0;
    if (grid == 0) {
        if (n_in != 22 || in_sizes[0] != T * D || out_size != T * D || ws_size < WS_END) {
            fprintf(stderr, "kernel_launch: built for 22 inputs, x/out of %d floats, >= %zu bytes of workspace; got n_in %d, in0 %d, out %d, ws %zu; nothing launched\n", T * D, (size_t)WS_END, n_in, n_in > 0 ? in_sizes[0] : -1, out_size, ws_size);
            grid = -1; return; }
        int dev = 0, cus = 0, per_cu = 0;
        if (hipGetDevice(&dev) != hipSuccess || hipDeviceGetAttribute(&cus, hipDeviceAttributeMultiprocessorCount, dev) != hipSuccess) { fprintf(stderr, "kernel_launch: device query failed\n"); grid = -1; return; }
        if (hipFuncSetAttribute((const void*)mk_fwd, hipFuncAttributeMaxDynamicSharedMemorySize, LDS_BYTES) != hipSuccess) { fprintf(stderr, "kernel_launch: hipFuncSetAttribute failed\n"); grid = -1; return; }
        if (hipOccupancyMaxActiveBlocksPerMultiprocessor(&per_cu, (const void*)mk_fwd, NWAVES * 64, LDS_BYTES) != hipSuccess || per_cu < 1)
            fprintf(stderr, "kernel_launch: note: occupancy query reports %d workgroups per CU\n", per_cu);
        (void)hipGetLastError();
        grid = cus;
    }
    if (grid < 0) return;
    if (hipMemsetAsync((char*)d_ws + WS_CTL, 0, CTL_ZERO_BYTES, stream) != hipSuccess) { fprintf(stderr, "kernel_launch: memset failed\n"); return; }
    Args a{};
    for (int i = 0; i < 22; ++i) a.in[i] = (const float*)d_in[i];
    a.out = (float*)d_out; a.ws = (unsigned char*)d_ws;
    hipLaunchKernelGGL(mk_fwd, dim3(grid), dim3(NWAVES * 64), LDS_BYTES, stream, a);
    const hipError_t le = hipPeekAtLastError();
    if (le != hipSuccess) fprintf(stderr, "kernel_launch: launch failed: %s\n", hipGetErrorName(le));
}
```

```cpp
#ifndef FFN_GU_FP8
#define FFN_GU_FP8 0
#endif
#ifndef FFN_DOWN_FP8
#define FFN_DOWN_FP8 1
#endif
#include <hip/hip_runtime.h>
#include <cstdio>
#include <cstdint>
namespace pg8 {
#define PG8_LAS __attribute__((address_space(3)))
typedef unsigned short bf16_t;
typedef short bf16x8 __attribute__((ext_vector_type(8)));
typedef float f32x4 __attribute__((ext_vector_type(4)));
typedef unsigned u32x4 __attribute__((ext_vector_type(4)));
constexpr int BM = 256, BK = 64, HALF = 128, HTB = HALF * BK * 2  , STAGE_BYTES = 8 * HTB, NXCD = 8, WGM = 8;

__host__ __device__ __forceinline__ int lds_byte(int r, int c) { const int st = (r >> 4) * 2 + (c >> 5), rr = r & 15, cc = c & 31, ob = rr * 64 + cc * 2; return st * 1024 + (ob ^ (((ob >> 9) & 1) << 5)); }
__host__ __device__ __forceinline__ void stage_rc(int b, int& R, int& C) { const int st = b / 1024, sb = b % 1024, swz = sb ^ (((sb >> 9) & 1) << 5); R = (st >> 1) * 16 + swz / 64; C = (st & 1) * 32 + (swz % 64) / 2; }
__host__ __device__ __forceinline__ int perm32(int rho) { const int n = rho >> 4, i = rho & 15; return 8 * (i >> 2) + 4 * n + (i & 3); }

typedef int i32x8 __attribute__((ext_vector_type(8)));
typedef int i32x4 __attribute__((ext_vector_type(4)));
__device__ __forceinline__ i32x8 cat8(bf16x8 lo, bf16x8 hi) { const i32x4 a = __builtin_bit_cast(i32x4, lo), b = __builtin_bit_cast(i32x4, hi); return __builtin_shufflevector(a, b, 0, 1, 2, 3, 4, 5, 6, 7); }
__device__ __forceinline__ void glds16s(const void* sbase, unsigned voff, unsigned lds_dst) { unsigned keep;
    asm volatile("s_mov_b32 %0, m0\n\ts_mov_b32 m0, %3\n\ts_nop 0\n\tglobal_load_lds_dwordx4 %1, %2\n\ts_mov_b32 m0, %0" : "=&s"(keep) : "v"(voff), "s"(sbase), "s"(lds_dst) : "memory"); }
__device__ __forceinline__ void mfma_f8(f32x4& acc, const i32x8 a, const i32x8 b, const int sa, const int sb) {
    asm volatile("v_mfma_scale_f32_16x16x128_f8f6f4 %0, %1, %2, %0, %3, %4 op_sel_hi:[0,0,0]" : "+v"(acc) : "v"(a), "v"(b), "v"(sa), "v"(sb)); }
__device__ __forceinline__ void mfma_f8_z(f32x4& acc, const i32x8 a, const i32x8 b, const int sa, const int sb) {
    asm volatile("v_mfma_scale_f32_16x16x128_f8f6f4 %0, %1, %2, 0, %3, %4 op_sel_hi:[0,0,0]" : "=&v"(acc) : "v"(a), "v"(b), "v"(sa), "v"(sb)); }
__device__ __forceinline__ void mfma_bf16(f32x4& acc, const bf16x8 a, const bf16x8 b) { asm volatile("v_mfma_f32_16x16x32_bf16 %0, %1, %2, %0" : "+v"(acc) : "v"(a), "v"(b)); }
__device__ __forceinline__ void mfma_bf16_z(f32x4& acc, const bf16x8 a, const bf16x8 b) { asm volatile("v_mfma_f32_16x16x32_bf16 %0, %1, %2, 0" : "=&v"(acc) : "v"(a), "v"(b)); }
struct Unit { int pm, pn, bn, skip, kofs; };
struct Gemm { const bf16_t* A; const bf16_t* Bt; int M, N, K, ld; };

struct StaticOrder {
    int nM, nN, nwg, G, c;
    __host__ __device__ void init(int M, int N, int G_, int c_) { nM = M / BM; nN = N / BM; nwg = nM * nN; G = G_; c = c_; }
    __host__ __device__ bool next(int i, Unit& u) const {
        const long L = (long)i * G + c; if (L >= nwg) return false;
        map((int)L, u); return true;
    }
    __host__ __device__ void map(int L, Unit& u) const {
        int wgid = L; { const int q = nwg / NXCD, r = nwg % NXCD, xcd = wgid % NXCD, off = wgid / NXCD; wgid = (xcd < r ? xcd * (q + 1) : r * (q + 1) + (xcd - r) * q) + off; }
        const int nig = WGM * nN, gid = wgid / nig, fm = gid * WGM, gsz = (nM - fm) < WGM ? (nM - fm) : WGM;
        u.pm = fm + ((wgid % nig) % gsz); u.pn = (wgid % nig) / gsz; u.bn = u.pn; u.skip = 0; u.kofs = 0;
    }
    __device__ __forceinline__ void a_ready(const Unit&) const {}
    __device__ __forceinline__ void done(const Unit&) const {}
};

__device__ __forceinline__ unsigned cvt_pk_bf16(float lo, float hi) { unsigned r; asm volatile("v_cvt_pk_bf16_f32 %0, %1, %2" : "=v"(r) : "v"(lo), "v"(hi)); return r; }
typedef float f32x2 __attribute__((ext_vector_type(2)));
__device__ __forceinline__ f32x2 gelu_pk(f32x2 v) {
    const f32x2 av = __builtin_elementwise_abs(v), d = av * 0.2316418882f + 1.0f;
    f32x2 t; t.x = __builtin_amdgcn_rcpf(d.x); t.y = __builtin_amdgcn_rcpf(d.y);
    f32x2 q = t * 0.5307027145f + (-0.7265760135f); q = q * t + 0.7107068705f; q = q * t + (-0.142248368f); q = q * t + 0.127414796f; q = q * t;
    const f32x2 s = (v * v) * (-0.72134752044f);
    f32x2 e; e.x = __builtin_amdgcn_exp2f(s.x); e.y = __builtin_amdgcn_exp2f(s.y);
    const f32x2 m = v * (q * e), r = v - m;
    f32x2 o; o.x = v.x < 0.f ? m.x : r.x; o.y = v.y < 0.f ? m.y : r.y; return o;
}


__device__ __forceinline__ void store_bf16x8(bf16_t* p, const f32x4 v0, const f32x4 v1) {
    u32x4 w; w.x = cvt_pk_bf16(v0[0], v0[1]); w.y = cvt_pk_bf16(v0[2], v0[3]); w.z = cvt_pk_bf16(v1[0], v1[1]); w.w = cvt_pk_bf16(v1[2], v1[3]); *(u32x4*)p = w;
}
__device__ __forceinline__ f32x4 gelu4(const f32x4 v) { const f32x2 a = gelu_pk((f32x2){v[0], v[1]}), b = gelu_pk((f32x2){v[2], v[3]}); return (f32x4){a.x, a.y, b.x, b.y}; }
__device__ __forceinline__ float silu_mul(float g, float u) { return g * u * __builtin_amdgcn_rcpf(1.0f + __builtin_amdgcn_exp2f(-1.4426950408889634f * g)); }
typedef float f32x2 __attribute__((ext_vector_type(2)));
__device__ __forceinline__ f32x4 swiglu4(const f32x4 g, const f32x4 u) {
    const f32x2 ga = {g[0], g[1]}, gb = {g[2], g[3]}, ua = {u[0], u[1]}, ub = {u[2], u[3]};
    const f32x2 ea = {__builtin_amdgcn_exp2f(-ga.x), __builtin_amdgcn_exp2f(-ga.y)}, eb = {__builtin_amdgcn_exp2f(-gb.x), __builtin_amdgcn_exp2f(-gb.y)};
    const f32x2 da = ea + 1.0f, db = eb + 1.0f;
    const f32x2 ra = {__builtin_amdgcn_rcpf(da.x), __builtin_amdgcn_rcpf(da.y)}, rb = {__builtin_amdgcn_rcpf(db.x), __builtin_amdgcn_rcpf(db.y)};
    const f32x2 oa = (ga * ua) * ra, ob = (gb * ub) * rb;
    return (f32x4){oa.x, oa.y, ob.x, ob.y};
}

struct EpiProj {
    static constexpr bool PERM = true, AFTER_DRAIN = false, IDEMP = true; static constexpr int BMODE = 0; static constexpr bool FP8 = false;
    bf16_t* O;
    __device__ __forceinline__ void operator()(const f32x4 (&acc)[2][2][4][2], const Unit& u, int wr, int wc, int fr, int fq) const {
        if (u.skip) return;
        const int row0 = u.pm * BM + wr * 64 + fr, col0 = u.pn * BM + wc * 32 + 8 * fq; const bool act = u.pn >= 6;
#pragma unroll
        for (int ai = 0; ai < 2; ++ai)
#pragma unroll
            for (int m = 0; m < 4; ++m) { bf16_t* rowp = O + (size_t)(row0 + ai * HALF + m * 16) * 2560 + col0;
#pragma unroll
                for (int bj = 0; bj < 2; ++bj) { f32x4 v0 = acc[ai][bj][m][0], v1 = acc[ai][bj][m][1];
                    if (act) { v0 = gelu4(v0); v1 = gelu4(v1); }
                    store_bf16x8(rowp + bj * HALF, v0, v1);
#ifdef DUPSTORE
                    store_bf16x8(rowp + bj * HALF + (size_t)160 * 1024 * 1024, v0, v1);
#endif
                    } }
    }
};
struct EpiProjQK {
    static constexpr bool PERM = true, AFTER_DRAIN = false, IDEMP = true; static constexpr int BMODE = 1; static constexpr bool FP8 = false;
    bf16_t* O; const float* qg; const float* kg; float qscale; float eps;
    __device__ __forceinline__ void operator()(const f32x4 (&acc)[2][2][4][2], const Unit& u, int wr, int wc, int fr, int fq) const {
        const int row0 = u.pm * BM + wr * 64 + fr, col0 = u.pn * BM + wc * 64 + 8 * fq; const int kind = u.pn >> 1;
        if (kind < 2) {
            const float* gp = (kind == 0 ? qg : kg) + 8 * fq; const float gs = (kind == 0) ? qscale : 1.0f;
            f32x4 gv[2][2];
#pragma unroll
            for (int bj = 0; bj < 2; ++bj)
#pragma unroll
                for (int n = 0; n < 2; ++n) gv[bj][n] = *(const f32x4*)(gp + 32 * bj + 4 * n) * gs;
#pragma unroll
            for (int ai = 0; ai < 2; ++ai)
#pragma unroll
                for (int m = 0; m < 4; ++m) { float ss = 0.f;
#pragma unroll
                    for (int bj = 0; bj < 2; ++bj)
#pragma unroll
                        for (int n = 0; n < 2; ++n) { const f32x4 v = acc[ai][bj][m][n]; ss += (v[0] * v[0] + v[1] * v[1]) + (v[2] * v[2] + v[3] * v[3]); }
                    ss += __shfl_xor(ss, 16); ss += __shfl_xor(ss, 32);
                    const float rs = __builtin_amdgcn_rsqf(ss * (1.0f / 64.0f) + eps);
                    bf16_t* rowp = O + (size_t)(row0 + ai * HALF + m * 16) * 2560 + col0;
#pragma unroll
                    for (int bj = 0; bj < 2; ++bj) store_bf16x8(rowp + 32 * bj, acc[ai][bj][m][0] * rs * gv[bj][0], acc[ai][bj][m][1] * rs * gv[bj][1]); }
        } else {
#ifdef GELU_IN_PROJ
            const bool act = kind >= 3;
#else
            constexpr bool act = false;
#endif
#pragma unroll
            for (int ai = 0; ai < 2; ++ai)
#pragma unroll
                for (int m = 0; m < 4; ++m) { bf16_t* rowp = O + (size_t)(row0 + ai * HALF + m * 16) * 2560 + col0;
#pragma unroll
                    for (int bj = 0; bj < 2; ++bj) { f32x4 v0 = acc[ai][bj][m][0], v1 = acc[ai][bj][m][1];
                        if (act) { v0 = gelu4(v0); v1 = gelu4(v1); }
                        store_bf16x8(rowp + 32 * bj, v0, v1); } }
        }
    }
};
struct EpiResid {
    static constexpr bool PERM = false, AFTER_DRAIN = false, IDEMP = false; static constexpr int BMODE = 0; static constexpr bool FP8 = false;
    const float* xin; float* xout; const float* gate;
    __device__ __forceinline__ void operator()(const f32x4 (&acc)[2][2][4][2], const Unit& u, int wr, int wc, int fr, int fq) const {
        const int row0 = u.pm * BM + wr * 64 + fr, col0 = u.pn * BM + wc * 32 + 4 * fq;
        const float* gp = gate + (size_t)(u.pm >> 3) * 6144 + col0;
        f32x4 gv[2][2];
#pragma unroll
        for (int bj = 0; bj < 2; ++bj)
#pragma unroll
            for (int n = 0; n < 2; ++n) gv[bj][n] = *(const f32x4*)(gp + bj * HALF + n * 16);
#pragma unroll
        for (int ai = 0; ai < 2; ++ai) {
            f32x4 xi[4][2][2];
#pragma unroll
            for (int m = 0; m < 4; ++m) { const size_t off = (size_t)(row0 + ai * HALF + m * 16) * 1024 + col0;
#pragma unroll
                for (int bj = 0; bj < 2; ++bj)
#pragma unroll
                    for (int n = 0; n < 2; ++n) xi[m][bj][n] = *(const f32x4*)(xin + off + bj * HALF + n * 16); }
            asm volatile("" ::: "memory");
#pragma unroll
            for (int m = 0; m < 4; ++m) { const size_t off = (size_t)(row0 + ai * HALF + m * 16) * 1024 + col0;
#pragma unroll
                for (int bj = 0; bj < 2; ++bj)
#pragma unroll
                    for (int n = 0; n < 2; ++n) *(f32x4*)(xout + off + bj * HALF + n * 16) = xi[m][bj][n] + gv[bj][n] * acc[ai][bj][m][n]; }
            asm volatile("" ::: "memory");
        }
    }
};
struct EpiSwiglu {
    static constexpr bool PERM = true, AFTER_DRAIN = false, IDEMP = true; static constexpr int BMODE = 0; static constexpr bool FP8 = false;
    bf16_t* O; int ldc;
    __device__ __forceinline__ void operator()(const f32x4 (&acc)[2][2][4][2], const Unit& u, int wr, int wc, int fr, int fq) const {
        const int row0 = u.pm * BM + wr * 64 + fr, col0 = u.pn * HALF + wc * 32 + 8 * fq;
#pragma unroll
        for (int ai = 0; ai < 2; ++ai)
#pragma unroll
            for (int m = 0; m < 4; ++m) { bf16_t* rowp = O + (size_t)(row0 + ai * HALF + m * 16) * ldc + col0;
                const f32x4 g0 = acc[ai][0][m][0], g1 = acc[ai][0][m][1], u0 = acc[ai][1][m][0], u1 = acc[ai][1][m][1];
                const f32x4 r0 = swiglu4(g0, u0), r1 = swiglu4(g1, u1);
                store_bf16x8(rowp, r0, r1); }
    }
};
__device__ __forceinline__ unsigned pk4_fp8(const f32x4 v) {
    int p = 0;
    p = __builtin_amdgcn_cvt_pk_fp8_f32(__builtin_amdgcn_fmed3f(v[0], -448.f, 448.f), __builtin_amdgcn_fmed3f(v[1], -448.f, 448.f), p, false);
    p = __builtin_amdgcn_cvt_pk_fp8_f32(__builtin_amdgcn_fmed3f(v[2], -448.f, 448.f), __builtin_amdgcn_fmed3f(v[3], -448.f, 448.f), p, true);
    return (unsigned)p;
}
struct EpiSwigluF8 {
    static constexpr bool PERM = true, AFTER_DRAIN = false, IDEMP = true; static constexpr int BMODE = 0; static constexpr bool FP8 = true;
    unsigned char* O; int ldc;
    __device__ __forceinline__ void operator()(const f32x4 (&acc)[2][2][4][2], const Unit& u, int wr, int wc, int fr, int fq) const {
        const int row0 = u.pm * BM + wr * 64 + fr, col0 = u.pn * HALF + wc * 32 + 8 * fq;
#pragma unroll
        for (int ai = 0; ai < 2; ++ai)
#pragma unroll
            for (int m = 0; m < 4; ++m) { unsigned char* rowp = O + (size_t)(row0 + ai * HALF + m * 16) * ldc + col0;
                const f32x4 g0 = acc[ai][0][m][0], g1 = acc[ai][0][m][1], u0 = acc[ai][1][m][0], u1 = acc[ai][1][m][1];
                const f32x4 r0 = swiglu4(g0, u0), r1 = swiglu4(g1, u1);
                typedef unsigned u32x2 __attribute__((ext_vector_type(2)));
                u32x2 w; w.x = pk4_fp8(r0); w.y = pk4_fp8(r1); *(u32x2*)rowp = w; }
    }
};
template <bool KF8, bool OF8>
struct EpiSwigluX {
    static constexpr bool PERM = true, AFTER_DRAIN = false, IDEMP = true; static constexpr int BMODE = 0; static constexpr bool FP8 = KF8;
    unsigned char* O; int ldc;
    __device__ __forceinline__ void operator()(const f32x4 (&acc)[2][2][4][2], const Unit& u, int wr, int wc, int fr, int fq) const {
        const int row0 = u.pm * BM + wr * 64 + fr, col0 = u.pn * HALF + wc * 32 + 8 * fq;
#pragma unroll
        for (int ai = 0; ai < 2; ++ai)
#pragma unroll
            for (int m = 0; m < 4; ++m) { unsigned char* rowp = O + ((size_t)(row0 + ai * HALF + m * 16) * ldc + col0) * (OF8 ? 1 : 2);
                const f32x4 r0 = swiglu4(acc[ai][0][m][0], acc[ai][1][m][0]), r1 = swiglu4(acc[ai][0][m][1], acc[ai][1][m][1]);
                if constexpr (OF8) { typedef unsigned u32x2 __attribute__((ext_vector_type(2))); u32x2 w; w.x = pk4_fp8(r0); w.y = pk4_fp8(r1); *(u32x2*)rowp = w; }
                else store_bf16x8((bf16_t*)rowp, r0, r1); }
    }
};
struct EpiSwigluO8 {
    static constexpr bool PERM = true, AFTER_DRAIN = false, IDEMP = true; static constexpr int BMODE = 0; static constexpr bool FP8 = false;
    unsigned char* O; int ldc;
    __device__ __forceinline__ void operator()(const f32x4 (&acc)[2][2][4][2], const Unit& u, int wr, int wc, int fr, int fq) const {
        const int row0 = u.pm * BM + wr * 64 + fr, col0 = u.pn * HALF + wc * 32 + 8 * fq;
#pragma unroll
        for (int ai = 0; ai < 2; ++ai)
#pragma unroll
            for (int m = 0; m < 4; ++m) { unsigned char* rowp = O + (size_t)(row0 + ai * HALF + m * 16) * ldc + col0;
                const f32x4 r0 = swiglu4(acc[ai][0][m][0], acc[ai][1][m][0]), r1 = swiglu4(acc[ai][0][m][1], acc[ai][1][m][1]);
                typedef unsigned u32x2 __attribute__((ext_vector_type(2)));
                u32x2 w; w.x = pk4_fp8(r0); w.y = pk4_fp8(r1); *(u32x2*)rowp = w; }
    }
};
struct EpiMoeDown {
    static constexpr bool PERM = false, AFTER_DRAIN = false, IDEMP = false; static constexpr int BMODE = 0; static constexpr bool FP8 = false;
    float* x; const float* gate; const int* slot_tok; const float* slot_gate;
    __device__ __forceinline__ void operator()(const f32x4 (&acc)[2][2][4][2], const Unit& u, int wr, int wc, int fr, int fq) const {
        const int slot0 = u.pm * BM + wr * 64 + fr, col0 = u.pn * BM + wc * 32 + 4 * fq;
        int tok[2][4]; float sg[2][4];
#pragma unroll
        for (int ai = 0; ai < 2; ++ai)
#pragma unroll
            for (int m = 0; m < 4; ++m) { const int slot = slot0 + ai * HALF + m * 16; tok[ai][m] = slot_tok[slot]; sg[ai][m] = slot_gate[slot]; }
#pragma unroll
        for (int ai = 0; ai < 2; ++ai)
#pragma unroll
            for (int mp = 0; mp < 2; ++mp) {
                f32x4 gvv[2][2][2], xi[2][2][2];
#pragma unroll
                for (int q = 0; q < 2; ++q) { const int t = tok[ai][2 * mp + q], te = t < 0 ? 0 : t;
                    const float* gp = gate + (size_t)(te >> 11) * 6144 + col0; const float* xp = x + (size_t)te * 1024 + col0;
#pragma unroll
                    for (int bj = 0; bj < 2; ++bj)
#pragma unroll
                        for (int n = 0; n < 2; ++n) { gvv[q][bj][n] = *(const f32x4*)(gp + bj * HALF + n * 16); xi[q][bj][n] = *(const f32x4*)(xp + bj * HALF + n * 16); } }
                asm volatile("" ::: "memory");
#pragma unroll
                for (int q = 0; q < 2; ++q) { const int m = 2 * mp + q; const int t = tok[ai][m];
                    if (t >= 0) { float* xp = x + (size_t)t * 1024 + col0; const float g1 = sg[ai][m];
#pragma unroll
                        for (int bj = 0; bj < 2; ++bj)
#pragma unroll
                            for (int n = 0; n < 2; ++n) *(f32x4*)(xp + bj * HALF + n * 16) = xi[q][bj][n] + (gvv[q][bj][n] * g1) * acc[ai][bj][m][n]; } }
                asm volatile("" ::: "memory");
            }
    }
};
struct EpiMoeDownF8 : EpiMoeDown { static constexpr bool FP8 = true; };
struct EpiResidF8 : EpiResid { static constexpr bool FP8 = true; };
__device__ __forceinline__ void unpack_bf16x8(const u32x4 w, f32x4& a, f32x4& b) {
    a = (f32x4){__builtin_bit_cast(float, w.x << 16), __builtin_bit_cast(float, w.x & 0xffff0000u), __builtin_bit_cast(float, w.y << 16), __builtin_bit_cast(float, w.y & 0xffff0000u)};
    b = (f32x4){__builtin_bit_cast(float, w.z << 16), __builtin_bit_cast(float, w.z & 0xffff0000u), __builtin_bit_cast(float, w.w << 16), __builtin_bit_cast(float, w.w & 0xffff0000u)}; }
template <bool IN_F32, bool F8>
struct EpiResidB {
    static constexpr bool PERM = true, AFTER_DRAIN = false, IDEMP = false; static constexpr int BMODE = 0; static constexpr bool FP8 = F8;
    const void* xin; bf16_t* xout; const float* gate;
    __device__ __forceinline__ void operator()(const f32x4 (&acc)[2][2][4][2], const Unit& u, int wr, int wc, int fr, int fq) const {
        const int row0 = u.pm * BM + wr * 64 + fr, col0 = u.pn * BM + wc * 32 + 8 * fq;
        const float* gp = gate + (size_t)(u.pm >> 3) * 6144 + col0;
        f32x4 gv[2][2];
#pragma unroll
        for (int bj = 0; bj < 2; ++bj)
#pragma unroll
            for (int n = 0; n < 2; ++n) gv[bj][n] = *(const f32x4*)(gp + bj * HALF + n * 4);
        const unsigned e0 = (unsigned)row0 * 1024u + (unsigned)col0;
        if constexpr (!IN_F32) {
            u32x4 xw[2][4][2];
#define RB_EO(ai, m, bj) (e0 + (unsigned)(((ai) * HALF + (m) * 16) * 1024 + (bj) * HALF))
#define RB_LD(ai, m, bj) xw[ai][m][bj] = *(const u32x4*)((const char*)xin + (size_t)(RB_EO(ai, m, bj) * 2u))
#define RB_ST(ai, m, bj) do { f32x4 xa_, xc_; unpack_bf16x8(xw[ai][m][bj], xa_, xc_); \
                store_bf16x8((bf16_t*)((char*)xout + (size_t)(RB_EO(ai, m, bj) * 2u)), xa_ + gv[bj][0] * acc[ai][bj][m][0], xc_ + gv[bj][1] * acc[ai][bj][m][1]); } while (0)
#pragma unroll
            for (int m = 0; m < 4; ++m) { RB_LD(0, m, 0); RB_LD(0, m, 1); }
#pragma unroll
            for (int m = 0; m < 2; ++m) { RB_LD(1, m, 0); RB_LD(1, m, 1); }
            asm volatile("" ::: "memory");
#pragma unroll
            for (int m = 0; m < 2; ++m) { RB_ST(0, m, 0); RB_ST(0, m, 1); }
            asm volatile("" ::: "memory");
#pragma unroll
            for (int m = 2; m < 4; ++m) { RB_LD(1, m, 0); RB_LD(1, m, 1); }
            asm volatile("" ::: "memory");
#pragma unroll
            for (int m = 2; m < 4; ++m) { RB_ST(0, m, 0); RB_ST(0, m, 1); }
#pragma unroll
            for (int m = 0; m < 4; ++m) { RB_ST(1, m, 0); RB_ST(1, m, 1); }
            asm volatile("" ::: "memory");
#undef RB_EO
#undef RB_LD
#undef RB_ST
            return;
        }
#pragma unroll
        for (int ai = 0; ai < 2; ++ai) {
            f32x4 xa[4][2], xb2[4][2];
#pragma unroll
            for (int m = 0; m < 4; ++m)
#pragma unroll
                for (int bj = 0; bj < 2; ++bj) { const unsigned eo = e0 + (unsigned)((ai * HALF + m * 16) * 1024 + bj * HALF);
                    if (IN_F32) { xa[m][bj] = *(const f32x4*)((const char*)xin + (size_t)(eo * 4u)); xb2[m][bj] = *(const f32x4*)((const char*)xin + (size_t)(eo * 4u) + 16); }
                    else unpack_bf16x8(*(const u32x4*)((const char*)xin + (size_t)(eo * 2u)), xa[m][bj], xb2[m][bj]); }
            asm volatile("" ::: "memory");
#pragma unroll
            for (int m = 0; m < 4; ++m)
#pragma unroll
                for (int bj = 0; bj < 2; ++bj) { const unsigned eo = e0 + (unsigned)((ai * HALF + m * 16) * 1024 + bj * HALF);
                    store_bf16x8((bf16_t*)((char*)xout + (size_t)(eo * 2u)), xa[m][bj] + gv[bj][0] * acc[ai][bj][m][0], xb2[m][bj] + gv[bj][1] * acc[ai][bj][m][1]); }
            asm volatile("" ::: "memory");
        }
    }
};
template <bool OUT_F32>
struct EpiMoeDownB {
    static constexpr bool PERM = true, AFTER_DRAIN = false, IDEMP = false; static constexpr int BMODE = 0; static constexpr bool FP8 = true;
    const bf16_t* xb; bf16_t* xbo; float* xf; const bf16_t* gate16; const int* slot_tok; const float* slot_gate;
    __device__ __forceinline__ void operator()(const f32x4 (&acc)[2][2][4][2], const Unit& u, int wr, int wc, int fr, int fq) const {
        const int slot0 = u.pm * BM + wr * 64 + fr, col0 = u.pn * BM + wc * 32 + 8 * fq;
        int tok[2][4]; float sg[2][4];
#pragma unroll
        for (int ai = 0; ai < 2; ++ai)
#pragma unroll
            for (int m = 0; m < 4; ++m) { const int slot = slot0 + ai * HALF + m * 16; tok[ai][m] = slot_tok[slot]; sg[ai][m] = slot_gate[slot]; }
#pragma unroll
        for (int ai = 0; ai < 2; ++ai) {
            u32x4 gw[4][2], xw[4][2];
#pragma unroll
            for (int q = 0; q < 4; ++q) { const int t = tok[ai][q], te = t < 0 ? 0 : t;
                const bf16_t* gp = gate16 + (size_t)(te >> 11) * 1024 + col0; const bf16_t* xp = xb + (size_t)te * 1024 + col0;
#pragma unroll
                for (int bj = 0; bj < 2; ++bj) { gw[q][bj] = *(const u32x4*)(gp + bj * HALF); xw[q][bj] = *(const u32x4*)(xp + bj * HALF); } }
            asm volatile("" ::: "memory");
#pragma unroll
            for (int q = 0; q < 4; ++q) { const int t = tok[ai][q];
                if (t >= 0) { const float g1 = sg[ai][q];
#pragma unroll
                    for (int bj = 0; bj < 2; ++bj) { f32x4 ga, gc, xa, xc; unpack_bf16x8(gw[q][bj], ga, gc); unpack_bf16x8(xw[q][bj], xa, xc);
                        const f32x4 r0 = xa + (ga * g1) * acc[ai][bj][q][0], r1 = xc + (gc * g1) * acc[ai][bj][q][1];
                        if (OUT_F32) { float* op = xf + (size_t)t * 1024 + col0 + bj * HALF; *(f32x4*)op = r0; *(f32x4*)(op + 4) = r1; }
                        else store_bf16x8(xbo + (size_t)t * 1024 + col0 + bj * HALF, r0, r1); } } }
            asm volatile("" ::: "memory");
        }
    }
};
struct DupOrder : StaticOrder {
    __device__ __forceinline__ bool next(int i, Unit& u) const { if (!StaticOrder::next(i >> 1, u)) return false; u.skip = i & 1; return true; }
};
struct PanelOrder {
    int nM, nN, G, c;
    __device__ __forceinline__ void init(int M, int N, int G_, int c_) { nM = M / BM; nN = N / BM; G = G_; c = c_; }
    __device__ __forceinline__ bool next(int i, Unit& u) const { const int pi = i / nN; u.pm = c + pi * G; if (u.pm >= nM) return false; u.pn = i - pi * nN; u.bn = u.pn; u.skip = 0; u.kofs = 0; return true; }
    __device__ __forceinline__ void a_ready(const Unit&) const {}
    __device__ __forceinline__ void done(const Unit&) const {}
};
struct MoeOrder : StaticOrder {
    const PG8_LAS unsigned char* tile_e; int ne_tiles; int limit;
    __device__ __forceinline__ bool next(int i, Unit& u) const { const long L = (long)i * G + c; if (L >= limit) return false; map((int)L, u); u.bn = (int)tile_e[u.pm] * ne_tiles + u.pn; return true; }
};
struct MoeOrder2 : StaticOrder {
    const PG8_LAS unsigned char* tile_e0; const PG8_LAS unsigned char* tile_e1; int ne_tiles, nt0, base1;
    __device__ __forceinline__ bool next(int i, Unit& u) const { const long L = (long)i * G + c; if (L >= nwg) return false; map((int)L, u);
        int e; if (u.pm < nt0) e = tile_e0[u.pm]; else { const int pl = u.pm - nt0; e = tile_e1[pl]; u.pm = base1 + pl; }
        u.bn = e * ne_tiles + u.pn; return true; }
};
struct MoeOrder2L : MoeOrder2 { int limit;
    __device__ __forceinline__ bool next(int i, Unit& u) const { const long L = (long)i * G + c; if (L >= limit) return false; map((int)L, u);
        int e; if (u.pm < nt0) e = tile_e0[u.pm]; else { const int pl = u.pm - nt0; e = tile_e1[pl]; u.pm = base1 + pl; }
        u.bn = e * ne_tiles + u.pn; return true; } };
struct MoeTail2 : MoeOrder2 { int base, ntail, nsl, ksl_bytes;
    __device__ __forceinline__ bool next(int i, Unit& u) const { const int j = i * G + c; if (j >= ntail * nsl) return false; const int q = j / nsl; map(base + q, u);
        int e; if (u.pm < nt0) e = tile_e0[u.pm]; else { const int pl = u.pm - nt0; e = tile_e1[pl]; u.pm = base1 + pl; }
        u.bn = e * ne_tiles + u.pn; u.kofs = (j - q * nsl) * ksl_bytes; u.skip = j; return true; } };
struct EpiTileF32F8 {
    static constexpr bool PERM = false, AFTER_DRAIN = false, IDEMP = true; static constexpr int BMODE = 0; static constexpr bool FP8 = true;
    float* S;
    __device__ __forceinline__ void operator()(const f32x4 (&acc)[2][2][4][2], const Unit& u, int wr, int wc, int fr, int fq) const {
        float* base = S + (size_t)u.skip * 65536 + (size_t)(wr * 64 + fr) * 256 + wc * 32 + 4 * fq;
#pragma unroll
        for (int ai = 0; ai < 2; ++ai)
#pragma unroll
            for (int m = 0; m < 4; ++m)
#pragma unroll
                for (int bj = 0; bj < 2; ++bj)
#pragma unroll
                    for (int n = 0; n < 2; ++n) *(f32x4*)(base + (size_t)(ai * HALF + m * 16) * 256 + bj * HALF + n * 16) = acc[ai][bj][m][n];
    }
};
struct MoeTailOrder : StaticOrder {
    const PG8_LAS unsigned char* tile_e; int ne_tiles; int base, ntail, nsl, ksl_bytes;
    __device__ __forceinline__ bool next(int i, Unit& u) const { const int j = i * G + c; if (j >= ntail * nsl) return false; const int q = j / nsl; map(base + q, u);
        u.bn = (int)tile_e[u.pm] * ne_tiles + u.pn; u.kofs = (j - q * nsl) * ksl_bytes; return true; }
};
struct EpiMoeDownAtomic {
    static constexpr bool PERM = false, AFTER_DRAIN = false, IDEMP = false; static constexpr int BMODE = 0; static constexpr bool FP8 = false;
    float* x; const float* gate; const int* slot_tok; const float* slot_gate;
    __device__ __forceinline__ void operator()(const f32x4 (&acc)[2][2][4][2], const Unit& u, int wr, int wc, int fr, int fq) const {
        const int slot0 = u.pm * BM + wr * 64 + fr, col0 = u.pn * BM + wc * 32 + 4 * fq;
#pragma unroll
        for (int ai = 0; ai < 2; ++ai)
#pragma unroll
            for (int m = 0; m < 4; ++m) { const int slot = slot0 + ai * HALF + m * 16; const int tok = slot_tok[slot];
                if (tok >= 0) { const float sg = slot_gate[slot]; const float* gp = gate + (size_t)(tok >> 11) * 6144 + col0; float* xp = x + (size_t)tok * 1024 + col0;
#pragma unroll
                    for (int bj = 0; bj < 2; ++bj)
#pragma unroll
                        for (int n = 0; n < 2; ++n) { const f32x4 v = (*(const f32x4*)(gp + bj * HALF + n * 16) * sg) * acc[ai][bj][m][n];
#pragma unroll
                            for (int e = 0; e < 4; ++e) unsafeAtomicAdd(xp + bj * HALF + n * 16 + e, v[e]); } } }
    }
};

#ifndef EPI_TWICE
#define EPI_TWICE false
#endif
template <class Epi, class Sched, bool ALIGN_EPI = false, bool SP2 = false>
__device__ __forceinline__ void gemm_phase(PG8_LAS unsigned char* lds, const Gemm g, const Sched& S, const Epi& E) {
    int tid_o = threadIdx.x; asm volatile("" : "+v"(tid_o));
    const int tid = tid_o, wid = __builtin_amdgcn_readfirstlane(tid >> 6), lane = tid & 63, wr = wid >> 2, wc = wid & 3, fr = lane & 15, fq = lane >> 4;
    const int nt = g.K / BK, K = g.ld ? g.ld : g.K;
    unsigned voffA[2], voffB[2];
#pragma unroll
    for (int i = 0; i < 2; ++i) { int R, C; stage_rc(tid * 16 + i * 8192, R, C); const int Rb = (Epi::BMODE == 1) ? (64 * (R >> 5) + perm32(R & 31)) : (Epi::PERM ? ((R & ~31) + perm32(R & 31)) : R);
        voffA[i] = (unsigned)(R * K + C) * 2u; voffB[i] = (unsigned)(Rb * K + C) * 2u; }
    const size_t kstep = (size_t)(BK * 2);
    const size_t hstep = (size_t)HALF * K * 2;
    const size_t hstepB = (Epi::BMODE == 1) ? (size_t)32 * K * 2 : hstep;
    const size_t tstep = 2 * hstep;
    const unsigned lds0 = (unsigned)(uintptr_t)lds;
    const unsigned ldsw = (unsigned)wid * 1024u;
    const int aoff = lds_byte(wr * 64 + fr, fq * 8), boff = lds_byte(wc * 32 + fr, fq * 8);
#define PG8_SA(b, h) (((b) * 2 + (h)) * HTB)
#define PG8_SB(b, h) ((4 + (b) * 2 + (h)) * HTB)
#ifndef PG8_ASM_STAGE
#define PG8_ASM_STAGE 1
#endif
#if PG8_ASM_STAGE
#define PG8_STAGE(bufoff, gbase, voff) do { _Pragma("unroll") for (int _i = 0; _i < 2; ++_i) glds16s((const void*)(gbase), (voff)[_i], (unsigned)__builtin_amdgcn_readfirstlane((int)(lds0 + (unsigned)(bufoff) + ldsw + (unsigned)_i * 8192u))); } while (0)
#else
#define PG8_STAGE(bufoff, gbase, voff) do { _Pragma("unroll") for (int _i = 0; _i < 2; ++_i) \
        __builtin_amdgcn_global_load_lds((const unsigned*)((const char*)(gbase) + (voff)[_i]), (PG8_LAS unsigned*)(lds + (bufoff) + ldsw + _i * 8192), 16, 0, 0); } while (0)
#endif
#define PG8_LDA(dst, b, h) do { _Pragma("unroll") for (int m = 0; m < 4; ++m) _Pragma("unroll") for (int k = 0; k < 2; ++k) dst[m][k] = *(const PG8_LAS bf16x8*)(lds + PG8_SA(b, h) + aoff + m * 2048 + k * 1024); } while (0)
#define PG8_LDB(dst, b, h) do { _Pragma("unroll") for (int n = 0; n < 2; ++n) _Pragma("unroll") for (int k = 0; k < 2; ++k) dst[n][k] = *(const PG8_LAS bf16x8*)(lds + PG8_SB(b, h) + boff + n * 2048 + k * 1024); } while (0)
#define PG8_MMA(ai, bj, At, Bt) do { __builtin_amdgcn_s_setprio(1); _Pragma("unroll") for (int m = 0; m < 4; ++m) _Pragma("unroll") for (int n = 0; n < 2; ++n) { \
        if constexpr (Epi::FP8) mfma_f8(acc[ai][bj][m][n], cat8(Bt[n][0], Bt[n][1]), cat8(At[m][0], At[m][1]), 0x7a7a7a7a, 0x7f7f7f7f); \
        else { _Pragma("unroll") for (int k = 0; k < 2; ++k) acc[ai][bj][m][n] = __builtin_amdgcn_mfma_f32_16x16x32_bf16(Bt[n][k], At[m][k], acc[ai][bj][m][n], 0, 0, 0); } } \
        __builtin_amdgcn_s_setprio(0); } while (0)
#define PG8_MMA0(ai, bj, At, Bt) do { __builtin_amdgcn_s_setprio(1); _Pragma("unroll") for (int m = 0; m < 4; ++m) _Pragma("unroll") for (int n = 0; n < 2; ++n) \
        mfma_f8_z(acc[ai][bj][m][n], cat8(Bt[n][0], Bt[n][1]), cat8(At[m][0], At[m][1]), 0x7a7a7a7a, 0x7f7f7f7f); \
        __builtin_amdgcn_s_setprio(0); } while (0)
#define PG8_WAIT_V(n) asm volatile("s_waitcnt vmcnt(" #n ")" ::: "memory")
#define PG8_WAIT_L(n) asm volatile("s_waitcnt lgkmcnt(" #n ")" ::: "memory")
#define PG8_BAR __builtin_amdgcn_s_barrier()
#define PG8_SCHED __builtin_amdgcn_sched_barrier(0)
    Unit cur, nxt; int ui = 0;
    if (!S.next(0, cur)) return;
    f32x4 acc[2][2][4][2];
    if constexpr (!(SP2 && Epi::FP8))
#pragma unroll
    for (int a = 0; a < 2; ++a)
#pragma unroll
        for (int b = 0; b < 2; ++b)
#pragma unroll
            for (int m = 0; m < 4; ++m)
#pragma unroll
                for (int n = 0; n < 2; ++n) acc[a][b][m][n] = (f32x4){0.f, 0.f, 0.f, 0.f};
    bf16x8 At[4][2], B0[2][2], B1[2][2];
    const char* cA = (const char*)g.A + (size_t)cur.pm * tstep + cur.kofs; const char* cB = (const char*)g.Bt + (size_t)cur.bn * tstep + cur.kofs;
    S.a_ready(cur);
    if constexpr (SP2) {
        PG8_STAGE(PG8_SB(0, 0), cB, voffB); PG8_STAGE(PG8_SB(0, 1), cB + hstepB, voffB); PG8_STAGE(PG8_SA(0, 0), cA, voffA); PG8_STAGE(PG8_SA(0, 1), cA + hstep, voffA);
        if (wr == 1) PG8_BAR;
        PG8_WAIT_V(2); PG8_BAR;
        PG8_STAGE(PG8_SB(1, 0), cB + kstep, voffB); PG8_STAGE(PG8_SA(1, 0), cA + kstep, voffA); PG8_STAGE(PG8_SB(1, 1), cB + hstepB + kstep, voffB);
        PG8_WAIT_V(6); PG8_BAR;
    } else {
        PG8_STAGE(PG8_SB(0, 0), cB, voffB); PG8_STAGE(PG8_SA(0, 0), cA, voffA); PG8_STAGE(PG8_SB(0, 1), cB + hstepB, voffB); PG8_STAGE(PG8_SA(0, 1), cA + hstep, voffA);
        if (wr == 1) PG8_BAR;
        PG8_WAIT_V(4); PG8_BAR;
        PG8_STAGE(PG8_SB(1, 0), cB + kstep, voffB); PG8_STAGE(PG8_SA(1, 0), cA + kstep, voffA); PG8_STAGE(PG8_SB(1, 1), cB + hstepB + kstep, voffB);
        PG8_WAIT_V(6); PG8_BAR;
    }
    for (;;) {
        const bool has_next = S.next(ui + 1, nxt);
        const char* nA = has_next ? (const char*)g.A + (size_t)nxt.pm * tstep + nxt.kofs : cA; const char* nB = has_next ? (const char*)g.Bt + (size_t)nxt.bn * tstep + nxt.kofs : cB;
#pragma unroll 1
        for (int t = 0; t < nt; t += 2) {
            const bool last = (t == nt - 2);
            const char* a1 = cA + (size_t)(t + 1) * kstep;
            const char* a2 = last ? nA : cA + (size_t)(t + 2) * kstep; const char* b2 = last ? nB : cB + (size_t)(t + 2) * kstep;
            const char* a3 = a2 + kstep; const char* b3 = b2 + kstep;
            if (last && has_next) S.a_ready(nxt);
            if constexpr (SP2) {
            PG8_LDB(B0, 0, 0); PG8_LDB(B1, 0, 1); PG8_SCHED; PG8_LDA(At, 0, 0); PG8_STAGE(PG8_SA(1, 1), a1 + hstep, voffA);
            PG8_WAIT_V(8); PG8_WAIT_L(0); PG8_BAR; if (Epi::FP8 && t == 0) { PG8_MMA0(0, 0, At, B0); PG8_MMA0(0, 1, At, B1); } else { PG8_MMA(0, 0, At, B0); PG8_MMA(0, 1, At, B1); } PG8_BAR; PG8_SCHED;
            PG8_LDA(At, 0, 1); PG8_STAGE(PG8_SB(0, 0), b2, voffB); PG8_STAGE(PG8_SB(0, 1), b2 + hstepB, voffB); PG8_STAGE(PG8_SA(0, 0), a2, voffA);
            PG8_WAIT_V(8); PG8_WAIT_L(0); PG8_BAR; if (Epi::FP8 && t == 0) { PG8_MMA0(1, 0, At, B0); PG8_MMA0(1, 1, At, B1); } else { PG8_MMA(1, 0, At, B0); PG8_MMA(1, 1, At, B1); } PG8_BAR; PG8_SCHED;
            PG8_LDB(B0, 1, 0); PG8_LDB(B1, 1, 1); PG8_SCHED; PG8_LDA(At, 1, 0); PG8_STAGE(PG8_SA(0, 1), a2 + hstep, voffA);
            PG8_WAIT_V(8); PG8_WAIT_L(0); PG8_BAR; PG8_MMA(0, 0, At, B0); PG8_MMA(0, 1, At, B1); PG8_BAR; PG8_SCHED;
            PG8_LDA(At, 1, 1); PG8_STAGE(PG8_SB(1, 0), b3, voffB); PG8_STAGE(PG8_SB(1, 1), b3 + hstepB, voffB); PG8_STAGE(PG8_SA(1, 0), a3, voffA);
            PG8_WAIT_V(8); PG8_WAIT_L(0); PG8_BAR; PG8_MMA(1, 0, At, B0); PG8_MMA(1, 1, At, B1); PG8_BAR; PG8_SCHED;
            } else {
            PG8_LDB(B0, 0, 0); PG8_SCHED; PG8_LDA(At, 0, 0); PG8_STAGE(PG8_SA(1, 1), a1 + hstep, voffA);
            PG8_WAIT_L(8); PG8_BAR; PG8_WAIT_L(0); PG8_MMA(0, 0, At, B0); PG8_BAR; PG8_SCHED;
            PG8_LDB(B1, 0, 1); PG8_STAGE(PG8_SB(0, 0), b2, voffB);
            PG8_BAR; PG8_WAIT_L(0); PG8_MMA(0, 1, At, B1); PG8_BAR;
            PG8_LDA(At, 0, 1); PG8_STAGE(PG8_SA(0, 0), a2, voffA);
            PG8_BAR; PG8_WAIT_L(0); PG8_MMA(1, 0, At, B0); PG8_BAR; PG8_SCHED;
            PG8_STAGE(PG8_SB(0, 1), b2 + hstepB, voffB);
            PG8_WAIT_V(6); PG8_BAR; PG8_MMA(1, 1, At, B1); PG8_BAR;
            PG8_LDB(B0, 1, 0); PG8_SCHED; PG8_LDA(At, 1, 0); PG8_STAGE(PG8_SA(0, 1), a2 + hstep, voffA);
            PG8_WAIT_L(8); PG8_BAR; PG8_WAIT_L(0); PG8_MMA(0, 0, At, B0); PG8_BAR; PG8_SCHED;
            PG8_LDB(B1, 1, 1); PG8_STAGE(PG8_SB(1, 0), b3, voffB);
            PG8_BAR; PG8_WAIT_L(0); PG8_MMA(0, 1, At, B1); PG8_BAR;
            PG8_LDA(At, 1, 1); PG8_STAGE(PG8_SA(1, 0), a3, voffA);
            PG8_BAR; PG8_WAIT_L(0); PG8_MMA(1, 0, At, B0); PG8_BAR; PG8_SCHED;
            PG8_STAGE(PG8_SB(1, 1), b3 + hstepB, voffB);
            PG8_WAIT_V(6); PG8_BAR; PG8_MMA(1, 1, At, B1); PG8_BAR;
            }
        }
        if constexpr (ALIGN_EPI) { if (wr == 0) PG8_BAR; }
        if constexpr (Epi::FP8) asm volatile("s_nop 15\n\ts_nop 15" ::: "memory");
        if constexpr (!Epi::AFTER_DRAIN) { E(acc, cur, wr, wc, fr, fq); if constexpr (EPI_TWICE && Epi::IDEMP) { asm volatile("" ::: "memory"); E(acc, cur, wr, wc, fr, fq); } S.done(cur); }
        if (!has_next) break;
        if constexpr (!(SP2 && Epi::FP8))
#pragma unroll
        for (int a = 0; a < 2; ++a)
#pragma unroll
            for (int b = 0; b < 2; ++b)
#pragma unroll
                for (int m = 0; m < 4; ++m)
#pragma unroll
                    for (int n = 0; n < 2; ++n) acc[a][b][m][n] = (f32x4){0.f, 0.f, 0.f, 0.f};
        cur = nxt; cA = nA; cB = nB; ++ui;
        if constexpr (ALIGN_EPI) { if (wr == 1) PG8_BAR; }
    }
    PG8_WAIT_V(0);
    if constexpr (!ALIGN_EPI) { if (wr == 0) PG8_BAR; }
    PG8_BAR;
    if constexpr (Epi::AFTER_DRAIN) { E.fused(acc, cur, wr, wc, fr, fq, lds, wid, lane); S.done(cur); }
#undef PG8_SA
#undef PG8_SB
#undef PG8_STAGE
#undef PG8_LDA
#undef PG8_LDB
#undef PG8_MMA
#undef PG8_MMA0
#undef PG8_WAIT_V
#undef PG8_WAIT_L
#undef PG8_BAR
#undef PG8_SCHED
}
}

constexpr int NWAVES = 8;
constexpr int BATCH = 32, SEQ = 2048, T = BATCH * SEQ, D = 1024, NPROJ = 2560, FF = 2816, NE = 8, DE = 3584, ADA = 6 * D;
constexpr float EPS = 1e-6f;
constexpr float C2 = 0.125f * 1.4426950408889634f;
constexpr int MAXTILES = 264;
constexpr size_t MiB = 1u << 20;
constexpr size_t WS_CTL = 0, CTL_ZERO_BYTES = 1 * MiB;
constexpr size_t WS_ADA = 1 * MiB;
constexpr size_t WS_G16 = 2560 * 1024;
constexpr size_t WS_PCNT = 3 * MiB;
constexpr size_t WS_TOKE = 4 * MiB, WS_TOKR = 5 * MiB, WS_TOKG = 6 * MiB;
constexpr size_t WS_SLOTT = 7 * MiB, WS_SLOTG = 3 * MiB + 256 * 1024;
constexpr size_t WS_WIN = 8 * MiB;
constexpr size_t WS_WOUT = 18 * MiB;
constexpr size_t WS_WGU = 22 * MiB;
constexpr size_t WS_WD = 33 * MiB;
constexpr size_t WS_GW = 39 * MiB;
constexpr size_t WS_MWGU = 40 * MiB;
constexpr size_t WS_MWD = 96 * MiB;
constexpr size_t WS_XB = 124 * MiB;
constexpr size_t WS_HB = 252 * MiB;
constexpr size_t WS_BIG = 380 * MiB;
constexpr size_t WS_ACT = WS_BIG;
constexpr size_t WS_XS = WS_BIG, WS_ACTM = WS_BIG + 132 * MiB;
constexpr size_t WS_END = 1024 * MiB;
static_assert(WS_ACTM + (size_t)2 * MAXTILES * 256 * DE <= WS_END && WS_XS + (size_t)2 * MAXTILES * 256 * D <= WS_ACTM && WS_ACT + (size_t)T * FF * 2 <= WS_END && WS_BIG + (size_t)T * NPROJ * 2 <= WS_END, "d_ws map");
static_assert(WS_SLOTG + (size_t)2 * MAXTILES * 256 * 4 <= WS_TOKE && WS_SLOTT + (size_t)2 * MAXTILES * 256 * 4 <= WS_WIN && WS_WD + (size_t)D * FF * 2 <= WS_GW && WS_MWGU + (size_t)NE * 2 * DE * D <= WS_MWD
              && WS_MWD + (size_t)NE * D * DE <= WS_XB && WS_XB + (size_t)T * D * 2 <= WS_HB && WS_HB + (size_t)T * D * 2 <= WS_BIG, "d_ws map");
constexpr int CW_TMO = 0, CW_CODE = 1, CW_BAR = 4096;
constexpr int RING_OFF = 0, RING_BYTES = 131072;
constexpr int LDSCTL_OFF = RING_BYTES, MISC_OFF = LDSCTL_OFF + 320, MOE_OFF = LDSCTL_OFF + 512;
constexpr int LDS_BYTES = 147456;
constexpr int MT_TOT = 0, MT_POFF = 8, MT_NT = 20, MT_PBASE = 24, MT_TILE = 32;
constexpr int MT_STRIDE = 128;
static_assert(MT_TILE * 4 + 272 <= MT_STRIDE * 4 && MOE_OFF + 2 * MT_STRIDE * 4 <= LDS_BYTES, "LDS map");

#define GAS __attribute__((address_space(1)))
#define LAS __attribute__((address_space(3)))
typedef unsigned short bf16;
typedef unsigned v4u __attribute__((ext_vector_type(4)));
typedef unsigned v2u __attribute__((ext_vector_type(2)));
typedef float f32x4 __attribute__((ext_vector_type(4)));
typedef GAS unsigned gu32;
#define RLX_AGENT __ATOMIC_RELAXED, __HIP_MEMORY_SCOPE_AGENT
#define LDS_WAIT() asm volatile("s_waitcnt lgkmcnt(0)" ::: "memory")
#define VM_WAIT() asm volatile("s_waitcnt vmcnt(0)" ::: "memory")
__device__ __forceinline__ unsigned f2bf(float f) { unsigned u = __builtin_bit_cast(unsigned, f); return (u + 0x7fffu + ((u >> 16) & 1u)) >> 16; }
__device__ __forceinline__ unsigned pk2(float lo, float hi) { return f2bf(lo) | (f2bf(hi) << 16); }
__device__ __forceinline__ float bflo(unsigned w) { return __builtin_bit_cast(float, w << 16); }
__device__ __forceinline__ float bfhi(unsigned w) { return __builtin_bit_cast(float, w & 0xffff0000u); }
template <int CTRL, int ROW_MASK>
__device__ __forceinline__ float dpp_f(float v) {
    return __builtin_bit_cast(float, __builtin_amdgcn_update_dpp(0, __builtin_bit_cast(int, v), CTRL, ROW_MASK, 0xf, false)); }
__device__ __forceinline__ float wave_sum(float v) {
    v += dpp_f<0xB1, 0xf>(v);
    v += dpp_f<0x4E, 0xf>(v);
    v += dpp_f<0x141, 0xf>(v);
    v += dpp_f<0x140, 0xf>(v);
    v += dpp_f<0x142, 0xa>(v);
    v += dpp_f<0x143, 0xc>(v);
    return __builtin_bit_cast(float, __builtin_amdgcn_readlane(__builtin_bit_cast(int, v), 63));
}

__device__ __forceinline__ int opaque_tid() { int t = threadIdx.x; asm volatile("" : "+v"(t)); return t; }
__device__ __forceinline__ unsigned char* opaque_ptr(unsigned char* p) { size_t z = 0; asm volatile("" : "+s"(z)); return p + z; }
__device__ __forceinline__ int opaque_i(int v) { asm volatile("" : "+s"(v)); return v; }
#define PHASE_IDS() const int tid = opaque_tid(), lane = tid & 63, wave = __builtin_amdgcn_readfirstlane(tid >> 6); (void)lane; (void)wave

#define XB_TMO      128
#define XB_XCNT(j)  (256  + 64 * (j))
#define XB_XSUB(j)  (1280 + 64 * (j))
#define XB_XGEN(j)  (2304 + 64 * (j))
#define XB_TOP      3328
#define XB_TOPGEN   3392
#define XCD_BAR_WORDS 3456
#define XB_SPIN_CAP (1u << 18)

__device__ __forceinline__ unsigned xb_ld(unsigned* p)              { return __hip_atomic_load(p, __ATOMIC_RELAXED, __HIP_MEMORY_SCOPE_AGENT); }
__device__ __forceinline__ unsigned xb_add(unsigned* p, unsigned v) { return __hip_atomic_fetch_add(p, v, __ATOMIC_RELAXED, __HIP_MEMORY_SCOPE_AGENT); }
__device__ __forceinline__ unsigned xb_xcc_id() { return (unsigned)__builtin_amdgcn_s_getreg((3 << 11) | 20) & 0xFu; }
#define XB_SPIN(cond, bar) do { unsigned _sp = 0; while (cond) { __builtin_amdgcn_s_sleep(1); \
    if ((++_sp & 255u) == 0u) { if (xb_ld(&(bar)[XB_TMO])) break; if (_sp > XB_SPIN_CAP) { atomicAdd(&(bar)[XB_TMO], 1u); break; } } } } while (0)

struct XcdBarrier {
    unsigned* bar; unsigned x;
    volatile LAS unsigned* st;
};

__device__ __forceinline__ XcdBarrier xcd_barrier_post(unsigned* bar, volatile LAS unsigned* st) {
    XcdBarrier b; b.bar = bar; b.x = xb_xcc_id(); b.st = st;
    if (threadIdx.x == 0) (void)xb_add(&bar[XB_XCNT(b.x)], 1u);
    return b;
}
__device__ __forceinline__ void xcd_barrier_complete(unsigned* bar, unsigned x, unsigned& nloc, unsigned& nx) {
    const unsigned G = gridDim.x * gridDim.y * gridDim.z;
    unsigned sum, cnt, mine, sp = 0u;
    for (;;) {
        sum = 0u; cnt = 0u; mine = 0u;
#pragma unroll
        for (unsigned j = 0; j < 16; ++j) { const unsigned c = xb_ld(&bar[XB_XCNT(j)]); sum += c; cnt += (c > 0u) ? 1u : 0u; mine = (j == x) ? c : mine; }
        if (sum == G) break;
        __builtin_amdgcn_s_sleep(1);
        if ((++sp & 255u) == 0u) { if (xb_ld(&bar[XB_TMO])) break; if (sp > XB_SPIN_CAP) { atomicAdd(&bar[XB_TMO], 1u); break; } }
    }
    nloc = mine > 0u ? mine : 1u; nx = cnt > 0u ? cnt : 1u;
}

__device__ __forceinline__ void xcd_barrier(const XcdBarrier& b) {
    asm volatile("s_waitcnt vmcnt(0)" ::: "memory");
    __syncthreads();
    if (threadIdx.x == 0) {
        unsigned* bar = b.bar;
        __builtin_amdgcn_s_waitcnt(0);
        unsigned nloc = b.st[0], nx = b.st[1];
        if (nloc == 0u) { xcd_barrier_complete(bar, b.x, nloc, nx); b.st[0] = nloc; b.st[1] = nx; }
        const unsigned old = xb_add(&bar[XB_XSUB(b.x)], 1u);
        const unsigned gen = old / nloc;
        if (old + 1u == (gen + 1u) * nloc) {
            __builtin_amdgcn_fence(__ATOMIC_RELEASE, "agent");
            asm volatile("s_waitcnt vmcnt(0)" ::: "memory");
            const unsigned og = xb_add(&bar[XB_TOP], 1u);
            const unsigned tg = og / nx;
            if (og + 1u == (tg + 1u) * nx) xb_add(&bar[XB_TOPGEN], 1u);
            else XB_SPIN(xb_ld(&bar[XB_TOPGEN]) == tg, bar);
            __builtin_amdgcn_fence(__ATOMIC_ACQUIRE, "agent");
            xb_add(&bar[XB_XGEN(b.x)], 1u);
            asm volatile("s_waitcnt vmcnt(0)" ::: "memory");
        } else {
            XB_SPIN(xb_ld(&bar[XB_XGEN(b.x)]) == gen, bar);
            __builtin_amdgcn_fence(__ATOMIC_ACQUIRE, "agent");
            asm volatile("s_waitcnt vmcnt(0)" ::: "memory");
        }
    }
    __syncthreads();
}

__device__ __forceinline__ void transpose_item(const float* W, int K, int N, bf16* WT, int mode, LAS float* scr, int item, int lane) {
    const int nblk = N / 32, kb = item / nblk, nb = item % nblk, k0 = 64 * kb, n0 = 32 * nb;
#pragma unroll 8
    for (int i = 0; i < 32; ++i) { const int kk = 2 * i + (lane >> 5); scr[kk * 33 + (lane & 31)] = W[(size_t)(k0 + kk) * N + n0 + (lane & 31)]; }
    LDS_WAIT(); asm volatile("" ::: "memory");
    const int c = lane & 7; const float wsc = (mode == 1) ? 1.4426950408889634f : (mode == 2) ? 0.6931471805599453f : 1.0f;
#pragma unroll
    for (int j = 0; j < 4; ++j) { const int n = (lane >> 3) + 8 * j; const LAS float* s = scr + (8 * c) * 33 + n;
        v4u o; o.x = pk2(s[0 * 33] * wsc, s[1 * 33] * wsc); o.y = pk2(s[2 * 33] * wsc, s[3 * 33] * wsc); o.z = pk2(s[4 * 33] * wsc, s[5 * 33] * wsc); o.w = pk2(s[6 * 33] * wsc, s[7 * 33] * wsc);
        const int nc = n0 + n; const int drow = (mode == 0) ? nc : (((nc >> 7) << 8) + ((mode == 2) ? 128 : 0) + (nc & 127));
        *(GAS v4u*)(WT + (size_t)drow * K + k0 + 8 * c) = o; }
    LDS_WAIT(); asm volatile("" ::: "memory");
}
__device__ __forceinline__ void transpose_item_f8(const float* W, int K, int N, unsigned char* WT, int mode, LAS float* scr, int item, int lane) {
    const int nblk = N / 32, kb = item / nblk, nb = item % nblk, k0 = 64 * kb, n0 = 32 * nb;
#pragma unroll 8
    for (int i = 0; i < 32; ++i) { const int kk = 2 * i + (lane >> 5); scr[kk * 33 + (lane & 31)] = W[(size_t)(k0 + kk) * N + n0 + (lane & 31)]; }
    LDS_WAIT(); asm volatile("" ::: "memory");
    const int c = lane & 7; const float wsc = (mode == 1) ? 1.4426950408889634f : (mode == 2) ? 0.6931471805599453f : 1.0f;
#pragma unroll
    for (int j = 0; j < 4; ++j) { const int n = (lane >> 3) + 8 * j; const LAS float* s = scr + (8 * c) * 33 + n;
        v2u o; o.x = pg8::pk4_fp8((f32x4){s[0 * 33], s[1 * 33], s[2 * 33], s[3 * 33]} * (32.0f * wsc)); o.y = pg8::pk4_fp8((f32x4){s[4 * 33], s[5 * 33], s[6 * 33], s[7 * 33]} * (32.0f * wsc));
        const int nc = n0 + n; const int drow = (mode == 0) ? nc : (((nc >> 7) << 8) + ((mode == 2) ? 128 : 0) + (nc & 127));
        *(GAS v2u*)(WT + (size_t)drow * K + k0 + 8 * c) = o; }
    LDS_WAIT(); asm volatile("" ::: "memory");
}
struct Args { const float* in[22]; float* out; unsigned char* ws; };
__device__ __forceinline__ void p0_transposes(const Args& P, LAS unsigned char* lds, int blk, int G) {
    PHASE_IDS();
    LAS float* scr = (LAS float*)(lds + RING_OFF + wave * 16384);
    const int gw = blk * NWAVES + wave, NGW = G * NWAVES;
    bf16* Win_t = (bf16*)(P.ws + WS_WIN); bf16* Wout_t = (bf16*)(P.ws + WS_WOUT); bf16* Wgu_t = (bf16*)(P.ws + WS_WGU); bf16* Wd_t = (bf16*)(P.ws + WS_WD);
    unsigned char* MWgu8 = P.ws + WS_MWGU; unsigned char* MWd8 = P.ws + WS_MWD;
    constexpr int I_IN = (D / 64) * (NPROJ / 32), I_OUT = (D / 64) * (D / 32), I_GU = (D / 64) * (FF / 32), I_DN = (FF / 64) * (D / 32), I_MGU = (D / 64) * (DE / 32), I_MDN = (DE / 64) * (D / 32);
    constexpr int NITEMS = 2 * I_IN + 2 * I_OUT + 2 * I_GU + I_DN + 16 * I_MGU + 8 * I_MDN;
    for (int it = gw; it < NITEMS; it += NGW) {
        int r = it;
        if (r < 2 * I_IN) { const int l = r / I_IN; transpose_item(P.in[6] + (size_t)l * D * NPROJ, D, NPROJ, Win_t + (size_t)l * NPROJ * D, 0, scr, r % I_IN, lane); continue; } r -= 2 * I_IN;
        if (r < 2 * I_OUT) { const int l = r / I_OUT; transpose_item(P.in[13] + (size_t)l * D * D, D, D, Wout_t + (size_t)l * D * D, 0, scr, r % I_OUT, lane); continue; } r -= 2 * I_OUT;
#ifdef FFN_FP8
        if (r < I_GU) { transpose_item_f8(P.in[14], D, FF, (unsigned char*)Wgu_t, 1, scr, r, lane); continue; } r -= I_GU;
        if (r < I_GU) { transpose_item_f8(P.in[15], D, FF, (unsigned char*)Wgu_t, 2, scr, r, lane); continue; } r -= I_GU;
        if (r < I_DN) { transpose_item_f8(P.in[16], FF, D, (unsigned char*)Wd_t, 0, scr, r, lane); continue; } r -= I_DN;
#else
#if FFN_GU_FP8
        if (r < I_GU) { transpose_item_f8(P.in[14], D, FF, (unsigned char*)Wgu_t, 1, scr, r, lane); continue; } r -= I_GU;
        if (r < I_GU) { transpose_item_f8(P.in[15], D, FF, (unsigned char*)Wgu_t, 2, scr, r, lane); continue; } r -= I_GU;
#else
        if (r < I_GU) { transpose_item(P.in[14], D, FF, Wgu_t, 1, scr, r, lane); continue; } r -= I_GU;
        if (r < I_GU) { transpose_item(P.in[15], D, FF, Wgu_t, 2, scr, r, lane); continue; } r -= I_GU;
#endif
#if FFN_DOWN_FP8
        if (r < I_DN) { transpose_item_f8(P.in[16], FF, D, (unsigned char*)Wd_t, 0, scr, r, lane); continue; } r -= I_DN;
#else
        if (r < I_DN) { transpose_item(P.in[16], FF, D, Wd_t, 0, scr, r, lane); continue; } r -= I_DN;
#endif
#endif
        if (r < 8 * I_MGU) { const int e = r / I_MGU; transpose_item_f8(P.in[19] + (size_t)e * D * DE, D, DE, MWgu8 + (size_t)e * 2 * DE * D, 1, scr, r % I_MGU, lane); continue; } r -= 8 * I_MGU;
        if (r < 8 * I_MGU) { const int e = r / I_MGU; transpose_item_f8(P.in[20] + (size_t)e * D * DE, D, DE, MWgu8 + (size_t)e * 2 * DE * D, 2, scr, r % I_MGU, lane); continue; } r -= 8 * I_MGU;
        { const int e = r / I_MDN; transpose_item_f8(P.in[21] + (size_t)e * DE * D, DE, D, MWd8 + (size_t)e * D * DE, 0, scr, r % I_MDN, lane); }
    }
}
__device__ __forceinline__ void p0_ada(const Args& P, LAS unsigned char* lds, int blk, int G) {
    PHASE_IDS();
    LAS float* ca = (LAS float*)(lds + RING_OFF);
    const float* c = P.in[1]; const float* ada_w = P.in[2]; const float* ada_b = P.in[3]; float* ada = (float*)(P.ws + WS_ADA);
    for (int u = blk; u < 192; u += G) {
        const int l = u / 96, col0 = (u % 96) * 64;
        __syncthreads();
        for (int idx = tid; idx < 32768; idx += NWAVES * 64) { const int b = idx & 31, k = idx >> 5; const float v = c[b * 1024 + k]; ca[idx] = v / (1.0f + expf(-v)); }
        __syncthreads();
        float acc[32];
#pragma unroll
        for (int b = 0; b < 32; ++b) acc[b] = 0.f;
        const float* wp = ada_w + ((size_t)l * 1024 + wave * 128) * ADA + col0 + lane;
        for (int kk = 0; kk < 128; ++kk) { const float wv = wp[(size_t)kk * ADA]; const LAS f32x4* cp = (const LAS f32x4*)(ca + (wave * 128 + kk) * 32);
#pragma unroll
            for (int q = 0; q < 8; ++q) { const f32x4 cv = cp[q]; acc[4 * q] += cv.x * wv; acc[4 * q + 1] += cv.y * wv; acc[4 * q + 2] += cv.z * wv; acc[4 * q + 3] += cv.w * wv; } }
        __syncthreads();
#pragma unroll
        for (int b = 0; b < 32; ++b) ca[(wave * 32 + b) * 64 + lane] = acc[b];
        __syncthreads();
#pragma unroll
        for (int o = 0; o < 4; ++o) { const int idx = tid + 512 * o, b = idx >> 6, ln = idx & 63; float s = 0.f;
#pragma unroll
            for (int w = 0; w < 8; ++w) s += ca[(w * 32 + b) * 64 + ln];
            const float av = s + ada_b[l * ADA + col0 + ln];
            ada[((size_t)l * 32 + b) * ADA + col0 + ln] = av;
            if (l == 1 && col0 >= 5 * D) ((bf16*)(P.ws + WS_G16))[b * D + col0 + ln - 5 * D] = (bf16)f2bf(av); }
    }
    __syncthreads();
}
template <bool ROUTE, bool OUT8 = false, bool XBF = false>
__device__ __forceinline__ void norm_phase(const float* xsrc, const float* gvec, const float* ada_l, int sc_off, int sh_off, bf16* HB,
                                           const float* rw, const float* rb, int* pcnt, int* tok_e, int* tok_rank, float* tok_gate,
                                           LAS unsigned char* lds, int blk, int G) {
    PHASE_IDS();
    LAS int* pe = (LAS int*)(lds + RING_OFF); LAS float* pg = (LAS float*)(lds + RING_OFF + 2048); LAS int* wcnt = (LAS int*)(lds + RING_OFF + 4096);
    const LAS f32x4* rwl = (const LAS f32x4*)(lds + RING_OFF + 8192);
    f32x4 rwr[16];
    if constexpr (ROUTE) {
#pragma unroll
        for (int j = 0; j < 4; ++j)
#pragma unroll
            for (int i = 0; i < 4; ++i) rwr[j * 4 + i] = *(const GAS f32x4*)(rw + (size_t)(256 * j + 4 * lane + i) * 8);
        LAS float* wl = (LAS float*)(lds + RING_OFF + 8192);
        for (int idx = tid; idx < D * 8; idx += NWAVES * 64) { const int col = idx >> 3, e = idx & 7; wl[((((col >> 8) * 4 + (col & 3)) * 2 + (e >> 2)) * 64 + ((col & 255) >> 2)) * 4 + (e & 3)] = rw[idx]; }
        __syncthreads();
    }
    for (int p = blk; p < T / 256; p += G) {
        const int b = p >> 3;
        f32x4 mod[4], sh[4];
#pragma unroll
        for (int j = 0; j < 4; ++j) { const int col = 4 * lane + 256 * j; const f32x4 g4 = *(const f32x4*)(gvec + col); const f32x4 sc4 = *(const f32x4*)(ada_l + (size_t)b * ADA + sc_off + col);
            sh[j] = *(const f32x4*)(ada_l + (size_t)b * ADA + sh_off + col); mod[j] = g4 * (1.0f + sc4); }
        float rbv[8];
        if constexpr (ROUTE) {
#pragma unroll
            for (int e = 0; e < 8; ++e) rbv[e] = rb[e];
        }
        constexpr int NAH = 4;
        f32x4 vbx[NAH][4]; v2u vbb[NAH][4];
#pragma unroll
        for (int q = 0; q < NAH; ++q) {
            if constexpr (XBF) { const GAS v2u* xr0 = (const GAS v2u*)((const bf16*)xsrc + (size_t)(p * 256 + q * 8 + wave) * D) + lane;
#pragma unroll
              for (int j = 0; j < 4; ++j) vbb[q][j] = xr0[64 * j]; }
            else { const GAS f32x4* xr0 = (const GAS f32x4*)(xsrc + (size_t)(p * 256 + q * 8 + wave) * D) + lane;
#pragma unroll
              for (int j = 0; j < 4; ++j) vbx[q][j] = xr0[64 * j]; } }
        for (int rr0 = 0; rr0 < 32; rr0 += NAH)
#pragma unroll
        for (int q = 0; q < NAH; ++q) {
            const int rr = rr0 + q;
            const int row = p * 256 + rr * 8 + wave;
            f32x4 v[4]; float ss = 0.f;
#pragma unroll
            for (int j = 0; j < 4; ++j) { if constexpr (XBF) v[j] = (f32x4){bflo(vbb[q][j].x), bfhi(vbb[q][j].x), bflo(vbb[q][j].y), bfhi(vbb[q][j].y)}; else v[j] = vbx[q][j]; }
            if (rr + NAH < 32) {
                if constexpr (XBF) { const GAS v2u* xr = (const GAS v2u*)((const bf16*)xsrc + (size_t)(row + 8 * NAH) * D) + lane;
#pragma unroll
                    for (int j = 0; j < 4; ++j) vbb[q][j] = xr[64 * j]; }
                else { const GAS f32x4* xr = (const GAS f32x4*)(xsrc + (size_t)(row + 8 * NAH) * D) + lane;
#pragma unroll
                    for (int j = 0; j < 4; ++j) vbx[q][j] = xr[64 * j]; } }
#pragma unroll
            for (int j = 0; j < 4; ++j) ss += (v[j].x * v[j].x + v[j].y * v[j].y) + (v[j].z * v[j].z + v[j].w * v[j].w);
            const float rs = 1.0f / sqrtf(wave_sum(ss) * (1.0f / D) + EPS);
            GAS unsigned long long* o8 = (GAS unsigned long long*)(HB + (size_t)row * D) + lane;
#pragma unroll
            for (int j = 0; j < 4; ++j) { v[j] = v[j] * rs * mod[j] + sh[j];
                if constexpr (OUT8) *(GAS unsigned*)((unsigned char*)HB + (size_t)row * D + 4 * lane + 256 * j) = pg8::pk4_fp8(v[j]);
                else o8[64 * j] = (unsigned long long)pk2(v[j].x, v[j].y) | ((unsigned long long)pk2(v[j].z, v[j].w) << 32); }
            if constexpr (ROUTE) {
                float lg[8];
#pragma unroll
                for (int e = 0; e < 8; ++e) lg[e] = 0.f;
#pragma unroll
                for (int j = 0; j < 4; ++j)
#pragma unroll
                    for (int i = 0; i < 4; ++i) { const float y = v[j][i]; const f32x4 r0 = rwr[j * 4 + i], r1 = rwl[((j * 4 + i) * 2 + 1) * 64 + lane];
#pragma unroll
                        for (int e = 0; e < 4; ++e) { lg[e] += y * r0[e]; lg[4 + e] += y * r1[e]; } }
#pragma unroll
                for (int e = 0; e < 8; ++e) lg[e] = wave_sum(lg[e]) + rbv[e];
                int e1 = 0; float l1 = lg[0];
#pragma unroll
                for (int e = 1; e < 8; ++e) if (lg[e] > l1) { l1 = lg[e]; e1 = e; }
                int e2 = 0; float l2 = -INFINITY;
#pragma unroll
                for (int e = 0; e < 8; ++e) if (e != e1 && lg[e] > l2) { l2 = lg[e]; e2 = e; }
                const float g1 = 1.0f / (1.0f + expf(l2 - l1));
                if (lane == 0) { const int i = rr * 8 + wave; pe[i] = e1; pe[256 + i] = e2; pg[i] = g1; pg[256 + i] = 1.0f - g1; }
            }
        }
        if constexpr (ROUTE) {
            __syncthreads();
            int lr[2] = {0, 0};
            if (tid < 256) {
#pragma unroll
                for (int k = 0; k < 2; ++k) { const int e = pe[k * 256 + tid];
#pragma unroll
                    for (int ee = 0; ee < 8; ++ee) { const unsigned long long m = __ballot(e == ee); if (e == ee) lr[k] = __popcll(m & ((1ull << lane) - 1ull)); if (lane == 0) wcnt[(k * 4 + wave) * 8 + ee] = __popcll(m); } }
            }
            __syncthreads();
            if (tid < 256) { const int t = p * 256 + tid;
#pragma unroll
                for (int k = 0; k < 2; ++k) { const int e = pe[k * 256 + tid]; int base = 0;
#pragma unroll
                    for (int w2 = 0; w2 < 4; ++w2) if (w2 < wave) base += wcnt[(k * 4 + w2) * 8 + e];
                    tok_e[t * 2 + k] = e; tok_rank[t * 2 + k] = base + lr[k]; tok_gate[t * 2 + k] = pg[k * 256 + tid]; } }
            if (tid < 16) { const int k = tid >> 3, ee = tid & 7; pcnt[p * 16 + tid] = wcnt[(k * 4 + 0) * 8 + ee] + wcnt[(k * 4 + 1) * 8 + ee] + wcnt[(k * 4 + 2) * 8 + ee] + wcnt[(k * 4 + 3) * 8 + ee]; }
            __syncthreads();
        }
    }
}
__device__ __forceinline__ void qknorm_phase(bf16* PROJ, const float* qg, const float* kg, int blk, int G) {
    PHASE_IDS();
    const int gw = blk * NWAVES + wave, NGW = G * NWAVES;
    float gq[8], gk[8];
#pragma unroll
    for (int i = 0; i < 8; ++i) { gq[i] = qg[(lane & 7) * 8 + i] * C2; gk[i] = kg[(lane & 7) * 8 + i]; }
    for (int it = gw; it < 2 * T; it += NGW) {
        const int row = it >> 1, which = it & 1;
        GAS v4u* p = (GAS v4u*)(PROJ + (size_t)row * NPROJ + which * 512 + lane * 8);
        const v4u raw = *p; float v[8];
#pragma unroll
        for (int i = 0; i < 4; ++i) { v[2 * i] = bflo(raw[i]); v[2 * i + 1] = bfhi(raw[i]); }
        float ss = 0.f;
#pragma unroll
        for (int i = 0; i < 8; ++i) ss += v[i] * v[i];
        ss += __shfl_xor(ss, 1); ss += __shfl_xor(ss, 2); ss += __shfl_xor(ss, 4);
        const float rs = 1.0f / sqrtf(ss * (1.0f / 64.0f) + EPS);
        v4u o;
#pragma unroll
        for (int i = 0; i < 4; ++i) { const float a = v[2 * i] * rs * (which ? gk[2 * i] : gq[2 * i]), c = v[2 * i + 1] * rs * (which ? gk[2 * i + 1] : gq[2 * i + 1]); o[i] = pk2(a, c); }
        *p = o;
    }
}
__device__ __forceinline__ void attn_simple(const bf16* PROJ, bf16* MIX, LAS unsigned char* lds, int blk, int G) {
    PHASE_IDS();
    LAS float* Ks = (LAS float*)(lds + RING_OFF); LAS float* Vs = Ks + 64 * 64;
    for (int i = 0;; ++i) {
        const int u = i * G + blk; if (u >= BATCH * 8 * 4) break;
        const int bh = u >> 2, qb = ((u & 3) + i) & 3, b = bh >> 3, h = bh & 7;
        const int tq = qb * 512 + tid; const size_t rowq = (size_t)b * SEQ + tq;
        float q[64], o[64];
        { const GAS v4u* qp = (const GAS v4u*)(PROJ + rowq * NPROJ + h * 64);
#pragma unroll
          for (int c = 0; c < 8; ++c) { const v4u w = qp[c];
#pragma unroll
              for (int e = 0; e < 4; ++e) { q[8 * c + 2 * e] = bflo(w[e]); q[8 * c + 2 * e + 1] = bfhi(w[e]); } } }
#pragma unroll
        for (int d = 0; d < 64; ++d) o[d] = 0.f;
        float carry = 0.f;
        const int wq_max = qb * 512 + wave * 64 + 63;
        for (int kt = (qb * 512 + 511) >> 6; kt >= 0; --kt) {
            __syncthreads();
            { const size_t krow = (size_t)b * SEQ + kt * 64 + (tid >> 3); const int d8 = (tid & 7) * 8;
              const v4u kr = *(const GAS v4u*)(PROJ + krow * NPROJ + 512 + h * 64 + d8); const v4u vr = *(const GAS v4u*)(PROJ + krow * NPROJ + 1024 + h * 64 + d8);
              LAS float* kd = Ks + (tid >> 3) * 64 + d8; LAS float* vd = Vs + (tid >> 3) * 64 + d8;
#pragma unroll
              for (int e = 0; e < 4; ++e) { kd[2 * e] = bflo(kr[e]); kd[2 * e + 1] = bfhi(kr[e]); vd[2 * e] = bflo(vr[e]); vd[2 * e + 1] = bfhi(vr[e]); } }
            __syncthreads();
            if (kt * 64 < wq_max) {
                for (int j = 63; j >= 0; --j) {
                    const int key = kt * 64 + j;
                    const LAS f32x4* kp = (const LAS f32x4*)(Ks + j * 64); float z = 0.f;
#pragma unroll
                    for (int d4 = 0; d4 < 16; ++d4) { const f32x4 kv = kp[d4]; z += q[4 * d4] * kv.x + q[4 * d4 + 1] * kv.y + q[4 * d4 + 2] * kv.z + q[4 * d4 + 3] * kv.w; }
                    const bool valid = key < tq;
                    const float sp = fmaxf(z, 0.f) + __builtin_amdgcn_logf(1.0f + __builtin_amdgcn_exp2f(-fabsf(z)));
                    const float L = valid ? -sp : 0.f;
                    const float w = valid ? __builtin_amdgcn_exp2f(z + L + carry) : 0.f;
                    carry += L;
                    const LAS f32x4* vp = (const LAS f32x4*)(Vs + j * 64);
#pragma unroll
                    for (int d4 = 0; d4 < 16; ++d4) { const f32x4 vv = vp[d4]; o[4 * d4] += w * vv.x; o[4 * d4 + 1] += w * vv.y; o[4 * d4 + 2] += w * vv.z; o[4 * d4 + 3] += w * vv.w; }
                }
            }
        }
        { GAS v4u* op = (GAS v4u*)(MIX + rowq * D + h * 64);
#pragma unroll
          for (int c = 0; c < 8; ++c) { v4u w;
#pragma unroll
              for (int e = 0; e < 4; ++e) w[e] = pk2(o[8 * c + 2 * e], o[8 * c + 2 * e + 1]);
              op[c] = w; } }
    }
    __syncthreads();
}
namespace sba {
typedef _Float16 f16x8 __attribute__((ext_vector_type(8)));
typedef _Float16 f16x2 __attribute__((ext_vector_type(2)));
typedef short bf16x8 __attribute__((ext_vector_type(8)));
typedef short s16x4 __attribute__((ext_vector_type(4)));
typedef float f32x16 __attribute__((ext_vector_type(16)));
typedef float f32x2_t __attribute__((ext_vector_type(2)));
typedef __bf16 bf16x2_t __attribute__((ext_vector_type(2)));
typedef unsigned u32x4 __attribute__((ext_vector_type(4)));
constexpr int SLOTB = 8192, NSLOT = 5, LDS_K = 0, LDS_V = NSLOT * SLOTB, LDS_BYTES_ATT = 2 * NSLOT * SLOTB;
constexpr float SBA_DEAD = -160.0f;
__device__ __forceinline__ int crow(int r, int hi) { return (r & 3) + 8 * (r >> 2) + 4 * hi; }
__device__ __forceinline__ unsigned cvtpk_bf16(float lo, float hi) { f32x2_t v = {lo, hi}; bf16x2_t b = __builtin_convertvector(v, bf16x2_t); return __builtin_bit_cast(unsigned, b); }
__device__ __forceinline__ unsigned cvtpk_f16(float lo, float hi) { f32x2_t v = {lo, hi}; f16x2 b = __builtin_convertvector(v, f16x2); return __builtin_bit_cast(unsigned, b); }
__device__ __forceinline__ s16x4 vtr(const LAS unsigned char* p) { return __builtin_bit_cast(s16x4, __builtin_amdgcn_ds_read_tr16_b64_v4i16((LAS s16x4*)p)); }

template <int MODE>
__device__ __forceinline__ void tile64(f32x16 (&oT)[2], float& carry, const bf16x8 (&qr)[4], const f16x8 (&tri)[2], const LAS unsigned char* Kslot, const LAS unsigned char* Vslot, int r32, int hi, int lane) {
    constexpr bool HAS1 = (MODE != 2), DIAG1 = (MODE == 1), DIAG0 = (MODE == 2);
    f32x16 z1, z0;
#pragma unroll
    for (int i = 0; i < 16; ++i) { z1[i] = 0.f; z0[i] = 0.f; }
#pragma unroll
    for (int d0 = 0; d0 < 4; ++d0) { const LAS unsigned char* kp = Kslot + (2 * d0 + hi) * 1024 + r32 * 16;
        if (HAS1) { const bf16x8 kf1 = *(const LAS bf16x8*)(kp + 512); z1 = __builtin_amdgcn_mfma_f32_32x32x16_bf16(kf1, qr[d0], z1, 0, 0, 0); }
        const bf16x8 kf0 = *(const LAS bf16x8*)kp; z0 = __builtin_amdgcn_mfma_f32_32x32x16_bf16(kf0, qr[d0], z0, 0, 0, 0); }
    float lg1[16], lg0[16];
#pragma unroll
    for (int i = 0; i < 16; ++i) {
        if (HAS1) { z1[i] = __builtin_amdgcn_fmed3f(z1[i], -3.0e38f, 126.0f); lg1[i] = __builtin_amdgcn_logf(1.0f + __builtin_amdgcn_exp2f(z1[i]));
            if (DIAG1) { const bool valid = crow(i, hi) < r32; lg1[i] = valid ? lg1[i] : 0.f; z1[i] = valid ? z1[i] : -1.0e30f; } }
        z0[i] = __builtin_amdgcn_fmed3f(z0[i], -3.0e38f, 126.0f); lg0[i] = __builtin_amdgcn_logf(1.0f + __builtin_amdgcn_exp2f(z0[i]));
        if (DIAG0) { const bool valid = crow(i, hi) < r32; lg0[i] = valid ? lg0[i] : 0.f; z0[i] = valid ? z0[i] : -1.0e30f; } }
    const float z1r0 = z1[0], z0r0 = z0[0];
    f32x16 D1 = z1, D0 = z0;
#pragma unroll
    for (int s = 0; s < 2; ++s) {
        if (HAS1) { u32x4 w;
#pragma unroll
            for (int j = 0; j < 4; ++j) w[j] = cvtpk_f16(lg1[8 * s + 2 * j], lg1[8 * s + 2 * j + 1]);
            D1 = __builtin_amdgcn_mfma_f32_32x32x16_f16(tri[s], __builtin_bit_cast(f16x8, w), D1, 0, 0, 0); }
        { u32x4 w;
#pragma unroll
            for (int j = 0; j < 4; ++j) w[j] = cvtpk_f16(lg0[8 * s + 2 * j], lg0[8 * s + 2 * j + 1]);
            D0 = __builtin_amdgcn_mfma_f32_32x32x16_f16(tri[s], __builtin_bit_cast(f16x8, w), D0, 0, 0, 0); } }
    float c0 = carry;
    if (HAS1) { const float t1 = D1[0] - z1r0; const auto rr = __builtin_amdgcn_permlane32_swap(__float_as_uint(t1), __float_as_uint(t1), false, false); c0 = carry + __uint_as_float(rr[0]); }
    const float t0 = D0[0] - z0r0; const auto rr0 = __builtin_amdgcn_permlane32_swap(__float_as_uint(t0), __float_as_uint(t0), false, false);
    float P1[16], P0[16];
#pragma unroll
    for (int i = 0; i < 16; ++i) { if (HAS1) P1[i] = __builtin_amdgcn_exp2f(D1[i] + carry); P0[i] = __builtin_amdgcn_exp2f(D0[i] + c0); }
    carry = c0 + __uint_as_float(rr0[0]);
#pragma unroll
    for (int ks = 3; ks >= 0; --ks) {
        if (ks >= 2 && !HAS1) continue;
        u32x4 w;
#pragma unroll
        for (int j = 0; j < 4; ++j) { const int e = 8 * (ks & 1) + 2 * j; w[j] = (ks >= 2) ? cvtpk_bf16(P1[e], P1[e + 1]) : cvtpk_bf16(P0[e], P0[e + 1]); }
        const bf16x8 pf = __builtin_bit_cast(bf16x8, w);
#pragma unroll
        for (int d0 = 0; d0 < 2; ++d0) { const LAS unsigned char* vp = Vslot + d0 * 4096 + ks * 1024 + ((lane >> 4) & 1) * 32 + (lane & 3) * 8 + (4 * hi + ((lane & 15) >> 2)) * 64;
            const s16x4 lo = vtr(vp), hh = vtr(vp + 512);
            const bf16x8 vf = (bf16x8){lo[0], lo[1], lo[2], lo[3], hh[0], hh[1], hh[2], hh[3]};
            oT[d0] = __builtin_amdgcn_mfma_f32_32x32x16_bf16(vf, pf, oT[d0], 0, 0, 0); } }
}
__device__ __forceinline__ void glds16(const void* gsrc, unsigned lds_dst) { unsigned keep;
    asm volatile("s_mov_b32 %0, m0\n\ts_mov_b32 m0, %2\n\ts_nop 0\n\tglobal_load_lds_dwordx4 %1, off\n\ts_mov_b32 m0, %0" : "=&s"(keep) : "v"(gsrc), "s"(lds_dst) : "memory"); }
#define SBA_DMA(t_, sl_) do { \
    glds16(ksrc + (size_t)(t_) * 64 * NPROJ, (unsigned)__builtin_amdgcn_readfirstlane(lds0 + LDS_K + (sl_) * SLOTB + wave * 1024)); \
    glds16(vsrc + (size_t)(t_) * 64 * NPROJ, (unsigned)__builtin_amdgcn_readfirstlane(lds0 + LDS_V + (sl_) * SLOTB + wave * 1024)); } while (0)
__device__ __forceinline__ void attn_phase(const bf16* PROJ, bf16* MIX, LAS unsigned char* lds, int blk, int G) {
    PHASE_IDS();
    const int r32 = lane & 31, hi = lane >> 5;
    const unsigned lds0 = (unsigned)(uintptr_t)lds;
    LAS unsigned* flg = (LAS unsigned*)(lds + LDS_BYTES_ATT);
    f16x8 tri[2];
#pragma unroll
    for (int s = 0; s < 2; ++s)
#pragma unroll
        for (int j = 0; j < 8; ++j) tri[s][j] = (16 * s + 8 * (j >> 2) + 4 * hi + (j & 3) >= r32) ? (_Float16)(-1.0f) : (_Float16)0.0f;
    int s0 = 0, s1 = 1, s2 = 2;
    int p0 = 3, p1 = 4;
    for (int bh = blk; bh < BATCH * 8; bh += G) {
        const int b = bh >> 3, h = bh & 7;
        const bf16* Kh = PROJ + (size_t)b * SEQ * NPROJ + 512 + h * 64; const bf16* Vh = PROJ + (size_t)b * SEQ * NPROJ + 1024 + h * 64;
        const bf16* ksrc = Kh + (size_t)lane * NPROJ + wave * 8;
        const bf16* vsrc = Vh + (size_t)(16 * (wave & 3) + (lane >> 2)) * NPROJ + (wave >> 2) * 32 + (lane & 3) * 8;
        SBA_DMA(3, s0); SBA_DMA(2, s1);
        bf16x8 qr[4], qn[4];
        { const bf16* qp = PROJ + ((size_t)b * SEQ + wave * 32 + r32) * NPROJ + h * 64 + hi * 8;
#pragma unroll
          for (int d0 = 0; d0 < 4; ++d0) qr[d0] = *(const GAS bf16x8*)(qp + d0 * 16); }
        asm volatile("" : "+v"(qr[0]), "+v"(qr[1]), "+v"(qr[2]), "+v"(qr[3]));
        for (int qb = 0; qb < SEQ / 256; ++qb) {
            const int q0w = qb * 256 + wave * 32, NT = 4 * (qb + 1);
            f32x16 oT[2];
#pragma unroll
            for (int i = 0; i < 16; ++i) { oT[0][i] = 0.f; oT[1][i] = 0.f; }
            float carry = 0.f;
            bool mydone = false;
            for (int t = NT - 1; t >= 0; --t) {
                if (t == NT - 1 && qb > 0) asm volatile("s_waitcnt lgkmcnt(0)\n\ts_barrier" ::: "memory");
                else if (t >= 1) asm volatile("s_waitcnt vmcnt(2) lgkmcnt(0)\n\ts_barrier" ::: "memory"); else asm volatile("s_waitcnt vmcnt(0) lgkmcnt(0)\n\ts_barrier" ::: "memory");
                if (t < NT - 1) { const LAS u32x4* fp = (const LAS u32x4*)(flg + ((t + 1) & 1) * 8); const u32x4 fa = fp[0], fb = fp[1];
                    const unsigned all8 = (fa.x & fa.y & fa.z & fa.w) & (fb.x & fb.y & fb.z & fb.w);
                    if (__builtin_amdgcn_readfirstlane((int)all8) != 0) break; }
                if (t == NT - 1 && qb + 1 < SEQ / 256) {
                    SBA_DMA(NT + 3, p0); SBA_DMA(NT + 2, p1);
                    const bf16* qp = PROJ + ((size_t)b * SEQ + q0w + 256 + r32) * NPROJ + h * 64 + hi * 8;
#pragma unroll
                    for (int d0 = 0; d0 < 4; ++d0) qn[d0] = *(const GAS bf16x8*)(qp + d0 * 16); }
                if (t >= 2) SBA_DMA(t - 2, s2);
                const LAS unsigned char* Kslot = lds + LDS_K + s0 * SLOTB; const LAS unsigned char* Vslot = lds + LDS_V + s0 * SLOTB;
                const int khi = 64 * t + 32;
                if (!mydone) {
                    if (khi < q0w) tile64<0>(oT, carry, qr, tri, Kslot, Vslot, r32, hi, lane);
                    else if (khi == q0w) tile64<1>(oT, carry, qr, tri, Kslot, Vslot, r32, hi, lane);
                    else if (khi == q0w + 32) tile64<2>(oT, carry, qr, tri, Kslot, Vslot, r32, hi, lane);
                    mydone = __all(carry < SBA_DEAD) != 0;
                }
                if (lane == 0) flg[(t & 1) * 8 + wave] = mydone ? 1u : 0u;
                { const int tmp = s0; s0 = s1; s1 = s2; s2 = tmp; }
            }
            { bf16* op = MIX + ((size_t)b * SEQ + q0w + r32) * D + h * 64 + 4 * hi;
#pragma unroll
              for (int d0 = 0; d0 < 2; ++d0)
#pragma unroll
                  for (int g = 0; g < 4; ++g) { v2u w; w.x = cvtpk_bf16(oT[d0][4 * g], oT[d0][4 * g + 1]); w.y = cvtpk_bf16(oT[d0][4 * g + 2], oT[d0][4 * g + 3]);
                      *(GAS v2u*)(op + 32 * d0 + 8 * g) = w; } }
            if (qb + 1 < SEQ / 256) {
                asm volatile("" : "+v"(qn[0]), "+v"(qn[1]), "+v"(qn[2]), "+v"(qn[3]));
#pragma unroll
                for (int d0 = 0; d0 < 4; ++d0) qr[d0] = qn[d0];
                const int o0 = s0, o1 = s1; s0 = p0; s1 = p1; p0 = o0; p1 = o1;
            }
        }
    }
    asm volatile("s_waitcnt vmcnt(0) lgkmcnt(0)" ::: "memory");
    __syncthreads();
}
#undef SBA_DMA
}
__device__ __forceinline__ void gmlp_simple(const bf16* PROJ, bf16* MIX, const float* lng, const float* lnb, const float* Wsp, const float* bsp,
                                            LAS unsigned char* lds, int blk, int G) {
    PHASE_IDS();
    LAS float* stats = (LAS float*)(lds + RING_OFF); LAS float* vln = stats + 256; LAS float* Wt = vln + 128 * 64;
    for (int u = blk; u < BATCH * 16; u += G) {
        const size_t row0 = (size_t)(u >> 4) * SEQ + (u & 15) * 128;
        __syncthreads();
        for (int tt = 0; tt < 16; ++tt) { const int tok = wave * 16 + tt;
            const v4u raw = *(const GAS v4u*)(PROJ + (row0 + tok) * NPROJ + 2048 + lane * 8); float v[8]; float s = 0.f;
#pragma unroll
            for (int i = 0; i < 4; ++i) { v[2 * i] = bflo(raw[i]); v[2 * i + 1] = bfhi(raw[i]); s += v[2 * i] + v[2 * i + 1]; }
            const float mean = wave_sum(s) * (1.0f / 512.0f); float s2 = 0.f;
#pragma unroll
            for (int i = 0; i < 8; ++i) { const float d = v[i] - mean; s2 += d * d; }
            const float rstd = 1.0f / sqrtf(wave_sum(s2) * (1.0f / 512.0f) + EPS);
            if (lane == 0) { stats[2 * tok] = mean; stats[2 * tok + 1] = rstd; } }
        for (int g = 0; g < 8; ++g) {
            __syncthreads();
            { const int tok = tid >> 2, cb = (tid & 3) * 16; const GAS v4u* vp = (const GAS v4u*)(PROJ + (row0 + tok) * NPROJ + 2048 + g * 64 + cb);
              const float mean = stats[2 * tok], rstd = stats[2 * tok + 1];
#pragma unroll
              for (int hh = 0; hh < 2; ++hh) { const v4u raw = vp[hh];
#pragma unroll
                  for (int e = 0; e < 4; ++e) { const int c = g * 64 + cb + hh * 8 + 2 * e;
                      vln[tok * 64 + cb + hh * 8 + 2 * e] = (bflo(raw[e]) - mean) * rstd * lng[c] + lnb[c];
                      vln[tok * 64 + cb + hh * 8 + 2 * e + 1] = (bfhi(raw[e]) - mean) * rstd * lng[c + 1] + lnb[c + 1]; } } }
            { const int i = tid & 127, jq = tid >> 7;
#pragma unroll
              for (int jj = 0; jj < 8; ++jj) { const int j4 = (jq * 8 + jj) * 4; f32x4 w = *(const f32x4*)(Wsp + ((size_t)g * 128 + i) * 128 + j4);
                  if (i < 64 && j4 >= 64) w = (f32x4){0.f, 0.f, 0.f, 0.f};
                  Wt[(j4 + 0) * 132 + i] = w.x; Wt[(j4 + 1) * 132 + i] = w.y; Wt[(j4 + 2) * 132 + i] = w.z; Wt[(j4 + 3) * 132 + i] = w.w; } }
            __syncthreads();
            const int tc = tid & 15, ti = tid >> 4; float acc[4][4];
#pragma unroll
            for (int r = 0; r < 4; ++r)
#pragma unroll
                for (int c = 0; c < 4; ++c) acc[r][c] = 0.f;
            const int jmax = (wave < 4) ? 64 : 128;
            for (int j = 0; j < jmax; ++j) { const f32x4 a = *(const LAS f32x4*)(vln + j * 64 + 4 * tc); const f32x4 w = *(const LAS f32x4*)(Wt + j * 132 + 4 * ti);
#pragma unroll
                for (int r = 0; r < 4; ++r)
#pragma unroll
                    for (int c = 0; c < 4; ++c) acc[r][c] += w[r] * a[c]; }
#pragma unroll
            for (int r = 0; r < 4; ++r) { const int i = 4 * ti + r; const float bias = bsp[g * 128 + i];
                const v2u ur = *(const GAS v2u*)(PROJ + (row0 + i) * NPROJ + 1536 + g * 64 + 4 * tc);
                v2u o; o.x = pk2((acc[r][0] + bias) * bflo(ur.x), (acc[r][1] + bias) * bfhi(ur.x)); o.y = pk2((acc[r][2] + bias) * bflo(ur.y), (acc[r][3] + bias) * bfhi(ur.y));
                *(GAS v2u*)(MIX + (row0 + i) * D + 512 + g * 64 + 4 * tc) = o; }
        }
    }
    __syncthreads();
}
__device__ __forceinline__ void p0_spatial(const Args& P, int blk, int G) {
    PHASE_IDS();
    bf16* GW = (bf16*)(P.ws + WS_GW); const float* W = P.in[11];
    for (int idx = blk * (NWAVES * 64) + tid; idx < 2 * 8 * 128 * 128; idx += G * NWAVES * 64) {
        const int p = idx & 127, i = (idx >> 7) & 127, ks = p >> 4, hh = (p >> 3) & 1, jj = p & 7, j = 16 * ks + 8 * (jj >> 2) + 4 * hh + (jj & 3);
        const float w = ((j >> 6) <= (i >> 6)) ? W[(size_t)(idx & ~127) + j] : 0.f;
        GW[idx] = (bf16)f2bf(w); }
}
__device__ __forceinline__ void gmlp_phase(const bf16* PROJ, bf16* MIX, const float* lng, const float* lnb, const bf16* GW, const float* bsp, LAS unsigned char* lds, int blk, int G) {
    PHASE_IDS();
    typedef short bf16x8 __attribute__((ext_vector_type(8))); typedef float f32x16 __attribute__((ext_vector_type(16)));
    const int r32 = lane & 31, hi = lane >> 5, mi = wave >> 1, ci = wave & 1;
    for (int u = blk; u < BATCH * 16; u += G) {
        const size_t row0 = (size_t)(u >> 4) * SEQ + (u & 15) * 128;
        float gam[8], bet[8];
#pragma unroll
        for (int i = 0; i < 8; ++i) { gam[i] = lng[lane * 8 + i]; bet[i] = lnb[lane * 8 + i]; }
        __syncthreads();
        v4u rawn[4];
#pragma unroll
        for (int q = 0; q < 4; ++q) rawn[q] = *(const GAS v4u*)(PROJ + (row0 + q * 8 + wave) * NPROJ + 2048 + lane * 8);
#pragma unroll 1
        for (int tb = 0; tb < 16; tb += 4) {
            v4u raw4[4];
#pragma unroll
            for (int q = 0; q < 4; ++q) raw4[q] = rawn[q];
            if (tb + 4 < 16) {
#pragma unroll
                for (int q = 0; q < 4; ++q) rawn[q] = *(const GAS v4u*)(PROJ + (row0 + (tb + 4 + q) * 8 + wave) * NPROJ + 2048 + lane * 8); }
#pragma unroll
            for (int q = 0; q < 4; ++q) { const int tt = tb + q; const v4u raw = raw4[q]; float v[8]; float s = 0.f;
#pragma unroll
                for (int i = 0; i < 4; ++i) {
#ifdef GELU_IN_PROJ
                    v[2 * i] = bflo(raw[i]); v[2 * i + 1] = bfhi(raw[i]);
#else
                    const pg8::f32x2 ge = pg8::gelu_pk((pg8::f32x2){bflo(raw[i]), bfhi(raw[i])}); v[2 * i] = ge.x; v[2 * i + 1] = ge.y;
#endif
                    s += v[2 * i] + v[2 * i + 1]; }
                const float mean = wave_sum(s) * (1.0f / 512.0f); float s2 = 0.f;
#pragma unroll
                for (int i = 0; i < 8; ++i) { v[i] -= mean; s2 += v[i] * v[i]; }
                const float rstd = 1.0f / sqrtf(wave_sum(s2) * (1.0f / 512.0f) + EPS);
                v4u o;
#pragma unroll
                for (int i = 0; i < 4; ++i) o[i] = pk2(v[2 * i] * rstd * gam[2 * i] + bet[2 * i], v[2 * i + 1] * rstd * gam[2 * i + 1] + bet[2 * i + 1]);
                { const int tok = tt * 8 + wave; *(LAS v4u*)(lds + RING_OFF + (((lane >> 3) * 2 + ((lane >> 2) & 1)) * 8 + (tok >> 4)) * 1024 + (tok & 15) * 64 + (lane & 3) * 16) = o; } } }
        __syncthreads();
        const int nks = (mi < 2) ? 4 : 8;
        const LAS unsigned char* vb = lds + RING_OFF + ((lane >> 4) & 1) * 32 + (lane & 3) * 8 + (4 * hi + ((lane & 15) >> 2)) * 64;
        const int tokr = mi * 32 + r32;
        bf16x8 wfA[8], wfB[8]; v2u urA[4], urB[4]; float biasA = 0.f, biasB = 0.f;
#define GM_LOAD(g_, W_, U_, B_) do { const bf16* wrow_ = GW + ((size_t)(g_) * 128 + mi * 32 + r32) * 128 + hi * 8; \
            _Pragma("unroll") for (int ks = 0; ks < 8; ++ks) W_[ks] = *(const GAS bf16x8*)(wrow_ + ks * 16);     \
            const bf16* up_ = PROJ + (row0 + tokr) * NPROJ + 1536 + (g_) * 64 + ci * 32 + 4 * hi; \
            _Pragma("unroll") for (int gg = 0; gg < 4; ++gg) U_[gg] = *(const GAS v2u*)(up_ + 8 * gg); \
            B_ = bsp[(g_) * 128 + tokr]; } while (0)
#define GM_COMP(g_, W_, U_, B_) do { f32x16 acc; _Pragma("unroll") for (int i = 0; i < 16; ++i) acc[i] = 0.f; \
            _Pragma("unroll") for (int ks = 0; ks < 8; ++ks) if (ks < nks) { const LAS unsigned char* vp = vb + (((g_) * 2 + ci) * 8 + ks) * 1024; \
                const sba::s16x4 lo = sba::vtr(vp), hh = sba::vtr(vp + 512); const bf16x8 vf = (bf16x8){lo[0], lo[1], lo[2], lo[3], hh[0], hh[1], hh[2], hh[3]}; \
                acc = __builtin_amdgcn_mfma_f32_32x32x16_bf16(vf, W_[ks], acc, 0, 0, 0); } \
            bf16* op = MIX + (row0 + tokr) * D + 512 + (g_) * 64 + ci * 32 + 4 * hi; \
            _Pragma("unroll") for (int gg = 0; gg < 4; ++gg) { const v2u ur = U_[gg]; \
                const pg8::f32x2 ga = pg8::gelu_pk((pg8::f32x2){bflo(ur.x), bfhi(ur.x)}), gb = pg8::gelu_pk((pg8::f32x2){bflo(ur.y), bfhi(ur.y)}); \
                v2u o; o.x = pk2((acc[4 * gg] + B_) * ga.x, (acc[4 * gg + 1] + B_) * ga.y); o.y = pk2((acc[4 * gg + 2] + B_) * gb.x, (acc[4 * gg + 3] + B_) * gb.y); \
                *(GAS v2u*)(op + 8 * gg) = o; } } while (0)
        GM_LOAD(0, wfA, urA, biasA);
#pragma unroll 1
        for (int g = 0; g < 8; g += 2) {
            GM_LOAD(g + 1, wfB, urB, biasB);
            GM_COMP(g, wfA, urA, biasA);
            { const int g2 = (g + 2 < 8) ? g + 2 : 0; GM_LOAD(g2, wfA, urA, biasA); }
            GM_COMP(g + 1, wfB, urB, biasB);
        }
#undef GM_LOAD
#undef GM_COMP
    }
    __syncthreads();
}
__device__ __forceinline__ void moe_tables(const int* pcnt, LAS int* MT, LAS int* stage  , int p, int tid, bool first) {
    __syncthreads();
    if (first) { for (int i = tid; i < 4096; i += NWAVES * 64) stage[i] = pcnt[i]; }
    __syncthreads();
    if (tid < 16) { LAS int* M = MT + (tid >> 3) * MT_STRIDE; const int ee = tid & 7; int sacc = 0, pb = 0;
#pragma unroll 16
        for (int q = 0; q < 256; ++q) { if (q == p) pb = sacc; sacc += stage[q * 16 + tid]; }
        M[MT_TOT + ee] = sacc; M[MT_PBASE + ee] = pb; }
    __syncthreads();
    if (first) {
        if (tid == 0 || tid == 64) { LAS int* M = MT + (tid >> 6) * MT_STRIDE; int o = 0;
            for (int e = 0; e < 8; ++e) { M[MT_POFF + e] = o; o += ((M[MT_TOT + e] + 255) >> 8) << 8; }
            M[MT_POFF + 8] = o; M[MT_NT] = o >> 8; }
        __syncthreads();
#pragma unroll
        for (int k = 0; k < 2; ++k) { LAS int* M = MT + k * MT_STRIDE; LAS unsigned char* tile_e = (LAS unsigned char*)(M + MT_TILE); const int nt = M[MT_NT];
            for (int t = tid; t < nt; t += NWAVES * 64) { const int r = t * 256; int e = 0;
#pragma unroll
                for (int ee = 1; ee < 8; ++ee) if (r >= M[MT_POFF + ee]) e = ee;
                tile_e[t] = (unsigned char)e; } }
        __syncthreads();
    }
}
__device__ __forceinline__ void moe_gather2(const bf16* HB, unsigned char* XS, const int* pcnt, const int* tok_e, const int* tok_rank, const float* tok_gate, int* slot_tok, float* slot_gate,
                                            LAS int* MT, LAS unsigned char* lds, int blk, int G) {
    PHASE_IDS();
    LAS int* stage = (LAS int*)(lds + RING_OFF);
    moe_tables(pcnt, MT, stage, blk < T / 256 ? blk : 0, tid, true);
    if (blk == 0) {
        for (int k = 0; k < 2; ++k) { LAS int* M = MT + k * MT_STRIDE;
            for (int e = 0; e < 8; ++e) for (int s = M[MT_POFF + e] + M[MT_TOT + e] + tid; s < M[MT_POFF + e + 1]; s += NWAVES * 64) slot_tok[k * MAXTILES * 256 + s] = -1; }
    }
    for (int p = blk; p < T / 256; p += G) {
        if (p != blk) moe_tables(pcnt, MT, stage, p, tid, false);
        int myslot;
        { const int tj = p * 256 + wave * 32 + (lane >> 1), kj = lane & 1; const LAS int* M = MT + kj * MT_STRIDE;
          const int e = tok_e[tj * 2 + kj]; const int rk = tok_rank[tj * 2 + kj]; const float gt = tok_gate[tj * 2 + kj];
          myslot = kj * MAXTILES * 256 + M[MT_POFF + e] + M[MT_PBASE + e] + rk;
          slot_tok[myslot] = tj; slot_gate[myslot] = gt; }
#pragma unroll
        for (int r0 = 0; r0 < 32; r0 += 16) {
            v4u rowv[16];
#pragma unroll
            for (int q = 0; q < 16; ++q) rowv[q] = ((const GAS v4u*)((const unsigned char*)HB + (size_t)(p * 256 + wave * 32 + r0 + q) * D))[lane];
#pragma unroll
            for (int q = 0; q < 16; ++q) { const int sa = __shfl(myslot, 2 * (r0 + q)), sb = __shfl(myslot, 2 * (r0 + q) + 1);
                ((GAS v4u*)(XS + (size_t)sa * D))[lane] = rowv[q]; ((GAS v4u*)(XS + (size_t)sb * D))[lane] = rowv[q]; }
        }
    }
    __syncthreads();
}

template <bool OUT_F32>
__device__ __forceinline__ void moe_tail_combine(int k, const float* S, const bf16* xb, bf16* xbo, float* xf, const float* gate, const int* slot_tok, const float* slot_gate, LAS int* MT, int nsl, int blk, int G) {
    PHASE_IDS();
    const int ntk = MT[k * MT_STRIDE + MT_NT]; const int nwg = ntk * (D / 256); int full = (nwg / G) * G, ntail = nwg - full;
    if (ntail > 32) { full = nwg; ntail = 0; }
    pg8::StaticOrder SO; SO.init(ntk * 256, D, G, 0);
    const int gw = blk * NWAVES + wave, NGW = G * NWAVES;
    for (int idx = gw; idx < ntail * 256; idx += NGW) { const int q = idx >> 8, r = idx & 255;
        pg8::Unit u; SO.map(full + q, u); const int pmr = k * MAXTILES + u.pm;
        const int slot = pmr * 256 + r; const int tok = slot_tok[slot];
        if (tok < 0) continue;
        const float sg = slot_gate[slot]; const int col = u.pn * 256 + 4 * lane;
        f32x4 a = (f32x4){0.f, 0.f, 0.f, 0.f};
        for (int sl = 0; sl < nsl; ++sl) a += *(const f32x4*)(S + ((size_t)(q * nsl + sl) * 256 + r) * 256 + 4 * lane);
        const f32x4 g4 = *(const f32x4*)(gate + (size_t)(tok >> 11) * ADA + col);
        const v2u xw = *(const GAS v2u*)(xb + (size_t)tok * D + col);
        const f32x4 r4 = (f32x4){bflo(xw.x), bfhi(xw.x), bflo(xw.y), bfhi(xw.y)} + (g4 * sg) * a;
        if (OUT_F32) *(f32x4*)(xf + (size_t)tok * D + col) = r4;
        else { v2u o; o.x = pk2(r4[0], r4[1]); o.y = pk2(r4[2], r4[3]); *(GAS v2u*)(xbo + (size_t)tok * D + col) = o; } }
}

#ifndef SKIPMASK
#define SKIPMASK 0u
#endif
#define PH_ON(x) (((SKIPMASK) & (1u << (x))) == 0u)
#ifndef DBLMASK
#define DBLMASK 0u
#endif
#define PH_REP(x) for (int rep_ = 0; rep_ < ((((DBLMASK) >> (x)) & 1u) ? 2 : 1); ++rep_)
#define GRID_BAR() xcd_barrier(bar)
#define WS_() opaque_ptr(args.ws)
#define WG_SYNC() do { asm volatile("s_waitcnt vmcnt(0) lgkmcnt(0)" ::: "memory"); __syncthreads(); } while (0)
#ifndef PANEL_ORDER
typedef pg8::StaticOrder ChainOrder;
#define CHAIN_SYNC() GRID_BAR()
#else
typedef pg8::PanelOrder ChainOrder;
#define CHAIN_SYNC() WG_SYNC()
#endif
constexpr int MOE_NSL = 7, MOE_KSL = (DE / 2) / MOE_NSL;
__device__ __forceinline__ void moe_tail_split(int ntk, int G, int& full, int& ntail) { const int nwg = ntk * (D / 256); full = (nwg / G) * G; ntail = nwg - full; if (ntail > 32) { full = nwg; ntail = 0; } }
template <int K, int L>
__device__ __forceinline__ void moe_down_main(const Args& args, LAS unsigned char* lds, LAS int* MT, int blk, int G) {
    unsigned char* ws = WS_(); const int ntk = MT[K * MT_STRIDE + MT_NT]; int full, ntail; moe_tail_split(ntk, G, full, ntail);
    pg8::Gemm g{(const bf16*)(ws + WS_ACTM), (const bf16*)(ws + WS_MWD), ntk * 256, D, DE / 2, 0}; pg8::MoeOrder2L S; S.init(ntk * 256, D, G, blk);
    S.tile_e0 = (const LAS unsigned char*)(MT + MT_TILE); S.tile_e1 = (const LAS unsigned char*)(MT + MT_STRIDE + MT_TILE); S.ne_tiles = D / 256; S.nt0 = (K == 0) ? ntk : 0; S.base1 = MAXTILES; S.limit = full;
    pg8::EpiMoeDownB<(K == 1)> E{(const bf16*)(ws + WS_XB), (bf16*)(ws + WS_XB), args.out, (const bf16*)(ws + WS_G16), (const int*)(ws + WS_SLOTT), (const float*)(ws + WS_SLOTG)};
    pg8::gemm_phase<pg8::EpiMoeDownB<(K == 1)>, pg8::MoeOrder2L, true, true>(lds + RING_OFF, g, S, E);
}
template <int K>
__device__ __forceinline__ void moe_down_slices(const Args& args, LAS unsigned char* lds, LAS int* MT, int blk, int G) {
    unsigned char* ws2 = WS_(); const int ntk = MT[K * MT_STRIDE + MT_NT]; int full, ntail; moe_tail_split(ntk, G, full, ntail);
    if (ntail > 0) {
        pg8::Gemm g{(const bf16*)(ws2 + WS_ACTM), (const bf16*)(ws2 + WS_MWD), ntk * 256, D, MOE_KSL, DE / 2}; pg8::MoeTail2 S; S.init(ntk * 256, D, G, blk);
        S.tile_e0 = (const LAS unsigned char*)(MT + MT_TILE); S.tile_e1 = (const LAS unsigned char*)(MT + MT_STRIDE + MT_TILE); S.ne_tiles = D / 256; S.nt0 = (K == 0) ? ntk : 0; S.base1 = MAXTILES;
        S.base = full; S.ntail = ntail; S.nsl = MOE_NSL; S.ksl_bytes = MOE_KSL * 2;
        pg8::EpiTileF32F8 E{(float*)(ws2 + WS_XS) + (size_t)K * 32 * MOE_NSL * 65536};
        pg8::gemm_phase<pg8::EpiTileF32F8, pg8::MoeTail2, true, true>(lds + RING_OFF, g, S, E); }
}
template <int K, int L>
__device__ __forceinline__ void moe_down_combine(const Args& args, LAS int* MT, int blk, int G) {
    unsigned char* ws = WS_();
    moe_tail_combine<(K == 1)>(K, (const float*)(ws + WS_XS) + (size_t)K * 32 * MOE_NSL * 65536, (const bf16*)(ws + WS_XB), (bf16*)(ws + WS_XB), args.out,
                               (const float*)(ws + WS_ADA) + (size_t)L * 32 * ADA + 5 * D, (const int*)(ws + WS_SLOTT), (const float*)(ws + WS_SLOTG), MT, MOE_NSL, blk, G);
}
#define WS_() opaque_ptr(args.ws)
#define WG_SYNC() do { asm volatile("s_waitcnt vmcnt(0) lgkmcnt(0)" ::: "memory"); __syncthreads(); } while (0)
#ifndef PANEL_ORDER
typedef pg8::StaticOrder ChainOrder;
#define CHAIN_SYNC() GRID_BAR()
#else
typedef pg8::PanelOrder ChainOrder;
#define CHAIN_SYNC() WG_SYNC()
#endif
template <int K, int L>
__device__ __forceinline__ void moe_down_half(const Args& args, const XcdBarrier& bar, LAS unsigned char* lds, LAS int* MT, int blk, int G) {
    constexpr int NSL = 7, KSL = (DE / 2) / NSL;
    if (PH_ON(14)) { unsigned char* ws = WS_(); const int ntk = MT[K * MT_STRIDE + MT_NT];
      const int nwg = ntk * (D / 256); int full = (nwg / G) * G, ntail = nwg - full;
      if (ntail > 32) { full = nwg; ntail = 0; }
      { pg8::Gemm g{(const bf16*)(ws + WS_ACTM), (const bf16*)(ws + WS_MWD), ntk * 256, D, DE / 2, 0}; pg8::MoeOrder2L S; S.init(ntk * 256, D, G, blk);
        S.tile_e0 = (const LAS unsigned char*)(MT + MT_TILE); S.tile_e1 = (const LAS unsigned char*)(MT + MT_STRIDE + MT_TILE); S.ne_tiles = D / 256; S.nt0 = (K == 0) ? ntk : 0; S.base1 = MAXTILES; S.limit = full;
        pg8::EpiMoeDownB<(K == 1)> E{(const bf16*)(ws + WS_XB), (bf16*)(ws + WS_XB), args.out, (const bf16*)(ws + WS_G16), (const int*)(ws + WS_SLOTT), (const float*)(ws + WS_SLOTG)};
        pg8::gemm_phase<pg8::EpiMoeDownB<(K == 1)>, pg8::MoeOrder2L, true, true>(lds + RING_OFF, g, S, E); }
      if (ntail > 0) { unsigned char* ws2 = WS_();
        pg8::Gemm g{(const bf16*)(ws2 + WS_ACTM), (const bf16*)(ws2 + WS_MWD), ntk * 256, D, KSL, DE / 2}; pg8::MoeTail2 S; S.init(ntk * 256, D, G, blk);
        S.tile_e0 = (const LAS unsigned char*)(MT + MT_TILE); S.tile_e1 = (const LAS unsigned char*)(MT + MT_STRIDE + MT_TILE); S.ne_tiles = D / 256; S.nt0 = (K == 0) ? ntk : 0; S.base1 = MAXTILES;
        S.base = full; S.ntail = ntail; S.nsl = NSL; S.ksl_bytes = KSL * 2;
        pg8::EpiTileF32F8 E{(float*)(ws2 + WS_XS) + (size_t)K * 32 * NSL * 65536};
        pg8::gemm_phase<pg8::EpiTileF32F8, pg8::MoeTail2, true, true>(lds + RING_OFF, g, S, E); } }
    GRID_BAR();
    if (PH_ON(14)) { unsigned char* ws = WS_();
      moe_tail_combine<(K == 1)>(K, (const float*)(ws + WS_XS) + (size_t)K * 32 * NSL * 65536, (const bf16*)(ws + WS_XB), (bf16*)(ws + WS_XB), args.out,
                                 (const float*)(ws + WS_ADA) + (size_t)L * 32 * ADA + 5 * D, (const int*)(ws + WS_SLOTT), (const float*)(ws + WS_SLOTG), MT, NSL, blk, G); }
}
template <int L>
__device__ __forceinline__ void layer_body(const Args& args, const XcdBarrier& bar, LAS unsigned char* lds, int blk, int G) {
    LAS int* MT = (LAS int*)(lds + MOE_OFF);
    PH_REP(2) if (PH_ON(2)) { unsigned char* ws = WS_();
        if constexpr (L == 0) norm_phase<false>(args.in[0], args.in[4] + L * D, (const float*)(ws + WS_ADA) + (size_t)L * 32 * ADA, 1 * D, 0 * D, (bf16*)(ws + WS_HB),
                          nullptr, nullptr, nullptr, nullptr, nullptr, nullptr, lds, blk, G);
        else norm_phase<false, false, true>((const float*)(ws + WS_XB), args.in[4] + L * D, (const float*)(ws + WS_ADA) + (size_t)L * 32 * ADA, 1 * D, 0 * D, (bf16*)(ws + WS_HB),
                          nullptr, nullptr, nullptr, nullptr, nullptr, nullptr, lds, blk, G); }
    CHAIN_SYNC();
    PH_REP(3) if (PH_ON(3)) { unsigned char* ws = WS_();
      pg8::Gemm g{(const bf16*)(ws + WS_HB), (const bf16*)(ws + WS_WIN) + (size_t)L * NPROJ * D, T, NPROJ, D}; ChainOrder S; S.init(T, NPROJ, G, blk);
      pg8::EpiProjQK E{(bf16*)(ws + WS_BIG), args.in[7] + L * 64, args.in[8] + L * 64, C2, EPS};
      pg8::gemm_phase<pg8::EpiProjQK, ChainOrder, true, true>(lds + RING_OFF, g, S, E); }
    GRID_BAR();
    PH_REP(5) if (PH_ON(5)) { unsigned char* ws = WS_();
        sba::attn_phase((const bf16*)(ws + WS_BIG), (bf16*)(ws + WS_HB), lds, blk, G); }
    PH_REP(6) if (PH_ON(6)) { unsigned char* ws = WS_();
        gmlp_phase((const bf16*)(ws + WS_BIG), (bf16*)(ws + WS_HB), args.in[9] + L * 512, args.in[10] + L * 512, (const bf16*)(ws + WS_GW) + (size_t)L * 8 * 128 * 128, args.in[12] + L * 8 * 128, lds, blk, G); }
    GRID_BAR();
    if (PH_ON(7)) { unsigned char* ws = WS_();
      pg8::Gemm g{(const bf16*)(ws + WS_HB), (const bf16*)(ws + WS_WOUT) + (size_t)L * D * D, T, D, D}; ChainOrder S; S.init(T, D, G, blk);
      if constexpr (L == 0) { pg8::EpiResidB<true, false> E{(const void*)args.in[0], (bf16*)(ws + WS_XB), (const float*)(ws + WS_ADA) + (size_t)L * 32 * ADA + 2 * D};
        pg8::gemm_phase<pg8::EpiResidB<true, false>, ChainOrder, true, true>(lds + RING_OFF, g, S, E); }
      else { pg8::EpiResidB<false, false> E{(const void*)(ws + WS_XB), (bf16*)(ws + WS_XB), (const float*)(ws + WS_ADA) + (size_t)L * 32 * ADA + 2 * D};
        pg8::gemm_phase<pg8::EpiResidB<false, false>, ChainOrder, true, true>(lds + RING_OFF, g, S, E); } }
    CHAIN_SYNC();
    if constexpr (L == 0) {
        if (PH_ON(8)) { unsigned char* ws = WS_();
            norm_phase<false, (FFN_GU_FP8 != 0), true>((const float*)(ws + WS_XB), args.in[5] + L * D, (const float*)(ws + WS_ADA) + (size_t)L * 32 * ADA, 4 * D, 3 * D, (bf16*)(ws + WS_HB),
                              nullptr, nullptr, nullptr, nullptr, nullptr, nullptr, lds, blk, G); }
        CHAIN_SYNC();
        PH_REP(9) if (PH_ON(9)) { unsigned char* ws = WS_();
#if FFN_GU_FP8
          pg8::Gemm g{(const bf16*)(ws + WS_HB), (const bf16*)(ws + WS_WGU), T, 2 * FF, D / 2, 0}; ChainOrder S; S.init(T, 2 * FF, G, blk);
          typedef pg8::EpiSwigluX<true, (FFN_DOWN_FP8 != 0)> EpiGU; EpiGU E{ws + WS_ACT, FF};
          pg8::gemm_phase<EpiGU, ChainOrder, true, true>(lds + RING_OFF, g, S, E); }
#elif FFN_DOWN_FP8
          pg8::Gemm g{(const bf16*)(ws + WS_HB), (const bf16*)(ws + WS_WGU), T, 2 * FF, D}; ChainOrder S; S.init(T, 2 * FF, G, blk);
          pg8::EpiSwigluO8 E{ws + WS_ACT, FF};
          pg8::gemm_phase<pg8::EpiSwigluO8, ChainOrder, true, true>(lds + RING_OFF, g, S, E); }
#else
          pg8::Gemm g{(const bf16*)(ws + WS_HB), (const bf16*)(ws + WS_WGU), T, 2 * FF, D}; ChainOrder S; S.init(T, 2 * FF, G, blk);
          pg8::EpiSwiglu E{(bf16*)(ws + WS_ACT), FF};
          pg8::gemm_phase<pg8::EpiSwiglu, ChainOrder, true, true>(lds + RING_OFF, g, S, E); }
#endif
        CHAIN_SYNC();
        if (PH_ON(10)) { unsigned char* ws = WS_();
#if FFN_DOWN_FP8
          pg8::Gemm g{(const bf16*)(ws + WS_ACT), (const bf16*)(ws + WS_WD), T, D, FF / 2, 0}; ChainOrder S; S.init(T, D, G, blk);
          pg8::EpiResidB<false, true> E{(const void*)(ws + WS_XB), (bf16*)(ws + WS_XB), (const float*)(ws + WS_ADA) + (size_t)L * 32 * ADA + 5 * D};
          pg8::gemm_phase<pg8::EpiResidB<false, true>, ChainOrder, true, true>(lds + RING_OFF, g, S, E); }
#else
          pg8::Gemm g{(const bf16*)(ws + WS_ACT), (const bf16*)(ws + WS_WD), T, D, FF}; ChainOrder S; S.init(T, D, G, blk);
          pg8::EpiResidB<false, false> E{(const void*)(ws + WS_XB), (bf16*)(ws + WS_XB), (const float*)(ws + WS_ADA) + (size_t)L * 32 * ADA + 5 * D};
          pg8::gemm_phase<pg8::EpiResidB<false, false>, ChainOrder, true, true>(lds + RING_OFF, g, S, E); }
#endif
        CHAIN_SYNC();
    } else {
        PH_REP(11) if (PH_ON(11)) { unsigned char* ws = WS_();
            norm_phase<true, true, true>((const float*)(ws + WS_XB), args.in[5] + L * D, (const float*)(ws + WS_ADA) + (size_t)L * 32 * ADA, 4 * D, 3 * D, (bf16*)(ws + WS_HB), args.in[17], args.in[18],
                             (int*)(ws + WS_PCNT), (int*)(ws + WS_TOKE), (int*)(ws + WS_TOKR), (float*)(ws + WS_TOKG), lds, blk, G); }
        GRID_BAR();
        PH_REP(12) if (PH_ON(12)) { unsigned char* ws = WS_();
            moe_gather2((const bf16*)(ws + WS_HB), ws + WS_XS, (const int*)(ws + WS_PCNT), (const int*)(ws + WS_TOKE), (const int*)(ws + WS_TOKR), (const float*)(ws + WS_TOKG),
                        (int*)(ws + WS_SLOTT), (float*)(ws + WS_SLOTG), MT, lds, blk, G); }
        GRID_BAR();
        PH_REP(13) if (PH_ON(13)) { unsigned char* ws = WS_(); const int nt0 = MT[MT_NT], nt1 = MT[MT_STRIDE + MT_NT];
          pg8::Gemm g{(const bf16*)(ws + WS_XS), (const bf16*)(ws + WS_MWGU), (nt0 + nt1) * 256, 2 * DE, D / 2, 0}; pg8::MoeOrder2 S; S.init((nt0 + nt1) * 256, 2 * DE, G, blk);
          S.tile_e0 = (const LAS unsigned char*)(MT + MT_TILE); S.tile_e1 = (const LAS unsigned char*)(MT + MT_STRIDE + MT_TILE); S.ne_tiles = 2 * DE / 256; S.nt0 = nt0; S.base1 = MAXTILES;
          pg8::EpiSwigluF8 E{ws + WS_ACTM, DE};
          pg8::gemm_phase<pg8::EpiSwigluF8, pg8::MoeOrder2, true, true>(lds + RING_OFF, g, S, E); }
        GRID_BAR();
        if (PH_ON(14)) { moe_down_main<0, L>(args, lds, MT, blk, G); moe_down_slices<0>(args, lds, MT, blk, G); moe_down_slices<1>(args, lds, MT, blk, G); }
        GRID_BAR();
        if (PH_ON(14)) moe_down_combine<0, L>(args, MT, blk, G);
        GRID_BAR();
        if (PH_ON(14)) { moe_down_main<1, L>(args, lds, MT, blk, G); moe_down_combine<1, L>(args, MT, blk, G); }
    }
}
__global__ void __launch_bounds__(NWAVES * 64, 2) mk_fwd(const Args args) {
    extern __shared__ __attribute__((aligned(16))) unsigned char lds_raw[];
    LAS unsigned char* lds = (LAS unsigned char*)lds_raw;
    volatile LAS unsigned* MISC = (volatile LAS unsigned*)(lds + MISC_OFF);
    const int G = gridDim.x, blk = blockIdx.x;
    for (int u = threadIdx.x; u < (LDS_BYTES - LDSCTL_OFF) / 4; u += NWAVES * 64) ((LAS unsigned*)(lds + LDSCTL_OFF))[u] = 0u;
    __syncthreads();
    const XcdBarrier bar = xcd_barrier_post((unsigned*)(args.ws + WS_CTL) + CW_BAR, MISC + 8);
    PH_REP(0) if (PH_ON(0)) p0_ada(args, lds, blk, G);
    PH_REP(1) if (PH_ON(1)) p0_transposes(args, lds, blk, G);
    if (PH_ON(1)) p0_spatial(args, blk, G);
    GRID_BAR();
#ifdef PROBE_BARS
    for (int i_ = 0; i_ < PROBE_BARS; ++i_) GRID_BAR();
#endif
    layer_body<0>(args, bar, lds, blk, G);
    layer_body<1>(args, bar, lds, blk, G);
}

extern "C" void kernel_launch(void* const* d_in, const int* in_sizes, int n_in, void* d_out, int out_size, void* d_ws, size_t ws_size, hipStream_t stream) {
    static int grid = 0;
    if (grid == 0) {
        if (n_in != 22 || in_sizes[0] != T * D || out_size != T * D || ws_size < WS_END) {
            fprintf(stderr, "kernel_launch: built for 22 inputs, x/out of %d floats, >= %zu bytes of workspace; got n_in %d, in0 %d, out %d, ws %zu; nothing launched\n", T * D, (size_t)WS_END, n_in, n_in > 0 ? in_sizes[0] : -1, out_size, ws_size);
            grid = -1; return; }
        int dev = 0, cus = 0, per_cu = 0;
        if (hipGetDevice(&dev) != hipSuccess || hipDeviceGetAttribute(&cus, hipDeviceAttributeMultiprocessorCount, dev) != hipSuccess) { fprintf(stderr, "kernel_launch: device query failed\n"); grid = -1; return; }
        if (hipFuncSetAttribute((const void*)mk_fwd, hipFuncAttributeMaxDynamicSharedMemorySize, LDS_BYTES) != hipSuccess) { fprintf(stderr, "kernel_launch: hipFuncSetAttribute failed\n"); grid = -1; return; }
        if (hipOccupancyMaxActiveBlocksPerMultiprocessor(&per_cu, (const void*)mk_fwd, NWAVES * 64, LDS_BYTES) != hipSuccess || per_cu < 1)
            fprintf(stderr, "kernel_launch: note: occupancy query reports %d workgroups per CU\n", per_cu);
        (void)hipGetLastError();
        grid = cus;
    }
    if (grid < 0) return;
    if (hipMemsetAsync((char*)d_ws + WS_CTL, 0, CTL_ZERO_BYTES, stream) != hipSuccess) { fprintf(stderr, "kernel_launch: memset failed\n"); return; }
    Args a{};
    for (int i = 0; i < 22; ++i) a.in[i] = (const float*)d_in[i];
    a.out = (float*)d_out; a.ws = (unsigned char*)d_ws;
    hipLaunchKernelGGL(mk_fwd, dim3(grid), dim3(NWAVES * 64), LDS_BYTES, stream, a);
    const hipError_t le = hipPeekAtLastError();
    if (le != hipSuccess) fprintf(stderr, "kernel_launch: launch failed: %s\n", hipGetErrorName(le));
}
```

```cpp
#ifndef FFN_GU_FP8
#define FFN_GU_FP8 0
#endif
#ifndef FFN_DOWN_FP8
#define FFN_DOWN_FP8 1
#endif
#include <hip/hip_runtime.h>
#include <cstdio>
#include <cstdint>
namespace pg8 {
#define PG8_LAS __attribute__((address_space(3)))
typedef unsigned short bf16_t;
typedef short bf16x8 __attribute__((ext_vector_type(8)));
typedef float f32x4 __attribute__((ext_vector_type(4)));
typedef unsigned u32x4 __attribute__((ext_vector_type(4)));
constexpr int BM = 256, BK = 64, HALF = 128, HTB = HALF * BK * 2  , STAGE_BYTES = 8 * HTB, NXCD = 8, WGM = 8;

__host__ __device__ __forceinline__ int lds_byte(int r, int c) { const int st = (r >> 4) * 2 + (c >> 5), rr = r & 15, cc = c & 31, ob = rr * 64 + cc * 2; return st * 1024 + (ob ^ (((ob >> 9) & 1) << 5)); }
__host__ __device__ __forceinline__ void stage_rc(int b, int& R, int& C) { const int st = b / 1024, sb = b % 1024, swz = sb ^ (((sb >> 9) & 1) << 5); R = (st >> 1) * 16 + swz / 64; C = (st & 1) * 32 + (swz % 64) / 2; }
__host__ __device__ __forceinline__ int perm32(int rho) { const int n = rho >> 4, i = rho & 15; return 8 * (i >> 2) + 4 * n + (i & 3); }

typedef int i32x8 __attribute__((ext_vector_type(8)));
typedef int i32x4 __attribute__((ext_vector_type(4)));
__device__ __forceinline__ i32x8 cat8(bf16x8 lo, bf16x8 hi) { const i32x4 a = __builtin_bit_cast(i32x4, lo), b = __builtin_bit_cast(i32x4, hi); return __builtin_shufflevector(a, b, 0, 1, 2, 3, 4, 5, 6, 7); }
__device__ __forceinline__ void glds16s(const void* sbase, unsigned voff, unsigned lds_dst) { unsigned keep;
    asm volatile("s_mov_b32 %0, m0\n\ts_mov_b32 m0, %3\n\ts_nop 0\n\tglobal_load_lds_dwordx4 %1, %2\n\ts_mov_b32 m0, %0" : "=&s"(keep) : "v"(voff), "s"(sbase), "s"(lds_dst) : "memory"); }
__device__ __forceinline__ void mfma_f8(f32x4& acc, const i32x8 a, const i32x8 b, const int sa, const int sb) {
    asm volatile("v_mfma_scale_f32_16x16x128_f8f6f4 %0, %1, %2, %0, %3, %4 op_sel_hi:[0,0,0]" : "+v"(acc) : "v"(a), "v"(b), "v"(sa), "v"(sb)); }
__device__ __forceinline__ void mfma_f8_z(f32x4& acc, const i32x8 a, const i32x8 b, const int sa, const int sb) {
    asm volatile("v_mfma_scale_f32_16x16x128_f8f6f4 %0, %1, %2, 0, %3, %4 op_sel_hi:[0,0,0]" : "=&v"(acc) : "v"(a), "v"(b), "v"(sa), "v"(sb)); }
__device__ __forceinline__ void mfma_bf16(f32x4& acc, const bf16x8 a, const bf16x8 b) { asm volatile("v_mfma_f32_16x16x32_bf16 %0, %1, %2, %0" : "+v"(acc) : "v"(a), "v"(b)); }
__device__ __forceinline__ void mfma_bf16_z(f32x4& acc, const bf16x8 a, const bf16x8 b) { asm volatile("v_mfma_f32_16x16x32_bf16 %0, %1, %2, 0" : "=&v"(acc) : "v"(a), "v"(b)); }
struct Unit { int pm, pn, bn, skip, kofs; };
struct Gemm { const bf16_t* A; const bf16_t* Bt; int M, N, K, ld; };

struct StaticOrder {
    int nM, nN, nwg, G, c;
    __host__ __device__ void init(int M, int N, int G_, int c_) { nM = M / BM; nN = N / BM; nwg = nM * nN; G = G_; c = c_; }
    __host__ __device__ bool next(int i, Unit& u) const {
        const long L = (long)i * G + c; if (L >= nwg) return false;
        map((int)L, u); return true;
    }
    __host__ __device__ void map(int L, Unit& u) const {
        int wgid = L; { const int q = nwg / NXCD, r = nwg % NXCD, xcd = wgid % NXCD, off = wgid / NXCD; wgid = (xcd < r ? xcd * (q + 1) : r * (q + 1) + (xcd - r) * q) + off; }
        const int nig = WGM * nN, gid = wgid / nig, fm = gid * WGM, gsz = (nM - fm) < WGM ? (nM - fm) : WGM;
        u.pm = fm + ((wgid % nig) % gsz); u.pn = (wgid % nig) / gsz; u.bn = u.pn; u.skip = 0; u.kofs = 0;
    }
    __device__ __forceinline__ void a_ready(const Unit&) const {}
    __device__ __forceinline__ void done(const Unit&) const {}
};

__device__ __forceinline__ unsigned cvt_pk_bf16(float lo, float hi) { unsigned r; asm volatile("v_cvt_pk_bf16_f32 %0, %1, %2" : "=v"(r) : "v"(lo), "v"(hi)); return r; }
typedef float f32x2 __attribute__((ext_vector_type(2)));
__device__ __forceinline__ f32x2 gelu_pk(f32x2 v) {
    const f32x2 av = __builtin_elementwise_abs(v), d = av * 0.2316418882f + 1.0f;
    f32x2 t; t.x = __builtin_amdgcn_rcpf(d.x); t.y = __builtin_amdgcn_rcpf(d.y);
    f32x2 q = t * 0.5307027145f + (-0.7265760135f); q = q * t + 0.7107068705f; q = q * t + (-0.142248368f); q = q * t + 0.127414796f; q = q * t;
    const f32x2 s = (v * v) * (-0.72134752044f);
    f32x2 e; e.x = __builtin_amdgcn_exp2f(s.x); e.y = __builtin_amdgcn_exp2f(s.y);
    const f32x2 m = v * (q * e), r = v - m;
    f32x2 o; o.x = v.x < 0.f ? m.x : r.x; o.y = v.y < 0.f ? m.y : r.y; return o;
}


__device__ __forceinline__ void store_bf16x8(bf16_t* p, const f32x4 v0, const f32x4 v1) {
    u32x4 w; w.x = cvt_pk_bf16(v0[0], v0[1]); w.y = cvt_pk_bf16(v0[2], v0[3]); w.z = cvt_pk_bf16(v1[0], v1[1]); w.w = cvt_pk_bf16(v1[2], v1[3]); *(u32x4*)p = w;
}
__device__ __forceinline__ f32x4 gelu4(const f32x4 v) { const f32x2 a = gelu_pk((f32x2){v[0], v[1]}), b = gelu_pk((f32x2){v[2], v[3]}); return (f32x4){a.x, a.y, b.x, b.y}; }
__device__ __forceinline__ float silu_mul(float g, float u) { return g * u * __builtin_amdgcn_rcpf(1.0f + __builtin_amdgcn_exp2f(-1.4426950408889634f * g)); }
typedef float f32x2 __attribute__((ext_vector_type(2)));
__device__ __forceinline__ f32x4 swiglu4(const f32x4 g, const f32x4 u) {
    const f32x2 ga = {g[0], g[1]}, gb = {g[2], g[3]}, ua = {u[0], u[1]}, ub = {u[2], u[3]};
    const f32x2 ea = {__builtin_amdgcn_exp2f(-ga.x), __builtin_amdgcn_exp2f(-ga.y)}, eb = {__builtin_amdgcn_exp2f(-gb.x), __builtin_amdgcn_exp2f(-gb.y)};
    const f32x2 da = ea + 1.0f, db = eb + 1.0f;
    const f32x2 ra = {__builtin_amdgcn_rcpf(da.x), __builtin_amdgcn_rcpf(da.y)}, rb = {__builtin_amdgcn_rcpf(db.x), __builtin_amdgcn_rcpf(db.y)};
    const f32x2 oa = (ga * ua) * ra, ob = (gb * ub) * rb;
    return (f32x4){oa.x, oa.y, ob.x, ob.y};
}

struct EpiProj {
    static constexpr bool PERM = true, AFTER_DRAIN = false, IDEMP = true; static constexpr int BMODE = 0; static constexpr bool FP8 = false;
    bf16_t* O;
    __device__ __forceinline__ void operator()(const f32x4 (&acc)[2][2][4][2], const Unit& u, int wr, int wc, int fr, int fq) const {
        if (u.skip) return;
        const int row0 = u.pm * BM + wr * 64 + fr, col0 = u.pn * BM + wc * 32 + 8 * fq; const bool act = u.pn >= 6;
#pragma unroll
        for (int ai = 0; ai < 2; ++ai)
#pragma unroll
            for (int m = 0; m < 4; ++m) { bf16_t* rowp = O + (size_t)(row0 + ai * HALF + m * 16) * 2560 + col0;
#pragma unroll
                for (int bj = 0; bj < 2; ++bj) { f32x4 v0 = acc[ai][bj][m][0], v1 = acc[ai][bj][m][1];
                    if (act) { v0 = gelu4(v0); v1 = gelu4(v1); }
                    store_bf16x8(rowp + bj * HALF, v0, v1);
#ifdef DUPSTORE
                    store_bf16x8(rowp + bj * HALF + (size_t)160 * 1024 * 1024, v0, v1);
#endif
                    } }
    }
};
struct EpiProjQK {
    static constexpr bool PERM = true, AFTER_DRAIN = false, IDEMP = true; static constexpr int BMODE = 1; static constexpr bool FP8 = false;
    bf16_t* O; const float* qg; const float* kg; float qscale; float eps;
    __device__ __forceinline__ void operator()(const f32x4 (&acc)[2][2][4][2], const Unit& u, int wr, int wc, int fr, int fq) const {
        const int row0 = u.pm * BM + wr * 64 + fr, col0 = u.pn * BM + wc * 64 + 8 * fq; const int kind = u.pn >> 1;
        if (kind < 2) {
            const float* gp = (kind == 0 ? qg : kg) + 8 * fq; const float gs = (kind == 0) ? qscale : 1.0f;
            f32x4 gv[2][2];
#pragma unroll
            for (int bj = 0; bj < 2; ++bj)
#pragma unroll
                for (int n = 0; n < 2; ++n) gv[bj][n] = *(const f32x4*)(gp + 32 * bj + 4 * n) * gs;
#pragma unroll
            for (int ai = 0; ai < 2; ++ai)
#pragma unroll
                for (int m = 0; m < 4; ++m) { float ss = 0.f;
#pragma unroll
                    for (int bj = 0; bj < 2; ++bj)
#pragma unroll
                        for (int n = 0; n < 2; ++n) { const f32x4 v = acc[ai][bj][m][n]; ss += (v[0] * v[0] + v[1] * v[1]) + (v[2] * v[2] + v[3] * v[3]); }
                    ss += __shfl_xor(ss, 16); ss += __shfl_xor(ss, 32);
                    const float rs = __builtin_amdgcn_rsqf(ss * (1.0f / 64.0f) + eps);
                    bf16_t* rowp = O + (size_t)(row0 + ai * HALF + m * 16) * 2560 + col0;
#pragma unroll
                    for (int bj = 0; bj < 2; ++bj) store_bf16x8(rowp + 32 * bj, acc[ai][bj][m][0] * rs * gv[bj][0], acc[ai][bj][m][1] * rs * gv[bj][1]); }
        } else {
#ifdef GELU_IN_PROJ
            const bool act = kind >= 3;
#else
            constexpr bool act = false;
#endif
#pragma unroll
            for (int ai = 0; ai < 2; ++ai)
#pragma unroll
                for (int m = 0; m < 4; ++m) { bf16_t* rowp = O + (size_t)(row0 + ai * HALF + m * 16) * 2560 + col0;
#pragma unroll
                    for (int bj = 0; bj < 2; ++bj) { f32x4 v0 = acc[ai][bj][m][0], v1 = acc[ai][bj][m][1];
                        if (act) { v0 = gelu4(v0); v1 = gelu4(v1); }
                        store_bf16x8(rowp + 32 * bj, v0, v1); } }
        }
    }
};
struct EpiResid {
    static constexpr bool PERM = false, AFTER_DRAIN = false, IDEMP = false; static constexpr int BMODE = 0; static constexpr bool FP8 = false;
    const float* xin; float* xout; const float* gate;
    __device__ __forceinline__ void operator()(const f32x4 (&acc)[2][2][4][2], const Unit& u, int wr, int wc, int fr, int fq) const {
        const int row0 = u.pm * BM + wr * 64 + fr, col0 = u.pn * BM + wc * 32 + 4 * fq;
        const float* gp = gate + (size_t)(u.pm >> 3) * 6144 + col0;
        f32x4 gv[2][2];
#pragma unroll
        for (int bj = 0; bj < 2; ++bj)
#pragma unroll
            for (int n = 0; n < 2; ++n) gv[bj][n] = *(const f32x4*)(gp + bj * HALF + n * 16);
#pragma unroll
        for (int ai = 0; ai < 2; ++ai) {
            f32x4 xi[4][2][2];
#pragma unroll
            for (int m = 0; m < 4; ++m) { const size_t off = (size_t)(row0 + ai * HALF + m * 16) * 1024 + col0;
#pragma unroll
                for (int bj = 0; bj < 2; ++bj)
#pragma unroll
                    for (int n = 0; n < 2; ++n) xi[m][bj][n] = *(const f32x4*)(xin + off + bj * HALF + n * 16); }
            asm volatile("" ::: "memory");
#pragma unroll
            for (int m = 0; m < 4; ++m) { const size_t off = (size_t)(row0 + ai * HALF + m * 16) * 1024 + col0;
#pragma unroll
                for (int bj = 0; bj < 2; ++bj)
#pragma unroll
                    for (int n = 0; n < 2; ++n) *(f32x4*)(xout + off + bj * HALF + n * 16) = xi[m][bj][n] + gv[bj][n] * acc[ai][bj][m][n]; }
            asm volatile("" ::: "memory");
        }
    }
};
struct EpiSwiglu {
    static constexpr bool PERM = true, AFTER_DRAIN = false, IDEMP = true; static constexpr int BMODE = 0; static constexpr bool FP8 = false;
    bf16_t* O; int ldc;
    __device__ __forceinline__ void operator()(const f32x4 (&acc)[2][2][4][2], const Unit& u, int wr, int wc, int fr, int fq) const {
        const int row0 = u.pm * BM + wr * 64 + fr, col0 = u.pn * HALF + wc * 32 + 8 * fq;
#pragma unroll
        for (int ai = 0; ai < 2; ++ai)
#pragma unroll
            for (int m = 0; m < 4; ++m) { bf16_t* rowp = O + (size_t)(row0 + ai * HALF + m * 16) * ldc + col0;
                const f32x4 g0 = acc[ai][0][m][0], g1 = acc[ai][0][m][1], u0 = acc[ai][1][m][0], u1 = acc[ai][1][m][1];
                const f32x4 r0 = swiglu4(g0, u0), r1 = swiglu4(g1, u1);
                store_bf16x8(rowp, r0, r1); }
    }
};
__device__ __forceinline__ unsigned pk4_fp8(const f32x4 v) {
    int p = 0;
    p = __builtin_amdgcn_cvt_pk_fp8_f32(__builtin_amdgcn_fmed3f(v[0], -448.f, 448.f), __builtin_amdgcn_fmed3f(v[1], -448.f, 448.f), p, false);
    p = __builtin_amdgcn_cvt_pk_fp8_f32(__builtin_amdgcn_fmed3f(v[2], -448.f, 448.f), __builtin_amdgcn_fmed3f(v[3], -448.f, 448.f), p, true);
    return (unsigned)p;
}
struct EpiSwigluF8 {
    static constexpr bool PERM = true, AFTER_DRAIN = false, IDEMP = true; static constexpr int BMODE = 0; static constexpr bool FP8 = true;
    unsigned char* O; int ldc;
    __device__ __forceinline__ void operator()(const f32x4 (&acc)[2][2][4][2], const Unit& u, int wr, int wc, int fr, int fq) const {
        const int row0 = u.pm * BM + wr * 64 + fr, col0 = u.pn * HALF + wc * 32 + 8 * fq;
#pragma unroll
        for (int ai = 0; ai < 2; ++ai)
#pragma unroll
            for (int m = 0; m < 4; ++m) { unsigned char* rowp = O + (size_t)(row0 + ai * HALF + m * 16) * ldc + col0;
                const f32x4 g0 = acc[ai][0][m][0], g1 = acc[ai][0][m][1], u0 = acc[ai][1][m][0], u1 = acc[ai][1][m][1];
                const f32x4 r0 = swiglu4(g0, u0), r1 = swiglu4(g1, u1);
                typedef unsigned u32x2 __attribute__((ext_vector_type(2)));
                u32x2 w; w.x = pk4_fp8(r0); w.y = pk4_fp8(r1); *(u32x2*)rowp = w; }
    }
};
template <bool KF8, bool OF8>
struct EpiSwigluX {
    static constexpr bool PERM = true, AFTER_DRAIN = false, IDEMP = true; static constexpr int BMODE = 0; static constexpr bool FP8 = KF8;
    unsigned char* O; int ldc;
    __device__ __forceinline__ void operator()(const f32x4 (&acc)[2][2][4][2], const Unit& u, int wr, int wc, int fr, int fq) const {
        const int row0 = u.pm * BM + wr * 64 + fr, col0 = u.pn * HALF + wc * 32 + 8 * fq;
#pragma unroll
        for (int ai = 0; ai < 2; ++ai)
#pragma unroll
            for (int m = 0; m < 4; ++m) { unsigned char* rowp = O + ((size_t)(row0 + ai * HALF + m * 16) * ldc + col0) * (OF8 ? 1 : 2);
                const f32x4 r0 = swiglu4(acc[ai][0][m][0], acc[ai][1][m][0]), r1 = swiglu4(acc[ai][0][m][1], acc[ai][1][m][1]);
                if constexpr (OF8) { typedef unsigned u32x2 __attribute__((ext_vector_type(2))); u32x2 w; w.x = pk4_fp8(r0); w.y = pk4_fp8(r1); *(u32x2*)rowp = w; }
                else store_bf16x8((bf16_t*)rowp, r0, r1); }
    }
};
struct EpiSwigluO8 {
    static constexpr bool PERM = true, AFTER_DRAIN = false, IDEMP = true; static constexpr int BMODE = 0; static constexpr bool FP8 = false;
    unsigned char* O; int ldc;
    __device__ __forceinline__ void operator()(const f32x4 (&acc)[2][2][4][2], const Unit& u, int wr, int wc, int fr, int fq) const {
        const int row0 = u.pm * BM + wr * 64 + fr, col0 = u.pn * HALF + wc * 32 + 8 * fq;
#pragma unroll
        for (int ai = 0; ai < 2; ++ai)
#pragma unroll
            for (int m = 0; m < 4; ++m) { unsigned char* rowp = O + (size_t)(row0 + ai * HALF + m * 16) * ldc + col0;
                const f32x4 r0 = swiglu4(acc[ai][0][m][0], acc[ai][1][m][0]), r1 = swiglu4(acc[ai][0][m][1], acc[ai][1][m][1]);
                typedef unsigned u32x2 __attribute__((ext_vector_type(2)));
                u32x2 w; w.x = pk4_fp8(r0); w.y = pk4_fp8(r1); *(u32x2*)rowp = w; }
    }
};
struct EpiMoeDown {
    static constexpr bool PERM = false, AFTER_DRAIN = false, IDEMP = false; static constexpr int BMODE = 0; static constexpr bool FP8 = false;
    float* x; const float* gate; const int* slot_tok; const float* slot_gate;
    __device__ __forceinline__ void operator()(const f32x4 (&acc)[2][2][4][2], const Unit& u, int wr, int wc, int fr, int fq) const {
        const int slot0 = u.pm * BM + wr * 64 + fr, col0 = u.pn * BM + wc * 32 + 4 * fq;
        int tok[2][4]; float sg[2][4];
#pragma unroll
        for (int ai = 0; ai < 2; ++ai)
#pragma unroll
            for (int m = 0; m < 4; ++m) { const int slot = slot0 + ai * HALF + m * 16; tok[ai][m] = slot_tok[slot]; sg[ai][m] = slot_gate[slot]; }
#pragma unroll
        for (int ai = 0; ai < 2; ++ai)
#pragma unroll
            for (int mp = 0; mp < 2; ++mp) {
                f32x4 gvv[2][2][2], xi[2][2][2];
#pragma unroll
                for (int q = 0; q < 2; ++q) { const int t = tok[ai][2 * mp + q], te = t < 0 ? 0 : t;
                    const float* gp = gate + (size_t)(te >> 11) * 6144 + col0; const float* xp = x + (size_t)te * 1024 + col0;
#pragma unroll
                    for (int bj = 0; bj < 2; ++bj)
#pragma unroll
                        for (int n = 0; n < 2; ++n) { gvv[q][bj][n] = *(const f32x4*)(gp + bj * HALF + n * 16); xi[q][bj][n] = *(const f32x4*)(xp + bj * HALF + n * 16); } }
                asm volatile("" ::: "memory");
#pragma unroll
                for (int q = 0; q < 2; ++q) { const int m = 2 * mp + q; const int t = tok[ai][m];
                    if (t >= 0) { float* xp = x + (size_t)t * 1024 + col0; const float g1 = sg[ai][m];
#pragma unroll
                        for (int bj = 0; bj < 2; ++bj)
#pragma unroll
                            for (int n = 0; n < 2; ++n) *(f32x4*)(xp + bj * HALF + n * 16) = xi[q][bj][n] + (gvv[q][bj][n] * g1) * acc[ai][bj][m][n]; } }
                asm volatile("" ::: "memory");
            }
    }
};
struct EpiMoeDownF8 : EpiMoeDown { static constexpr bool FP8 = true; };
struct EpiResidF8 : EpiResid { static constexpr bool FP8 = true; };
__device__ __forceinline__ void unpack_bf16x8(const u32x4 w, f32x4& a, f32x4& b) {
    a = (f32x4){__builtin_bit_cast(float, w.x << 16), __builtin_bit_cast(float, w.x & 0xffff0000u), __builtin_bit_cast(float, w.y << 16), __builtin_bit_cast(float, w.y & 0xffff0000u)};
    b = (f32x4){__builtin_bit_cast(float, w.z << 16), __builtin_bit_cast(float, w.z & 0xffff0000u), __builtin_bit_cast(float, w.w << 16), __builtin_bit_cast(float, w.w & 0xffff0000u)}; }
template <bool IN_F32, bool F8>
struct EpiResidB {
    static constexpr bool PERM = true, AFTER_DRAIN = false, IDEMP = false; static constexpr int BMODE = 0; static constexpr bool FP8 = F8;
    const void* xin; bf16_t* xout; const float* gate;
    __device__ __forceinline__ void operator()(const f32x4 (&acc)[2][2][4][2], const Unit& u, int wr, int wc, int fr, int fq) const {
        const int row0 = u.pm * BM + wr * 64 + fr, col0 = u.pn * BM + wc * 32 + 8 * fq;
        const float* gp = gate + (size_t)(u.pm >> 3) * 6144 + col0;
        f32x4 gv[2][2];
#pragma unroll
        for (int bj = 0; bj < 2; ++bj)
#pragma unroll
            for (int n = 0; n < 2; ++n) gv[bj][n] = *(const f32x4*)(gp + bj * HALF + n * 4);
        const unsigned e0 = (unsigned)row0 * 1024u + (unsigned)col0;
        if constexpr (!IN_F32) {
            u32x4 xw[2][4][2];
#define RB_EO(ai, m, bj) (e0 + (unsigned)(((ai) * HALF + (m) * 16) * 1024 + (bj) * HALF))
#define RB_LD(ai, m, bj) xw[ai][m][bj] = *(const u32x4*)((const char*)xin + (size_t)(RB_EO(ai, m, bj) * 2u))
#define RB_ST(ai, m, bj) do { f32x4 xa_, xc_; unpack_bf16x8(xw[ai][m][bj], xa_, xc_); \
                store_bf16x8((bf16_t*)((char*)xout + (size_t)(RB_EO(ai, m, bj) * 2u)), xa_ + gv[bj][0] * acc[ai][bj][m][0], xc_ + gv[bj][1] * acc[ai][bj][m][1]); } while (0)
#pragma unroll
            for (int m = 0; m < 4; ++m) { RB_LD(0, m, 0); RB_LD(0, m, 1); }
#pragma unroll
            for (int m = 0; m < 2; ++m) { RB_LD(1, m, 0); RB_LD(1, m, 1); }
            asm volatile("" ::: "memory");
#pragma unroll
            for (int m = 0; m < 2; ++m) { RB_ST(0, m, 0); RB_ST(0, m, 1); }
            asm volatile("" ::: "memory");
#pragma unroll
            for (int m = 2; m < 4; ++m) { RB_LD(1, m, 0); RB_LD(1, m, 1); }
            asm volatile("" ::: "memory");
#pragma unroll
            for (int m = 2; m < 4; ++m) { RB_ST(0, m, 0); RB_ST(0, m, 1); }
#pragma unroll
            for (int m = 0; m < 4; ++m) { RB_ST(1, m, 0); RB_ST(1, m, 1); }
            asm volatile("" ::: "memory");
#undef RB_EO
#undef RB_LD
#undef RB_ST
            return;
        }
#pragma unroll
        for (int ai = 0; ai < 2; ++ai) {
            f32x4 xa[4][2], xb2[4][2];
#pragma unroll
            for (int m = 0; m < 4; ++m)
#pragma unroll
                for (int bj = 0; bj < 2; ++bj) { const unsigned eo = e0 + (unsigned)((ai * HALF + m * 16) * 1024 + bj * HALF);
                    if (IN_F32) { xa[m][bj] = *(const f32x4*)((const char*)xin + (size_t)(eo * 4u)); xb2[m][bj] = *(const f32x4*)((const char*)xin + (size_t)(eo * 4u) + 16); }
                    else unpack_bf16x8(*(const u32x4*)((const char*)xin + (size_t)(eo * 2u)), xa[m][bj], xb2[m][bj]); }
            asm volatile("" ::: "memory");
#pragma unroll
            for (int m = 0; m < 4; ++m)
#pragma unroll
                for (int bj = 0; bj < 2; ++bj) { const unsigned eo = e0 + (unsigned)((ai * HALF + m * 16) * 1024 + bj * HALF);
                    store_bf16x8((bf16_t*)((char*)xout + (size_t)(eo * 2u)), xa[m][bj] + gv[bj][0] * acc[ai][bj][m][0], xb2[m][bj] + gv[bj][1] * acc[ai][bj][m][1]); }
            asm volatile("" ::: "memory");
        }
    }
};
template <bool OUT_F32>
struct EpiMoeDownB {
    static constexpr bool PERM = true, AFTER_DRAIN = false, IDEMP = false; static constexpr int BMODE = 0; static constexpr bool FP8 = true;
    const bf16_t* xb; bf16_t* xbo; float* xf; const bf16_t* gate16; const int* slot_tok; const float* slot_gate;
    __device__ __forceinline__ void operator()(const f32x4 (&acc)[2][2][4][2], const Unit& u, int wr, int wc, int fr, int fq) const {
        const int slot0 = u.pm * BM + wr * 64 + fr, col0 = u.pn * BM + wc * 32 + 8 * fq;
        int tok[2][4]; float sg[2][4];
#pragma unroll
        for (int ai = 0; ai < 2; ++ai)
#pragma unroll
            for (int m = 0; m < 4; ++m) { const int slot = slot0 + ai * HALF + m * 16; tok[ai][m] = slot_tok[slot]; sg[ai][m] = slot_gate[slot]; }
#pragma unroll
        for (int ai = 0; ai < 2; ++ai) {
            u32x4 gw[4][2], xw[4][2];
#pragma unroll
            for (int q = 0; q < 4; ++q) { const int t = tok[ai][q], te = t < 0 ? 0 : t;
                const bf16_t* gp = gate16 + (size_t)(te >> 11) * 1024 + col0; const bf16_t* xp = xb + (size_t)te * 1024 + col0;
#pragma unroll
                for (int bj = 0; bj < 2; ++bj) { gw[q][bj] = *(const u32x4*)(gp + bj * HALF); xw[q][bj] = *(const u32x4*)(xp + bj * HALF); } }
            asm volatile("" ::: "memory");
#pragma unroll
            for (int q = 0; q < 4; ++q) { const int t = tok[ai][q];
                if (t >= 0) { const float g1 = sg[ai][q];
#pragma unroll
                    for (int bj = 0; bj < 2; ++bj) { f32x4 ga, gc, xa, xc; unpack_bf16x8(gw[q][bj], ga, gc); unpack_bf16x8(xw[q][bj], xa, xc);
                        const f32x4 r0 = xa + (ga * g1) * acc[ai][bj][q][0], r1 = xc + (gc * g1) * acc[ai][bj][q][1];
                        if (OUT_F32) { float* op = xf + (size_t)t * 1024 + col0 + bj * HALF; *(f32x4*)op = r0; *(f32x4*)(op + 4) = r1; }
                        else store_bf16x8(xbo + (size_t)t * 1024 + col0 + bj * HALF, r0, r1); } } }
            asm volatile("" ::: "memory");
        }
    }
};
struct DupOrder : StaticOrder {
    __device__ __forceinline__ bool next(int i, Unit& u) const { if (!StaticOrder::next(i >> 1, u)) return false; u.skip = i & 1; return true; }
};
struct PanelOrder {
    int nM, nN, G, c;
    __device__ __forceinline__ void init(int M, int N, int G_, int c_) { nM = M / BM; nN = N / BM; G = G_; c = c_; }
    __device__ __forceinline__ bool next(int i, Unit& u) const { const int pi = i / nN; u.pm = c + pi * G; if (u.pm >= nM) return false; u.pn = i - pi * nN; u.bn = u.pn; u.skip = 0; u.kofs = 0; return true; }
    __device__ __forceinline__ void a_ready(const Unit&) const {}
    __device__ __forceinline__ void done(const Unit&) const {}
};
struct MoeOrder : StaticOrder {
    const PG8_LAS unsigned char* tile_e; int ne_tiles; int limit;
    __device__ __forceinline__ bool next(int i, Unit& u) const { const long L = (long)i * G + c; if (L >= limit) return false; map((int)L, u); u.bn = (int)tile_e[u.pm] * ne_tiles + u.pn; return true; }
};
struct MoeOrder2 : StaticOrder {
    const PG8_LAS unsigned char* tile_e0; const PG8_LAS unsigned char* tile_e1; int ne_tiles, nt0, base1;
    __device__ __forceinline__ bool next(int i, Unit& u) const { const long L = (long)i * G + c; if (L >= nwg) return false; map((int)L, u);
        int e; if (u.pm < nt0) e = tile_e0[u.pm]; else { const int pl = u.pm - nt0; e = tile_e1[pl]; u.pm = base1 + pl; }
        u.bn = e * ne_tiles + u.pn; return true; }
};
struct MoeOrder2L : MoeOrder2 { int limit;
    __device__ __forceinline__ bool next(int i, Unit& u) const { const long L = (long)i * G + c; if (L >= limit) return false; map((int)L, u);
        int e; if (u.pm < nt0) e = tile_e0[u.pm]; else { const int pl = u.pm - nt0; e = tile_e1[pl]; u.pm = base1 + pl; }
        u.bn = e * ne_tiles + u.pn; return true; } };
struct MoeTail2 : MoeOrder2 { int base, ntail, nsl, ksl_bytes;
    __device__ __forceinline__ bool next(int i, Unit& u) const { const int j = i * G + c; if (j >= ntail * nsl) return false; const int q = j / nsl; map(base + q, u);
        int e; if (u.pm < nt0) e = tile_e0[u.pm]; else { const int pl = u.pm - nt0; e = tile_e1[pl]; u.pm = base1 + pl; }
        u.bn = e * ne_tiles + u.pn; u.kofs = (j - q * nsl) * ksl_bytes; u.skip = j; return true; } };
struct EpiTileF32F8 {
    static constexpr bool PERM = false, AFTER_DRAIN = false, IDEMP = true; static constexpr int BMODE = 0; static constexpr bool FP8 = true;
    float* S;
    __device__ __forceinline__ void operator()(const f32x4 (&acc)[2][2][4][2], const Unit& u, int wr, int wc, int fr, int fq) const {
        float* base = S + (size_t)u.skip * 65536 + (size_t)(wr * 64 + fr) * 256 + wc * 32 + 4 * fq;
#pragma unroll
        for (int ai = 0; ai < 2; ++ai)
#pragma unroll
            for (int m = 0; m < 4; ++m)
#pragma unroll
                for (int bj = 0; bj < 2; ++bj)
#pragma unroll
                    for (int n = 0; n < 2; ++n) *(f32x4*)(base + (size_t)(ai * HALF + m * 16) * 256 + bj * HALF + n * 16) = acc[ai][bj][m][n];
    }
};
struct MoeTailOrder : StaticOrder {
    const PG8_LAS unsigned char* tile_e; int ne_tiles; int base, ntail, nsl, ksl_bytes;
    __device__ __forceinline__ bool next(int i, Unit& u) const { const int j = i * G + c; if (j >= ntail * nsl) return false; const int q = j / nsl; map(base + q, u);
        u.bn = (int)tile_e[u.pm] * ne_tiles + u.pn; u.kofs = (j - q * nsl) * ksl_bytes; return true; }
};
struct EpiMoeDownAtomic {
    static constexpr bool PERM = false, AFTER_DRAIN = false, IDEMP = false; static constexpr int BMODE = 0; static constexpr bool FP8 = false;
    float* x; const float* gate; const int* slot_tok; const float* slot_gate;
    __device__ __forceinline__ void operator()(const f32x4 (&acc)[2][2][4][2], const Unit& u, int wr, int wc, int fr, int fq) const {
        const int slot0 = u.pm * BM + wr * 64 + fr, col0 = u.pn * BM + wc * 32 + 4 * fq;
#pragma unroll
        for (int ai = 0; ai < 2; ++ai)
#pragma unroll
            for (int m = 0; m < 4; ++m) { const int slot = slot0 + ai * HALF + m * 16; const int tok = slot_tok[slot];
                if (tok >= 0) { const float sg = slot_gate[slot]; const float* gp = gate + (size_t)(tok >> 11) * 6144 + col0; float* xp = x + (size_t)tok * 1024 + col0;
#pragma unroll
                    for (int bj = 0; bj < 2; ++bj)
#pragma unroll
                        for (int n = 0; n < 2; ++n) { const f32x4 v = (*(const f32x4*)(gp + bj * HALF + n * 16) * sg) * acc[ai][bj][m][n];
#pragma unroll
                            for (int e = 0; e < 4; ++e) unsafeAtomicAdd(xp + bj * HALF + n * 16 + e, v[e]); } } }
    }
};

#ifndef EPI_TWICE
#define EPI_TWICE false
#endif
template <class Epi, class Sched, bool ALIGN_EPI = false, bool SP2 = false>
__device__ __forceinline__ void gemm_phase(PG8_LAS unsigned char* lds, const Gemm g, const Sched& S, const Epi& E) {
    int tid_o = threadIdx.x; asm volatile("" : "+v"(tid_o));
    const int tid = tid_o, wid = __builtin_amdgcn_readfirstlane(tid >> 6), lane = tid & 63, wr = wid >> 2, wc = wid & 3, fr = lane & 15, fq = lane >> 4;
    const int nt = g.K / BK, K = g.ld ? g.ld : g.K;
    unsigned voffA[2], voffB[2];
#pragma unroll
    for (int i = 0; i < 2; ++i) { int R, C; stage_rc(tid * 16 + i * 8192, R, C); const int Rb = (Epi::BMODE == 1) ? (64 * (R >> 5) + perm32(R & 31)) : (Epi::PERM ? ((R & ~31) + perm32(R & 31)) : R);
        voffA[i] = (unsigned)(R * K + C) * 2u; voffB[i] = (unsigned)(Rb * K + C) * 2u; }
    const size_t kstep = (size_t)(BK * 2);
    const size_t hstep = (size_t)HALF * K * 2;
    const size_t hstepB = (Epi::BMODE == 1) ? (size_t)32 * K * 2 : hstep;
    const size_t tstep = 2 * hstep;
    const unsigned lds0 = (unsigned)(uintptr_t)lds;
    const unsigned ldsw = (unsigned)wid * 1024u;
    const int aoff = lds_byte(wr * 64 + fr, fq * 8), boff = lds_byte(wc * 32 + fr, fq * 8);
#define PG8_SA(b, h) (((b) * 2 + (h)) * HTB)
#define PG8_SB(b, h) ((4 + (b) * 2 + (h)) * HTB)
#ifndef PG8_ASM_STAGE
#define PG8_ASM_STAGE 1
#endif
#if PG8_ASM_STAGE
#define PG8_STAGE(bufoff, gbase, voff) do { _Pragma("unroll") for (int _i = 0; _i < 2; ++_i) glds16s((const void*)(gbase), (voff)[_i], (unsigned)__builtin_amdgcn_readfirstlane((int)(lds0 + (unsigned)(bufoff) + ldsw + (unsigned)_i * 8192u))); } while (0)
#else
#define PG8_STAGE(bufoff, gbase, voff) do { _Pragma("unroll") for (int _i = 0; _i < 2; ++_i) \
        __builtin_amdgcn_global_load_lds((const unsigned*)((const char*)(gbase) + (voff)[_i]), (PG8_LAS unsigned*)(lds + (bufoff) + ldsw + _i * 8192), 16, 0, 0); } while (0)
#endif
#define PG8_LDA(dst, b, h) do { _Pragma("unroll") for (int m = 0; m < 4; ++m) _Pragma("unroll") for (int k = 0; k < 2; ++k) dst[m][k] = *(const PG8_LAS bf16x8*)(lds + PG8_SA(b, h) + aoff + m * 2048 + k * 1024); } while (0)
#define PG8_LDB(dst, b, h) do { _Pragma("unroll") for (int n = 0; n < 2; ++n) _Pragma("unroll") for (int k = 0; k < 2; ++k) dst[n][k] = *(const PG8_LAS bf16x8*)(lds + PG8_SB(b, h) + boff + n * 2048 + k * 1024); } while (0)
#define PG8_MMA(ai, bj, At, Bt) do { __builtin_amdgcn_s_setprio(1); _Pragma("unroll") for (int m = 0; m < 4; ++m) _Pragma("unroll") for (int n = 0; n < 2; ++n) { \
        if constexpr (Epi::FP8) mfma_f8(acc[ai][bj][m][n], cat8(Bt[n][0], Bt[n][1]), cat8(At[m][0], At[m][1]), 0x7a7a7a7a, 0x7f7f7f7f); \
        else { _Pragma("unroll") for (int k = 0; k < 2; ++k) acc[ai][bj][m][n] = __builtin_amdgcn_mfma_f32_16x16x32_bf16(Bt[n][k], At[m][k], acc[ai][bj][m][n], 0, 0, 0); } } \
        __builtin_amdgcn_s_setprio(0); } while (0)
#define PG8_MMA0(ai, bj, At, Bt) do { __builtin_amdgcn_s_setprio(1); _Pragma("unroll") for (int m = 0; m < 4; ++m) _Pragma("unroll") for (int n = 0; n < 2; ++n) \
        mfma_f8_z(acc[ai][bj][m][n], cat8(Bt[n][0], Bt[n][1]), cat8(At[m][0], At[m][1]), 0x7a7a7a7a, 0x7f7f7f7f); \
        __builtin_amdgcn_s_setprio(0); } while (0)
#define PG8_WAIT_V(n) asm volatile("s_waitcnt vmcnt(" #n ")" ::: "memory")
#define PG8_WAIT_L(n) asm volatile("s_waitcnt lgkmcnt(" #n ")" ::: "memory")
#define PG8_BAR __builtin_amdgcn_s_barrier()
#define PG8_SCHED __builtin_amdgcn_sched_barrier(0)
    Unit cur, nxt; int ui = 0;
    if (!S.next(0, cur)) return;
    f32x4 acc[2][2][4][2];
    if constexpr (!(SP2 && Epi::FP8))
#pragma unroll
    for (int a = 0; a < 2; ++a)
#pragma unroll
        for (int b = 0; b < 2; ++b)
#pragma unroll
            for (int m = 0; m < 4; ++m)
#pragma unroll
                for (int n = 0; n < 2; ++n) acc[a][b][m][n] = (f32x4){0.f, 0.f, 0.f, 0.f};
    bf16x8 At[4][2], B0[2][2], B1[2][2];
    const char* cA = (const char*)g.A + (size_t)cur.pm * tstep + cur.kofs; const char* cB = (const char*)g.Bt + (size_t)cur.bn * tstep + cur.kofs;
    S.a_ready(cur);
    if constexpr (SP2) {
        PG8_STAGE(PG8_SB(0, 0), cB, voffB); PG8_STAGE(PG8_SB(0, 1), cB + hstepB, voffB); PG8_STAGE(PG8_SA(0, 0), cA, voffA); PG8_STAGE(PG8_SA(0, 1), cA + hstep, voffA);
        if (wr == 1) PG8_BAR;
        PG8_WAIT_V(2); PG8_BAR;
        PG8_STAGE(PG8_SB(1, 0), cB + kstep, voffB); PG8_STAGE(PG8_SA(1, 0), cA + kstep, voffA); PG8_STAGE(PG8_SB(1, 1), cB + hstepB + kstep, voffB);
        PG8_WAIT_V(6); PG8_BAR;
    } else {
        PG8_STAGE(PG8_SB(0, 0), cB, voffB); PG8_STAGE(PG8_SA(0, 0), cA, voffA); PG8_STAGE(PG8_SB(0, 1), cB + hstepB, voffB); PG8_STAGE(PG8_SA(0, 1), cA + hstep, voffA);
        if (wr == 1) PG8_BAR;
        PG8_WAIT_V(4); PG8_BAR;
        PG8_STAGE(PG8_SB(1, 0), cB + kstep, voffB); PG8_STAGE(PG8_SA(1, 0), cA + kstep, voffA); PG8_STAGE(PG8_SB(1, 1), cB + hstepB + kstep, voffB);
        PG8_WAIT_V(6); PG8_BAR;
    }
    for (;;) {
        const bool has_next = S.next(ui + 1, nxt);
        const char* nA = has_next ? (const char*)g.A + (size_t)nxt.pm * tstep + nxt.kofs : cA; const char* nB = has_next ? (const char*)g.Bt + (size_t)nxt.bn * tstep + nxt.kofs : cB;
#pragma unroll 1
        for (int t = 0; t < nt; t += 2) {
            const bool last = (t == nt - 2);
            const char* a1 = cA + (size_t)(t + 1) * kstep;
            const char* a2 = last ? nA : cA + (size_t)(t + 2) * kstep; const char* b2 = last ? nB : cB + (size_t)(t + 2) * kstep;
            const char* a3 = a2 + kstep; const char* b3 = b2 + kstep;
            if (last && has_next) S.a_ready(nxt);
            if constexpr (SP2) {
            PG8_LDB(B0, 0, 0); PG8_LDB(B1, 0, 1); PG8_SCHED; PG8_LDA(At, 0, 0); PG8_STAGE(PG8_SA(1, 1), a1 + hstep, voffA);
            PG8_WAIT_V(8); PG8_WAIT_L(0); PG8_BAR; if (Epi::FP8 && t == 0) { PG8_MMA0(0, 0, At, B0); PG8_MMA0(0, 1, At, B1); } else { PG8_MMA(0, 0, At, B0); PG8_MMA(0, 1, At, B1); } PG8_BAR; PG8_SCHED;
            PG8_LDA(At, 0, 1); PG8_STAGE(PG8_SB(0, 0), b2, voffB); PG8_STAGE(PG8_SB(0, 1), b2 + hstepB, voffB); PG8_STAGE(PG8_SA(0, 0), a2, voffA);
            PG8_WAIT_V(8); PG8_WAIT_L(0); PG8_BAR; if (Epi::FP8 && t == 0) { PG8_MMA0(1, 0, At, B0); PG8_MMA0(1, 1, At, B1); } else { PG8_MMA(1, 0, At, B0); PG8_MMA(1, 1, At, B1); } PG8_BAR; PG8_SCHED;
            PG8_LDB(B0, 1, 0); PG8_LDB(B1, 1, 1); PG8_SCHED; PG8_LDA(At, 1, 0); PG8_STAGE(PG8_SA(0, 1), a2 + hstep, voffA);
            PG8_WAIT_V(8); PG8_WAIT_L(0); PG8_BAR; PG8_MMA(0, 0, At, B0); PG8_MMA(0, 1, At, B1); PG8_BAR; PG8_SCHED;
            PG8_LDA(At, 1, 1); PG8_STAGE(PG8_SB(1, 0), b3, voffB); PG8_STAGE(PG8_SB(1, 1), b3 + hstepB, voffB); PG8_STAGE(PG8_SA(1, 0), a3, voffA);
            PG8_WAIT_V(8); PG8_WAIT_L(0); PG8_BAR; PG8_MMA(1, 0, At, B0); PG8_MMA(1, 1, At, B1); PG8_BAR; PG8_SCHED;
            } else {
            PG8_LDB(B0, 0, 0); PG8_SCHED; PG8_LDA(At, 0, 0); PG8_STAGE(PG8_SA(1, 1), a1 + hstep, voffA);
            PG8_WAIT_L(8); PG8_BAR; PG8_WAIT_L(0); PG8_MMA(0, 0, At, B0); PG8_BAR; PG8_SCHED;
            PG8_LDB(B1, 0, 1); PG8_STAGE(PG8_SB(0, 0), b2, voffB);
            PG8_BAR; PG8_WAIT_L(0); PG8_MMA(0, 1, At, B1); PG8_BAR;
            PG8_LDA(At, 0, 1); PG8_STAGE(PG8_SA(0, 0), a2, voffA);
            PG8_BAR; PG8_WAIT_L(0); PG8_MMA(1, 0, At, B0); PG8_BAR; PG8_SCHED;
            PG8_STAGE(PG8_SB(0, 1), b2 + hstepB, voffB);
            PG8_WAIT_V(6); PG8_BAR; PG8_MMA(1, 1, At, B1); PG8_BAR;
            PG8_LDB(B0, 1, 0); PG8_SCHED; PG8_LDA(At, 1, 0); PG8_STAGE(PG8_SA(0, 1), a2 + hstep, voffA);
            PG8_WAIT_L(8); PG8_BAR; PG8_WAIT_L(0); PG8_MMA(0, 0, At, B0); PG8_BAR; PG8_SCHED;
            PG8_LDB(B1, 1, 1); PG8_STAGE(PG8_SB(1, 0), b3, voffB);
            PG8_BAR; PG8_WAIT_L(0); PG8_MMA(0, 1, At, B1); PG8_BAR;
            PG8_LDA(At, 1, 1); PG8_STAGE(PG8_SA(1, 0), a3, voffA);
            PG8_BAR; PG8_WAIT_L(0); PG8_MMA(1, 0, At, B0); PG8_BAR; PG8_SCHED;
            PG8_STAGE(PG8_SB(1, 1), b3 + hstepB, voffB);
            PG8_WAIT_V(6); PG8_BAR; PG8_MMA(1, 1, At, B1); PG8_BAR;
            }
        }
        if constexpr (ALIGN_EPI) { if (wr == 0) PG8_BAR; }
        if constexpr (Epi::FP8) asm volatile("s_nop 15\n\ts_nop 15" ::: "memory");
        if constexpr (!Epi::AFTER_DRAIN) { E(acc, cur, wr, wc, fr, fq); if constexpr (EPI_TWICE && Epi::IDEMP) { asm volatile("" ::: "memory"); E(acc, cur, wr, wc, fr, fq); } S.done(cur); }
        if (!has_next) break;
        if constexpr (!(SP2 && Epi::FP8))
#pragma unroll
        for (int a = 0; a < 2; ++a)
#pragma unroll
            for (int b = 0; b < 2; ++b)
#pragma unroll
                for (int m = 0; m < 4; ++m)
#pragma unroll
                    for (int n = 0; n < 2; ++n) acc[a][b][m][n] = (f32x4){0.f, 0.f, 0.f, 0.f};
        cur = nxt; cA = nA; cB = nB; ++ui;
        if constexpr (ALIGN_EPI) { if (wr == 1) PG8_BAR; }
    }
    PG8_WAIT_V(0);
    if constexpr (!ALIGN_EPI) { if (wr == 0) PG8_BAR; }
    PG8_BAR;
    if constexpr (Epi::AFTER_DRAIN) { E.fused(acc, cur, wr, wc, fr, fq, lds, wid, lane); S.done(cur); }
#undef PG8_SA
#undef PG8_SB
#undef PG8_STAGE
#undef PG8_LDA
#undef PG8_LDB
#undef PG8_MMA
#undef PG8_MMA0
#undef PG8_WAIT_V
#undef PG8_WAIT_L
#undef PG8_BAR
#undef PG8_SCHED
}
}

constexpr int NWAVES = 8;
constexpr int BATCH = 32, SEQ = 2048, T = BATCH * SEQ, D = 1024, NPROJ = 2560, FF = 2816, NE = 8, DE = 3584, ADA = 6 * D;
constexpr float EPS = 1e-6f;
constexpr float C2 = 0.125f * 1.4426950408889634f;
constexpr int MAXTILES = 264;
constexpr size_t MiB = 1u << 20;
constexpr size_t WS_CTL = 0, CTL_ZERO_BYTES = 1 * MiB;
constexpr size_t WS_ADA = 1 * MiB;
constexpr size_t WS_G16 = 2560 * 1024;
constexpr size_t WS_PCNT = 3 * MiB;
constexpr size_t WS_TOKE = 4 * MiB, WS_TOKR = 5 * MiB, WS_TOKG = 6 * MiB;
constexpr size_t WS_SLOTT = 7 * MiB, WS_SLOTG = 3 * MiB + 256 * 1024;
constexpr size_t WS_WIN = 8 * MiB;
constexpr size_t WS_WOUT = 18 * MiB;
constexpr size_t WS_WGU = 22 * MiB;
constexpr size_t WS_WD = 33 * MiB;
constexpr size_t WS_GW = 39 * MiB;
constexpr size_t WS_MWGU = 40 * MiB;
constexpr size_t WS_MWD = 96 * MiB;
constexpr size_t WS_XB = 124 * MiB;
constexpr size_t WS_HB = 252 * MiB;
constexpr size_t WS_BIG = 380 * MiB;
constexpr size_t WS_ACT = WS_BIG;
constexpr size_t WS_XS = WS_BIG, WS_ACTM = WS_BIG + 132 * MiB;
constexpr size_t WS_END = 1024 * MiB;
static_assert(WS_ACTM + (size_t)2 * MAXTILES * 256 * DE <= WS_END && WS_XS + (size_t)2 * MAXTILES * 256 * D <= WS_ACTM && WS_ACT + (size_t)T * FF * 2 <= WS_END && WS_BIG + (size_t)T * NPROJ * 2 <= WS_END, "d_ws map");
static_assert(WS_SLOTG + (size_t)2 * MAXTILES * 256 * 4 <= WS_TOKE && WS_SLOTT + (size_t)2 * MAXTILES * 256 * 4 <= WS_WIN && WS_WD + (size_t)D * FF * 2 <= WS_GW && WS_MWGU + (size_t)NE * 2 * DE * D <= WS_MWD
              && WS_MWD + (size_t)NE * D * DE <= WS_XB && WS_XB + (size_t)T * D * 2 <= WS_HB && WS_HB + (size_t)T * D * 2 <= WS_BIG, "d_ws map");
constexpr int CW_TMO = 0, CW_CODE = 1, CW_BAR = 4096;
constexpr int RING_OFF = 0, RING_BYTES = 131072;
constexpr int LDSCTL_OFF = RING_BYTES, MISC_OFF = LDSCTL_OFF + 320, MOE_OFF = LDSCTL_OFF + 512;
constexpr int LDS_BYTES = 147456;
constexpr int MT_TOT = 0, MT_POFF = 8, MT_NT = 20, MT_PBASE = 24, MT_TILE = 32;
constexpr int MT_STRIDE = 128;
static_assert(MT_TILE * 4 + 272 <= MT_STRIDE * 4 && MOE_OFF + 2 * MT_STRIDE * 4 <= LDS_BYTES, "LDS map");

#define GAS __attribute__((address_space(1)))
#define LAS __attribute__((address_space(3)))
typedef unsigned short bf16;
typedef unsigned v4u __attribute__((ext_vector_type(4)));
typedef unsigned v2u __attribute__((ext_vector_type(2)));
typedef float f32x4 __attribute__((ext_vector_type(4)));
typedef GAS unsigned gu32;
#define RLX_AGENT __ATOMIC_RELAXED, __HIP_MEMORY_SCOPE_AGENT
#define LDS_WAIT() asm volatile("s_waitcnt lgkmcnt(0)" ::: "memory")
#define VM_WAIT() asm volatile("s_waitcnt vmcnt(0)" ::: "memory")
__device__ __forceinline__ unsigned f2bf(float f) { unsigned u = __builtin_bit_cast(unsigned, f); return (u + 0x7fffu + ((u >> 16) & 1u)) >> 16; }
__device__ __forceinline__ unsigned pk2(float lo, float hi) { return f2bf(lo) | (f2bf(hi) << 16); }
__device__ __forceinline__ float bflo(unsigned w) { return __builtin_bit_cast(float, w << 16); }
__device__ __forceinline__ float bfhi(unsigned w) { return __builtin_bit_cast(float, w & 0xffff0000u); }
template <int CTRL, int ROW_MASK>
__device__ __forceinline__ float dpp_f(float v) {
    return __builtin_bit_cast(float, __builtin_amdgcn_update_dpp(0, __builtin_bit_cast(int, v), CTRL, ROW_MASK, 0xf, false)); }
__device__ __forceinline__ float wave_sum(float v) {
    v += dpp_f<0xB1, 0xf>(v);
    v += dpp_f<0x4E, 0xf>(v);
    v += dpp_f<0x141, 0xf>(v);
    v += dpp_f<0x140, 0xf>(v);
    v += dpp_f<0x142, 0xa>(v);
    v += dpp_f<0x143, 0xc>(v);
    return __builtin_bit_cast(float, __builtin_amdgcn_readlane(__builtin_bit_cast(int, v), 63));
}

__device__ __forceinline__ int opaque_tid() { int t = threadIdx.x; asm volatile("" : "+v"(t)); return t; }
__device__ __forceinline__ unsigned char* opaque_ptr(unsigned char* p) { size_t z = 0; asm volatile("" : "+s"(z)); return p + z; }
__device__ __forceinline__ int opaque_i(int v) { asm volatile("" : "+s"(v)); return v; }
#define PHASE_IDS() const int tid = opaque_tid(), lane = tid & 63, wave = __builtin_amdgcn_readfirstlane(tid >> 6); (void)lane; (void)wave

#define XB_TMO      128
#define XB_XCNT(j)  (256  + 64 * (j))
#define XB_XSUB(j)  (1280 + 64 * (j))
#define XB_XGEN(j)  (2304 + 64 * (j))
#define XB_TOP      3328
#define XB_TOPGEN   3392
#define XCD_BAR_WORDS 3456
#define XB_SPIN_CAP (1u << 18)

__device__ __forceinline__ unsigned xb_ld(unsigned* p)              { return __hip_atomic_load(p, __ATOMIC_RELAXED, __HIP_MEMORY_SCOPE_AGENT); }
__device__ __forceinline__ unsigned xb_add(unsigned* p, unsigned v) { return __hip_atomic_fetch_add(p, v, __ATOMIC_RELAXED, __HIP_MEMORY_SCOPE_AGENT); }
__device__ __forceinline__ unsigned xb_xcc_id() { return (unsigned)__builtin_amdgcn_s_getreg((3 << 11) | 20) & 0xFu; }
#define XB_SPIN(cond, bar) do { unsigned _sp = 0; while (cond) { __builtin_amdgcn_s_sleep(1); \
    if ((++_sp & 255u) == 0u) { if (xb_ld(&(bar)[XB_TMO])) break; if (_sp > XB_SPIN_CAP) { atomicAdd(&(bar)[XB_TMO], 1u); break; } } } } while (0)

struct XcdBarrier {
    unsigned* bar; unsigned x;
    volatile LAS unsigned* st;
};

__device__ __forceinline__ XcdBarrier xcd_barrier_post(unsigned* bar, volatile LAS unsigned* st) {
    XcdBarrier b; b.bar = bar; b.x = xb_xcc_id(); b.st = st;
    if (threadIdx.x == 0) (void)xb_add(&bar[XB_XCNT(b.x)], 1u);
    return b;
}
__device__ __forceinline__ void xcd_barrier_complete(unsigned* bar, unsigned x, unsigned& nloc, unsigned& nx) {
    const unsigned G = gridDim.x * gridDim.y * gridDim.z;
    unsigned sum, cnt, mine, sp = 0u;
    for (;;) {
        sum = 0u; cnt = 0u; mine = 0u;
#pragma unroll
        for (unsigned j = 0; j < 16; ++j) { const unsigned c = xb_ld(&bar[XB_XCNT(j)]); sum += c; cnt += (c > 0u) ? 1u : 0u; mine = (j == x) ? c : mine; }
        if (sum == G) break;
        __builtin_amdgcn_s_sleep(1);
        if ((++sp & 255u) == 0u) { if (xb_ld(&bar[XB_TMO])) break; if (sp > XB_SPIN_CAP) { atomicAdd(&bar[XB_TMO], 1u); break; } }
    }
    nloc = mine > 0u ? mine : 1u; nx = cnt > 0u ? cnt : 1u;
}

__device__ __forceinline__ void xcd_barrier(const XcdBarrier& b) {
    asm volatile("s_waitcnt vmcnt(0)" ::: "memory");
    __syncthreads();
    if (threadIdx.x == 0) {
        unsigned* bar = b.bar;
        __builtin_amdgcn_s_waitcnt(0);
        unsigned nloc = b.st[0], nx = b.st[1];
        if (nloc == 0u) { xcd_barrier_complete(bar, b.x, nloc, nx); b.st[0] = nloc; b.st[1] = nx; }
        const unsigned old = xb_add(&bar[XB_XSUB(b.x)], 1u);
        const unsigned gen = old / nloc;
        if (old + 1u == (gen + 1u) * nloc) {
            __builtin_amdgcn_fence(__ATOMIC_RELEASE, "agent");
            asm volatile("s_waitcnt vmcnt(0)" ::: "memory");
            const unsigned og = xb_add(&bar[XB_TOP], 1u);
            const unsigned tg = og / nx;
            if (og + 1u == (tg + 1u) * nx) xb_add(&bar[XB_TOPGEN], 1u);
            else XB_SPIN(xb_ld(&bar[XB_TOPGEN]) == tg, bar);
            __builtin_amdgcn_fence(__ATOMIC_ACQUIRE, "agent");
            xb_add(&bar[XB_XGEN(b.x)], 1u);
            asm volatile("s_waitcnt vmcnt(0)" ::: "memory");
        } else {
            XB_SPIN(xb_ld(&bar[XB_XGEN(b.x)]) == gen, bar);
            __builtin_amdgcn_fence(__ATOMIC_ACQUIRE, "agent");
            asm volatile("s_waitcnt vmcnt(0)" ::: "memory");
        }
    }
    __syncthreads();
}

__device__ __forceinline__ void transpose_item(const float* W, int K, int N, bf16* WT, int mode, LAS float* scr, int item, int lane) {
    const int nblk = N / 32, kb = item / nblk, nb = item % nblk, k0 = 64 * kb, n0 = 32 * nb;
#pragma unroll 8
    for (int i = 0; i < 32; ++i) { const int kk = 2 * i + (lane >> 5); scr[kk * 33 + (lane & 31)] = W[(size_t)(k0 + kk) * N + n0 + (lane & 31)]; }
    LDS_WAIT(); asm volatile("" ::: "memory");
    const int c = lane & 7; const float wsc = (mode == 1) ? 1.4426950408889634f : (mode == 2) ? 0.6931471805599453f : 1.0f;
#pragma unroll
    for (int j = 0; j < 4; ++j) { const int n = (lane >> 3) + 8 * j; const LAS float* s = scr + (8 * c) * 33 + n;
        v4u o; o.x = pk2(s[0 * 33] * wsc, s[1 * 33] * wsc); o.y = pk2(s[2 * 33] * wsc, s[3 * 33] * wsc); o.z = pk2(s[4 * 33] * wsc, s[5 * 33] * wsc); o.w = pk2(s[6 * 33] * wsc, s[7 * 33] * wsc);
        const int nc = n0 + n; const int drow = (mode == 0) ? nc : (((nc >> 7) << 8) + ((mode == 2) ? 128 : 0) + (nc & 127));
        *(GAS v4u*)(WT + (size_t)drow * K + k0 + 8 * c) = o; }
    LDS_WAIT(); asm volatile("" ::: "memory");
}
__device__ __forceinline__ void transpose_item_f8(const float* W, int K, int N, unsigned char* WT, int mode, LAS float* scr, int item, int lane) {
    const int nblk = N / 32, kb = item / nblk, nb = item % nblk, k0 = 64 * kb, n0 = 32 * nb;
#pragma unroll 8
    for (int i = 0; i < 32; ++i) { const int kk = 2 * i + (lane >> 5); scr[kk * 33 + (lane & 31)] = W[(size_t)(k0 + kk) * N + n0 + (lane & 31)]; }
    LDS_WAIT(); asm volatile("" ::: "memory");
    const int c = lane & 7; const float wsc = (mode == 1) ? 1.4426950408889634f : (mode == 2) ? 0.6931471805599453f : 1.0f;
#pragma unroll
    for (int j = 0; j < 4; ++j) { const int n = (lane >> 3) + 8 * j; const LAS float* s = scr + (8 * c) * 33 + n;
        v2u o; o.x = pg8::pk4_fp8((f32x4){s[0 * 33], s[1 * 33], s[2 * 33], s[3 * 33]} * (32.0f * wsc)); o.y = pg8::pk4_fp8((f32x4){s[4 * 33], s[5 * 33], s[6 * 33], s[7 * 33]} * (32.0f * wsc));
        const int nc = n0 + n; const int drow = (mode == 0) ? nc : (((nc >> 7) << 8) + ((mode == 2) ? 128 : 0) + (nc & 127));
        *(GAS v2u*)(WT + (size_t)drow * K + k0 + 8 * c) = o; }
    LDS_WAIT(); asm volatile("" ::: "memory");
}
struct Args { const float* in[22]; float* out; unsigned char* ws; };
__device__ __forceinline__ void p0_transposes(const Args& P, LAS unsigned char* lds, int blk, int G) {
    PHASE_IDS();
    LAS float* scr = (LAS float*)(lds + RING_OFF + wave * 16384);
    const int gw = blk * NWAVES + wave, NGW = G * NWAVES;
    bf16* Win_t = (bf16*)(P.ws + WS_WIN); bf16* Wout_t = (bf16*)(P.ws + WS_WOUT); bf16* Wgu_t = (bf16*)(P.ws + WS_WGU); bf16* Wd_t = (bf16*)(P.ws + WS_WD);
    unsigned char* MWgu8 = P.ws + WS_MWGU; unsigned char* MWd8 = P.ws + WS_MWD;
    constexpr int I_IN = (D / 64) * (NPROJ / 32), I_OUT = (D / 64) * (D / 32), I_GU = (D / 64) * (FF / 32), I_DN = (FF / 64) * (D / 32), I_MGU = (D / 64) * (DE / 32), I_MDN = (DE / 64) * (D / 32);
    constexpr int NITEMS = 2 * I_IN + 2 * I_OUT + 2 * I_GU + I_DN + 16 * I_MGU + 8 * I_MDN;
    for (int it = gw; it < NITEMS; it += NGW) {
        int r = it;
        if (r < 2 * I_IN) { const int l = r / I_IN; transpose_item(P.in[6] + (size_t)l * D * NPROJ, D, NPROJ, Win_t + (size_t)l * NPROJ * D, 0, scr, r % I_IN, lane); continue; } r -= 2 * I_IN;
        if (r < 2 * I_OUT) { const int l = r / I_OUT; transpose_item(P.in[13] + (size_t)l * D * D, D, D, Wout_t + (size_t)l * D * D, 0, scr, r % I_OUT, lane); continue; } r -= 2 * I_OUT;
#ifdef FFN_FP8
        if (r < I_GU) { transpose_item_f8(P.in[14], D, FF, (unsigned char*)Wgu_t, 1, scr, r, lane); continue; } r -= I_GU;
        if (r < I_GU) { transpose_item_f8(P.in[15], D, FF, (unsigned char*)Wgu_t, 2, scr, r, lane); continue; } r -= I_GU;
        if (r < I_DN) { transpose_item_f8(P.in[16], FF, D, (unsigned char*)Wd_t, 0, scr, r, lane); continue; } r -= I_DN;
#else
#if FFN_GU_FP8
        if (r < I_GU) { transpose_item_f8(P.in[14], D, FF, (unsigned char*)Wgu_t, 1, scr, r, lane); continue; } r -= I_GU;
        if (r < I_GU) { transpose_item_f8(P.in[15], D, FF, (unsigned char*)Wgu_t, 2, scr, r, lane); continue; } r -= I_GU;
#else
        if (r < I_GU) { transpose_item(P.in[14], D, FF, Wgu_t, 1, scr, r, lane); continue; } r -= I_GU;
        if (r < I_GU) { transpose_item(P.in[15], D, FF, Wgu_t, 2, scr, r, lane); continue; } r -= I_GU;
#endif
#if FFN_DOWN_FP8
        if (r < I_DN) { transpose_item_f8(P.in[16], FF, D, (unsigned char*)Wd_t, 0, scr, r, lane); continue; } r -= I_DN;
#else
        if (r < I_DN) { transpose_item(P.in[16], FF, D, Wd_t, 0, scr, r, lane); continue; } r -= I_DN;
#endif
#endif
        if (r < 8 * I_MGU) { const int e = r / I_MGU; transpose_item_f8(P.in[19] + (size_t)e * D * DE, D, DE, MWgu8 + (size_t)e * 2 * DE * D, 1, scr, r % I_MGU, lane); continue; } r -= 8 * I_MGU;
        if (r < 8 * I_MGU) { const int e = r / I_MGU; transpose_item_f8(P.in[20] + (size_t)e * D * DE, D, DE, MWgu8 + (size_t)e * 2 * DE * D, 2, scr, r % I_MGU, lane); continue; } r -= 8 * I_MGU;
        { const int e = r / I_MDN; transpose_item_f8(P.in[21] + (size_t)e * DE * D, DE, D, MWd8 + (size_t)e * D * DE, 0, scr, r % I_MDN, lane); }
    }
}
__device__ __forceinline__ void p0_ada(const Args& P, LAS unsigned char* lds, int blk, int G) {
    PHASE_IDS();
    LAS float* ca = (LAS float*)(lds + RING_OFF);
    const float* c = P.in[1]; const float* ada_w = P.in[2]; const float* ada_b = P.in[3]; float* ada = (float*)(P.ws + WS_ADA);
    for (int u = blk; u < 192; u += G) {
        const int l = u / 96, col0 = (u % 96) * 64;
        __syncthreads();
        for (int idx = tid; idx < 32768; idx += NWAVES * 64) { const int b = idx & 31, k = idx >> 5; const float v = c[b * 1024 + k]; ca[idx] = v / (1.0f + expf(-v)); }
        __syncthreads();
        float acc[32];
#pragma unroll
        for (int b = 0; b < 32; ++b) acc[b] = 0.f;
        const float* wp = ada_w + ((size_t)l * 1024 + wave * 128) * ADA + col0 + lane;
        for (int kk = 0; kk < 128; ++kk) { const float wv = wp[(size_t)kk * ADA]; const LAS f32x4* cp = (const LAS f32x4*)(ca + (wave * 128 + kk) * 32);
#pragma unroll
            for (int q = 0; q < 8; ++q) { const f32x4 cv = cp[q]; acc[4 * q] += cv.x * wv; acc[4 * q + 1] += cv.y * wv; acc[4 * q + 2] += cv.z * wv; acc[4 * q + 3] += cv.w * wv; } }
        __syncthreads();
#pragma unroll
        for (int b = 0; b < 32; ++b) ca[(wave * 32 + b) * 64 + lane] = acc[b];
        __syncthreads();
#pragma unroll
        for (int o = 0; o < 4; ++o) { const int idx = tid + 512 * o, b = idx >> 6, ln = idx & 63; float s = 0.f;
#pragma unroll
            for (int w = 0; w < 8; ++w) s += ca[(w * 32 + b) * 64 + ln];
            const float av = s + ada_b[l * ADA + col0 + ln];
            ada[((size_t)l * 32 + b) * ADA + col0 + ln] = av;
            if (l == 1 && col0 >= 5 * D) ((bf16*)(P.ws + WS_G16))[b * D + col0 + ln - 5 * D] = (bf16)f2bf(av); }
    }
    __syncthreads();
}
template <bool ROUTE, bool OUT8 = false, bool XBF = false>
__device__ __forceinline__ void norm_phase(const float* xsrc, const float* gvec, const float* ada_l, int sc_off, int sh_off, bf16* HB,
                                           const float* rw, const float* rb, int* pcnt, int* tok_e, int* tok_rank, float* tok_gate,
                                           LAS unsigned char* lds, int blk, int G) {
    PHASE_IDS();
    LAS int* pe = (LAS int*)(lds + RING_OFF); LAS float* pg = (LAS float*)(lds + RING_OFF + 2048); LAS int* wcnt = (LAS int*)(lds + RING_OFF + 4096);
    const LAS f32x4* rwl = (const LAS f32x4*)(lds + RING_OFF + 8192);
    f32x4 rwr[16];
    if constexpr (ROUTE) {
#pragma unroll
        for (int j = 0; j < 4; ++j)
#pragma unroll
            for (int i = 0; i < 4; ++i) rwr[j * 4 + i] = *(const GAS f32x4*)(rw + (size_t)(256 * j + 4 * lane + i) * 8);
        LAS float* wl = (LAS float*)(lds + RING_OFF + 8192);
        for (int idx = tid; idx < D * 8; idx += NWAVES * 64) { const int col = idx >> 3, e = idx & 7; wl[((((col >> 8) * 4 + (col & 3)) * 2 + (e >> 2)) * 64 + ((col & 255) >> 2)) * 4 + (e & 3)] = rw[idx]; }
        __syncthreads();
    }
    for (int p = blk; p < T / 256; p += G) {
        const int b = p >> 3;
        f32x4 mod[4], sh[4];
#pragma unroll
        for (int j = 0; j < 4; ++j) { const int col = 4 * lane + 256 * j; const f32x4 g4 = *(const f32x4*)(gvec + col); const f32x4 sc4 = *(const f32x4*)(ada_l + (size_t)b * ADA + sc_off + col);
            sh[j] = *(const f32x4*)(ada_l + (size_t)b * ADA + sh_off + col); mod[j] = g4 * (1.0f + sc4); }
        float rbv[8];
        if constexpr (ROUTE) {
#pragma unroll
            for (int e = 0; e < 8; ++e) rbv[e] = rb[e];
        }
#define NROW_(rr_) ((((rr_) >> 1) << 4) + wave * 2 + ((rr_) & 1))
        constexpr int NAH = 4;
        f32x4 vbx[NAH][4]; v2u vbb[NAH][4];
#pragma unroll
        for (int q = 0; q < NAH; ++q) {
            if constexpr (XBF) { const GAS v2u* xr0 = (const GAS v2u*)((const bf16*)xsrc + (size_t)(p * 256 + NROW_(q)) * D) + lane;
#pragma unroll
              for (int j = 0; j < 4; ++j) vbb[q][j] = xr0[64 * j]; }
            else { const GAS f32x4* xr0 = (const GAS f32x4*)(xsrc + (size_t)(p * 256 + NROW_(q)) * D) + lane;
#pragma unroll
              for (int j = 0; j < 4; ++j) vbx[q][j] = xr0[64 * j]; } }
        for (int rr0 = 0; rr0 < 32; rr0 += NAH)
#pragma unroll
        for (int q = 0; q < NAH; ++q) {
            const int rr = rr0 + q;
            const int row = p * 256 + NROW_(rr);
            f32x4 v[4]; float ss = 0.f;
#pragma unroll
            for (int j = 0; j < 4; ++j) { if constexpr (XBF) v[j] = (f32x4){bflo(vbb[q][j].x), bfhi(vbb[q][j].x), bflo(vbb[q][j].y), bfhi(vbb[q][j].y)}; else v[j] = vbx[q][j]; }
            if (rr + NAH < 32) {
                if constexpr (XBF) { const GAS v2u* xr = (const GAS v2u*)((const bf16*)xsrc + (size_t)(p * 256 + NROW_(rr + NAH)) * D) + lane;
#pragma unroll
                    for (int j = 0; j < 4; ++j) vbb[q][j] = xr[64 * j]; }
                else { const GAS f32x4* xr = (const GAS f32x4*)(xsrc + (size_t)(p * 256 + NROW_(rr + NAH)) * D) + lane;
#pragma unroll
                    for (int j = 0; j < 4; ++j) vbx[q][j] = xr[64 * j]; } }
#pragma unroll
            for (int j = 0; j < 4; ++j) ss += (v[j].x * v[j].x + v[j].y * v[j].y) + (v[j].z * v[j].z + v[j].w * v[j].w);
            const float rs = 1.0f / sqrtf(wave_sum(ss) * (1.0f / D) + EPS);
            GAS unsigned long long* o8 = (GAS unsigned long long*)(HB + (size_t)row * D) + lane;
#pragma unroll
            for (int j = 0; j < 4; ++j) { v[j] = v[j] * rs * mod[j] + sh[j];
                if constexpr (OUT8) *(GAS unsigned*)((unsigned char*)HB + (size_t)row * D + 4 * lane + 256 * j) = pg8::pk4_fp8(v[j]);
                else o8[64 * j] = (unsigned long long)pk2(v[j].x, v[j].y) | ((unsigned long long)pk2(v[j].z, v[j].w) << 32); }
            if constexpr (ROUTE) {
                float lg[8];
#pragma unroll
                for (int e = 0; e < 8; ++e) lg[e] = 0.f;
#pragma unroll
                for (int j = 0; j < 4; ++j)
#pragma unroll
                    for (int i = 0; i < 4; ++i) { const float y = v[j][i]; const f32x4 r0 = rwr[j * 4 + i], r1 = rwl[((j * 4 + i) * 2 + 1) * 64 + lane];
#pragma unroll
                        for (int e = 0; e < 4; ++e) { lg[e] += y * r0[e]; lg[4 + e] += y * r1[e]; } }
#pragma unroll
                for (int e = 0; e < 8; ++e) lg[e] = wave_sum(lg[e]) + rbv[e];
                int e1 = 0; float l1 = lg[0];
#pragma unroll
                for (int e = 1; e < 8; ++e) if (lg[e] > l1) { l1 = lg[e]; e1 = e; }
                int e2 = 0; float l2 = -INFINITY;
#pragma unroll
                for (int e = 0; e < 8; ++e) if (e != e1 && lg[e] > l2) { l2 = lg[e]; e2 = e; }
                const float g1 = 1.0f / (1.0f + expf(l2 - l1));
                if (lane == 0) { const int i = NROW_(rr); pe[i] = e1; pe[256 + i] = e2; pg[i] = g1; pg[256 + i] = 1.0f - g1; }
            }
        }
        if constexpr (ROUTE) {
            __syncthreads();
            int lr[2] = {0, 0};
            if (tid < 256) {
#pragma unroll
                for (int k = 0; k < 2; ++k) { const int e = pe[k * 256 + tid];
#pragma unroll
                    for (int ee = 0; ee < 8; ++ee) { const unsigned long long m = __ballot(e == ee); if (e == ee) lr[k] = __popcll(m & ((1ull << lane) - 1ull)); if (lane == 0) wcnt[(k * 4 + wave) * 8 + ee] = __popcll(m); } }
            }
            __syncthreads();
            if (tid < 256) { const int t = p * 256 + tid;
#pragma unroll
                for (int k = 0; k < 2; ++k) { const int e = pe[k * 256 + tid]; int base = 0;
#pragma unroll
                    for (int w2 = 0; w2 < 4; ++w2) if (w2 < wave) base += wcnt[(k * 4 + w2) * 8 + e];
                    tok_e[t * 2 + k] = e; tok_rank[t * 2 + k] = base + lr[k]; tok_gate[t * 2 + k] = pg[k * 256 + tid]; } }
            if (tid < 16) { const int k = tid >> 3, ee = tid & 7; pcnt[p * 16 + tid] = wcnt[(k * 4 + 0) * 8 + ee] + wcnt[(k * 4 + 1) * 8 + ee] + wcnt[(k * 4 + 2) * 8 + ee] + wcnt[(k * 4 + 3) * 8 + ee]; }
            __syncthreads();
        }
    }
}
__device__ __forceinline__ void qknorm_phase(bf16* PROJ, const float* qg, const float* kg, int blk, int G) {
    PHASE_IDS();
    const int gw = blk * NWAVES + wave, NGW = G * NWAVES;
    float gq[8], gk[8];
#pragma unroll
    for (int i = 0; i < 8; ++i) { gq[i] = qg[(lane & 7) * 8 + i] * C2; gk[i] = kg[(lane & 7) * 8 + i]; }
    for (int it = gw; it < 2 * T; it += NGW) {
        const int row = it >> 1, which = it & 1;
        GAS v4u* p = (GAS v4u*)(PROJ + (size_t)row * NPROJ + which * 512 + lane * 8);
        const v4u raw = *p; float v[8];
#pragma unroll
        for (int i = 0; i < 4; ++i) { v[2 * i] = bflo(raw[i]); v[2 * i + 1] = bfhi(raw[i]); }
        float ss = 0.f;
#pragma unroll
        for (int i = 0; i < 8; ++i) ss += v[i] * v[i];
        ss += __shfl_xor(ss, 1); ss += __shfl_xor(ss, 2); ss += __shfl_xor(ss, 4);
        const float rs = 1.0f / sqrtf(ss * (1.0f / 64.0f) + EPS);
        v4u o;
#pragma unroll
        for (int i = 0; i < 4; ++i) { const float a = v[2 * i] * rs * (which ? gk[2 * i] : gq[2 * i]), c = v[2 * i + 1] * rs * (which ? gk[2 * i + 1] : gq[2 * i + 1]); o[i] = pk2(a, c); }
        *p = o;
    }
}
__device__ __forceinline__ void attn_simple(const bf16* PROJ, bf16* MIX, LAS unsigned char* lds, int blk, int G) {
    PHASE_IDS();
    LAS float* Ks = (LAS float*)(lds + RING_OFF); LAS float* Vs = Ks + 64 * 64;
    for (int i = 0;; ++i) {
        const int u = i * G + blk; if (u >= BATCH * 8 * 4) break;
        const int bh = u >> 2, qb = ((u & 3) + i) & 3, b = bh >> 3, h = bh & 7;
        const int tq = qb * 512 + tid; const size_t rowq = (size_t)b * SEQ + tq;
        float q[64], o[64];
        { const GAS v4u* qp = (const GAS v4u*)(PROJ + rowq * NPROJ + h * 64);
#pragma unroll
          for (int c = 0; c < 8; ++c) { const v4u w = qp[c];
#pragma unroll
              for (int e = 0; e < 4; ++e) { q[8 * c + 2 * e] = bflo(w[e]); q[8 * c + 2 * e + 1] = bfhi(w[e]); } } }
#pragma unroll
        for (int d = 0; d < 64; ++d) o[d] = 0.f;
        float carry = 0.f;
        const int wq_max = qb * 512 + wave * 64 + 63;
        for (int kt = (qb * 512 + 511) >> 6; kt >= 0; --kt) {
            __syncthreads();
            { const size_t krow = (size_t)b * SEQ + kt * 64 + (tid >> 3); const int d8 = (tid & 7) * 8;
              const v4u kr = *(const GAS v4u*)(PROJ + krow * NPROJ + 512 + h * 64 + d8); const v4u vr = *(const GAS v4u*)(PROJ + krow * NPROJ + 1024 + h * 64 + d8);
              LAS float* kd = Ks + (tid >> 3) * 64 + d8; LAS float* vd = Vs + (tid >> 3) * 64 + d8;
#pragma unroll
              for (int e = 0; e < 4; ++e) { kd[2 * e] = bflo(kr[e]); kd[2 * e + 1] = bfhi(kr[e]); vd[2 * e] = bflo(vr[e]); vd[2 * e + 1] = bfhi(vr[e]); } }
            __syncthreads();
            if (kt * 64 < wq_max) {
                for (int j = 63; j >= 0; --j) {
                    const int key = kt * 64 + j;
                    const LAS f32x4* kp = (const LAS f32x4*)(Ks + j * 64); float z = 0.f;
#pragma unroll
                    for (int d4 = 0; d4 < 16; ++d4) { const f32x4 kv = kp[d4]; z += q[4 * d4] * kv.x + q[4 * d4 + 1] * kv.y + q[4 * d4 + 2] * kv.z + q[4 * d4 + 3] * kv.w; }
                    const bool valid = key < tq;
                    const float sp = fmaxf(z, 0.f) + __builtin_amdgcn_logf(1.0f + __builtin_amdgcn_exp2f(-fabsf(z)));
                    const float L = valid ? -sp : 0.f;
                    const float w = valid ? __builtin_amdgcn_exp2f(z + L + carry) : 0.f;
                    carry += L;
                    const LAS f32x4* vp = (const LAS f32x4*)(Vs + j * 64);
#pragma unroll
                    for (int d4 = 0; d4 < 16; ++d4) { const f32x4 vv = vp[d4]; o[4 * d4] += w * vv.x; o[4 * d4 + 1] += w * vv.y; o[4 * d4 + 2] += w * vv.z; o[4 * d4 + 3] += w * vv.w; }
                }
            }
        }
        { GAS v4u* op = (GAS v4u*)(MIX + rowq * D + h * 64);
#pragma unroll
          for (int c = 0; c < 8; ++c) { v4u w;
#pragma unroll
              for (int e = 0; e < 4; ++e) w[e] = pk2(o[8 * c + 2 * e], o[8 * c + 2 * e + 1]);
              op[c] = w; } }
    }
    __syncthreads();
}
namespace sba {
typedef _Float16 f16x8 __attribute__((ext_vector_type(8)));
typedef _Float16 f16x2 __attribute__((ext_vector_type(2)));
typedef short bf16x8 __attribute__((ext_vector_type(8)));
typedef short s16x4 __attribute__((ext_vector_type(4)));
typedef float f32x16 __attribute__((ext_vector_type(16)));
typedef float f32x2_t __attribute__((ext_vector_type(2)));
typedef __bf16 bf16x2_t __attribute__((ext_vector_type(2)));
typedef unsigned u32x4 __attribute__((ext_vector_type(4)));
constexpr int SLOTB = 8192, NSLOT = 5, LDS_K = 0, LDS_V = NSLOT * SLOTB, LDS_BYTES_ATT = 2 * NSLOT * SLOTB;
constexpr float SBA_DEAD = -160.0f;
__device__ __forceinline__ int crow(int r, int hi) { return (r & 3) + 8 * (r >> 2) + 4 * hi; }
__device__ __forceinline__ unsigned cvtpk_bf16(float lo, float hi) { f32x2_t v = {lo, hi}; bf16x2_t b = __builtin_convertvector(v, bf16x2_t); return __builtin_bit_cast(unsigned, b); }
__device__ __forceinline__ unsigned cvtpk_f16(float lo, float hi) { f32x2_t v = {lo, hi}; f16x2 b = __builtin_convertvector(v, f16x2); return __builtin_bit_cast(unsigned, b); }
__device__ __forceinline__ s16x4 vtr(const LAS unsigned char* p) { return __builtin_bit_cast(s16x4, __builtin_amdgcn_ds_read_tr16_b64_v4i16((LAS s16x4*)p)); }

template <int MODE>
__device__ __forceinline__ void tile64(f32x16 (&oT)[2], float& carry, const bf16x8 (&qr)[4], const f16x8 (&tri)[2], const LAS unsigned char* Kslot, const LAS unsigned char* Vslot, int r32, int hi, int lane) {
    constexpr bool HAS1 = (MODE != 2), DIAG1 = (MODE == 1), DIAG0 = (MODE == 2);
    f32x16 z1, z0;
#pragma unroll
    for (int i = 0; i < 16; ++i) { z1[i] = 0.f; z0[i] = 0.f; }
#pragma unroll
    for (int d0 = 0; d0 < 4; ++d0) { const LAS unsigned char* kp = Kslot + (2 * d0 + hi) * 1024 + r32 * 16;
        if (HAS1) { const bf16x8 kf1 = *(const LAS bf16x8*)(kp + 512); z1 = __builtin_amdgcn_mfma_f32_32x32x16_bf16(kf1, qr[d0], z1, 0, 0, 0); }
        const bf16x8 kf0 = *(const LAS bf16x8*)kp; z0 = __builtin_amdgcn_mfma_f32_32x32x16_bf16(kf0, qr[d0], z0, 0, 0, 0); }
    float lg1[16], lg0[16];
#pragma unroll
    for (int i = 0; i < 16; ++i) {
        if (HAS1) { z1[i] = __builtin_amdgcn_fmed3f(z1[i], -3.0e38f, 126.0f); lg1[i] = __builtin_amdgcn_logf(1.0f + __builtin_amdgcn_exp2f(z1[i]));
            if (DIAG1) { const bool valid = crow(i, hi) < r32; lg1[i] = valid ? lg1[i] : 0.f; z1[i] = valid ? z1[i] : -1.0e30f; } }
        z0[i] = __builtin_amdgcn_fmed3f(z0[i], -3.0e38f, 126.0f); lg0[i] = __builtin_amdgcn_logf(1.0f + __builtin_amdgcn_exp2f(z0[i]));
        if (DIAG0) { const bool valid = crow(i, hi) < r32; lg0[i] = valid ? lg0[i] : 0.f; z0[i] = valid ? z0[i] : -1.0e30f; } }
    const float z1r0 = z1[0], z0r0 = z0[0];
    f32x16 D1 = z1, D0 = z0;
#pragma unroll
    for (int s = 0; s < 2; ++s) {
        if (HAS1) { u32x4 w;
#pragma unroll
            for (int j = 0; j < 4; ++j) w[j] = cvtpk_f16(lg1[8 * s + 2 * j], lg1[8 * s + 2 * j + 1]);
            D1 = __builtin_amdgcn_mfma_f32_32x32x16_f16(tri[s], __builtin_bit_cast(f16x8, w), D1, 0, 0, 0); }
        { u32x4 w;
#pragma unroll
            for (int j = 0; j < 4; ++j) w[j] = cvtpk_f16(lg0[8 * s + 2 * j], lg0[8 * s + 2 * j + 1]);
            D0 = __builtin_amdgcn_mfma_f32_32x32x16_f16(tri[s], __builtin_bit_cast(f16x8, w), D0, 0, 0, 0); } }
    float c0 = carry;
    if (HAS1) { const float t1 = D1[0] - z1r0; const auto rr = __builtin_amdgcn_permlane32_swap(__float_as_uint(t1), __float_as_uint(t1), false, false); c0 = carry + __uint_as_float(rr[0]); }
    const float t0 = D0[0] - z0r0; const auto rr0 = __builtin_amdgcn_permlane32_swap(__float_as_uint(t0), __float_as_uint(t0), false, false);
    float P1[16], P0[16];
#pragma unroll
    for (int i = 0; i < 16; ++i) { if (HAS1) P1[i] = __builtin_amdgcn_exp2f(D1[i] + carry); P0[i] = __builtin_amdgcn_exp2f(D0[i] + c0); }
    carry = c0 + __uint_as_float(rr0[0]);
#pragma unroll
    for (int ks = 3; ks >= 0; --ks) {
        if (ks >= 2 && !HAS1) continue;
        u32x4 w;
#pragma unroll
        for (int j = 0; j < 4; ++j) { const int e = 8 * (ks & 1) + 2 * j; w[j] = (ks >= 2) ? cvtpk_bf16(P1[e], P1[e + 1]) : cvtpk_bf16(P0[e], P0[e + 1]); }
        const bf16x8 pf = __builtin_bit_cast(bf16x8, w);
#pragma unroll
        for (int d0 = 0; d0 < 2; ++d0) { const LAS unsigned char* vp = Vslot + d0 * 4096 + ks * 1024 + ((lane >> 4) & 1) * 32 + (lane & 3) * 8 + (4 * hi + ((lane & 15) >> 2)) * 64;
            const s16x4 lo = vtr(vp), hh = vtr(vp + 512);
            const bf16x8 vf = (bf16x8){lo[0], lo[1], lo[2], lo[3], hh[0], hh[1], hh[2], hh[3]};
            oT[d0] = __builtin_amdgcn_mfma_f32_32x32x16_bf16(vf, pf, oT[d0], 0, 0, 0); } }
}
__device__ __forceinline__ void glds16(const void* gsrc, unsigned lds_dst) { unsigned keep;
    asm volatile("s_mov_b32 %0, m0\n\ts_mov_b32 m0, %2\n\ts_nop 0\n\tglobal_load_lds_dwordx4 %1, off\n\ts_mov_b32 m0, %0" : "=&s"(keep) : "v"(gsrc), "s"(lds_dst) : "memory"); }
#define SBA_DMA(t_, sl_) do { \
    glds16(ksrc + (size_t)(t_) * 64 * NPROJ, (unsigned)__builtin_amdgcn_readfirstlane(lds0 + LDS_K + (sl_) * SLOTB + wave * 1024)); \
    glds16(vsrc + (size_t)(t_) * 64 * NPROJ, (unsigned)__builtin_amdgcn_readfirstlane(lds0 + LDS_V + (sl_) * SLOTB + wave * 1024)); } while (0)
__device__ __forceinline__ void attn_phase(const bf16* PROJ, bf16* MIX, LAS unsigned char* lds, int blk, int G) {
    PHASE_IDS();
    const int r32 = lane & 31, hi = lane >> 5;
    const unsigned lds0 = (unsigned)(uintptr_t)lds;
    LAS unsigned* flg = (LAS unsigned*)(lds + LDS_BYTES_ATT);
    f16x8 tri[2];
#pragma unroll
    for (int s = 0; s < 2; ++s)
#pragma unroll
        for (int j = 0; j < 8; ++j) tri[s][j] = (16 * s + 8 * (j >> 2) + 4 * hi + (j & 3) >= r32) ? (_Float16)(-1.0f) : (_Float16)0.0f;
    int s0 = 0, s1 = 1, s2 = 2;
    int p0 = 3, p1 = 4;
    for (int bh = blk; bh < BATCH * 8; bh += G) {
        const int b = bh >> 3, h = bh & 7;
        const bf16* Kh = PROJ + (size_t)b * SEQ * NPROJ + 512 + h * 64; const bf16* Vh = PROJ + (size_t)b * SEQ * NPROJ + 1024 + h * 64;
        const bf16* ksrc = Kh + (size_t)lane * NPROJ + wave * 8;
        const bf16* vsrc = Vh + (size_t)(16 * (wave & 3) + (lane >> 2)) * NPROJ + (wave >> 2) * 32 + (lane & 3) * 8;
        SBA_DMA(3, s0); SBA_DMA(2, s1);
        bf16x8 qr[4], qn[4];
        { const bf16* qp = PROJ + ((size_t)b * SEQ + wave * 32 + r32) * NPROJ + h * 64 + hi * 8;
#pragma unroll
          for (int d0 = 0; d0 < 4; ++d0) qr[d0] = *(const GAS bf16x8*)(qp + d0 * 16); }
        asm volatile("" : "+v"(qr[0]), "+v"(qr[1]), "+v"(qr[2]), "+v"(qr[3]));
        for (int qb = 0; qb < SEQ / 256; ++qb) {
            const int q0w = qb * 256 + wave * 32, NT = 4 * (qb + 1);
            f32x16 oT[2];
#pragma unroll
            for (int i = 0; i < 16; ++i) { oT[0][i] = 0.f; oT[1][i] = 0.f; }
            float carry = 0.f;
            bool mydone = false;
            for (int t = NT - 1; t >= 0; --t) {
                if (t == NT - 1 && qb > 0) asm volatile("s_waitcnt lgkmcnt(0)\n\ts_barrier" ::: "memory");
                else if (t >= 1) asm volatile("s_waitcnt vmcnt(2) lgkmcnt(0)\n\ts_barrier" ::: "memory"); else asm volatile("s_waitcnt vmcnt(0) lgkmcnt(0)\n\ts_barrier" ::: "memory");
                if (t < NT - 1) { const LAS u32x4* fp = (const LAS u32x4*)(flg + ((t + 1) & 1) * 8); const u32x4 fa = fp[0], fb = fp[1];
                    const unsigned all8 = (fa.x & fa.y & fa.z & fa.w) & (fb.x & fb.y & fb.z & fb.w);
                    if (__builtin_amdgcn_readfirstlane((int)all8) != 0) break; }
                if (t == NT - 1 && qb + 1 < SEQ / 256) {
                    SBA_DMA(NT + 3, p0); SBA_DMA(NT + 2, p1);
                    const bf16* qp = PROJ + ((size_t)b * SEQ + q0w + 256 + r32) * NPROJ + h * 64 + hi * 8;
#pragma unroll
                    for (int d0 = 0; d0 < 4; ++d0) qn[d0] = *(const GAS bf16x8*)(qp + d0 * 16); }
                if (t >= 2) SBA_DMA(t - 2, s2);
                const LAS unsigned char* Kslot = lds + LDS_K + s0 * SLOTB; const LAS unsigned char* Vslot = lds + LDS_V + s0 * SLOTB;
                const int khi = 64 * t + 32;
                if (!mydone) {
                    if (khi < q0w) tile64<0>(oT, carry, qr, tri, Kslot, Vslot, r32, hi, lane);
                    else if (khi == q0w) tile64<1>(oT, carry, qr, tri, Kslot, Vslot, r32, hi, lane);
                    else if (khi == q0w + 32) tile64<2>(oT, carry, qr, tri, Kslot, Vslot, r32, hi, lane);
                    mydone = __all(carry < SBA_DEAD) != 0;
                }
                if (lane == 0) flg[(t & 1) * 8 + wave] = mydone ? 1u : 0u;
                { const int tmp = s0; s0 = s1; s1 = s2; s2 = tmp; }
            }
            { bf16* op = MIX + ((size_t)b * SEQ + q0w + r32) * D + h * 64 + 4 * hi;
#pragma unroll
              for (int d0 = 0; d0 < 2; ++d0)
#pragma unroll
                  for (int g = 0; g < 4; ++g) { v2u w; w.x = cvtpk_bf16(oT[d0][4 * g], oT[d0][4 * g + 1]); w.y = cvtpk_bf16(oT[d0][4 * g + 2], oT[d0][4 * g + 3]);
                      *(GAS v2u*)(op + 32 * d0 + 8 * g) = w; } }
            if (qb + 1 < SEQ / 256) {
                asm volatile("" : "+v"(qn[0]), "+v"(qn[1]), "+v"(qn[2]), "+v"(qn[3]));
#pragma unroll
                for (int d0 = 0; d0 < 4; ++d0) qr[d0] = qn[d0];
                const int o0 = s0, o1 = s1; s0 = p0; s1 = p1; p0 = o0; p1 = o1;
            }
        }
    }
    asm volatile("s_waitcnt vmcnt(0) lgkmcnt(0)" ::: "memory");
    __syncthreads();
}
#undef SBA_DMA
}
__device__ __forceinline__ void gmlp_simple(const bf16* PROJ, bf16* MIX, const float* lng, const float* lnb, const float* Wsp, const float* bsp,
                                            LAS unsigned char* lds, int blk, int G) {
    PHASE_IDS();
    LAS float* stats = (LAS float*)(lds + RING_OFF); LAS float* vln = stats + 256; LAS float* Wt = vln + 128 * 64;
    for (int u = blk; u < BATCH * 16; u += G) {
        const size_t row0 = (size_t)(u >> 4) * SEQ + (u & 15) * 128;
        __syncthreads();
        for (int tt = 0; tt < 16; ++tt) { const int tok = wave * 16 + tt;
            const v4u raw = *(const GAS v4u*)(PROJ + (row0 + tok) * NPROJ + 2048 + lane * 8); float v[8]; float s = 0.f;
#pragma unroll
            for (int i = 0; i < 4; ++i) { v[2 * i] = bflo(raw[i]); v[2 * i + 1] = bfhi(raw[i]); s += v[2 * i] + v[2 * i + 1]; }
            const float mean = wave_sum(s) * (1.0f / 512.0f); float s2 = 0.f;
#pragma unroll
            for (int i = 0; i < 8; ++i) { const float d = v[i] - mean; s2 += d * d; }
            const float rstd = 1.0f / sqrtf(wave_sum(s2) * (1.0f / 512.0f) + EPS);
            if (lane == 0) { stats[2 * tok] = mean; stats[2 * tok + 1] = rstd; } }
        for (int g = 0; g < 8; ++g) {
            __syncthreads();
            { const int tok = tid >> 2, cb = (tid & 3) * 16; const GAS v4u* vp = (const GAS v4u*)(PROJ + (row0 + tok) * NPROJ + 2048 + g * 64 + cb);
              const float mean = stats[2 * tok], rstd = stats[2 * tok + 1];
#pragma unroll
              for (int hh = 0; hh < 2; ++hh) { const v4u raw = vp[hh];
#pragma unroll
                  for (int e = 0; e < 4; ++e) { const int c = g * 64 + cb + hh * 8 + 2 * e;
                      vln[tok * 64 + cb + hh * 8 + 2 * e] = (bflo(raw[e]) - mean) * rstd * lng[c] + lnb[c];
                      vln[tok * 64 + cb + hh * 8 + 2 * e + 1] = (bfhi(raw[e]) - mean) * rstd * lng[c + 1] + lnb[c + 1]; } } }
            { const int i = tid & 127, jq = tid >> 7;
#pragma unroll
              for (int jj = 0; jj < 8; ++jj) { const int j4 = (jq * 8 + jj) * 4; f32x4 w = *(const f32x4*)(Wsp + ((size_t)g * 128 + i) * 128 + j4);
                  if (i < 64 && j4 >= 64) w = (f32x4){0.f, 0.f, 0.f, 0.f};
                  Wt[(j4 + 0) * 132 + i] = w.x; Wt[(j4 + 1) * 132 + i] = w.y; Wt[(j4 + 2) * 132 + i] = w.z; Wt[(j4 + 3) * 132 + i] = w.w; } }
            __syncthreads();
            const int tc = tid & 15, ti = tid >> 4; float acc[4][4];
#pragma unroll
            for (int r = 0; r < 4; ++r)
#pragma unroll
                for (int c = 0; c < 4; ++c) acc[r][c] = 0.f;
            const int jmax = (wave < 4) ? 64 : 128;
            for (int j = 0; j < jmax; ++j) { const f32x4 a = *(const LAS f32x4*)(vln + j * 64 + 4 * tc); const f32x4 w = *(const LAS f32x4*)(Wt + j * 132 + 4 * ti);
#pragma unroll
                for (int r = 0; r < 4; ++r)
#pragma unroll
                    for (int c = 0; c < 4; ++c) acc[r][c] += w[r] * a[c]; }
#pragma unroll
            for (int r = 0; r < 4; ++r) { const int i = 4 * ti + r; const float bias = bsp[g * 128 + i];
                const v2u ur = *(const GAS v2u*)(PROJ + (row0 + i) * NPROJ + 1536 + g * 64 + 4 * tc);
                v2u o; o.x = pk2((acc[r][0] + bias) * bflo(ur.x), (acc[r][1] + bias) * bfhi(ur.x)); o.y = pk2((acc[r][2] + bias) * bflo(ur.y), (acc[r][3] + bias) * bfhi(ur.y));
                *(GAS v2u*)(MIX + (row0 + i) * D + 512 + g * 64 + 4 * tc) = o; }
        }
    }
    __syncthreads();
}
__device__ __forceinline__ void p0_spatial(const Args& P, int blk, int G) {
    PHASE_IDS();
    bf16* GW = (bf16*)(P.ws + WS_GW); const float* W = P.in[11];
    for (int idx = blk * (NWAVES * 64) + tid; idx < 2 * 8 * 128 * 128; idx += G * NWAVES * 64) {
        const int p = idx & 127, i = (idx >> 7) & 127, ks = p >> 4, hh = (p >> 3) & 1, jj = p & 7, j = 16 * ks + 8 * (jj >> 2) + 4 * hh + (jj & 3);
        const float w = ((j >> 6) <= (i >> 6)) ? W[(size_t)(idx & ~127) + j] : 0.f;
        GW[idx] = (bf16)f2bf(w); }
}
__device__ __forceinline__ void gmlp_phase(const bf16* PROJ, bf16* MIX, const float* lng, const float* lnb, const bf16* GW, const float* bsp, LAS unsigned char* lds, int blk, int G) {
    PHASE_IDS();
    typedef short bf16x8 __attribute__((ext_vector_type(8))); typedef float f32x16 __attribute__((ext_vector_type(16)));
    const int r32 = lane & 31, hi = lane >> 5, mi = wave >> 1, ci = wave & 1;
    for (int u = blk; u < BATCH * 16; u += G) {
        const size_t row0 = (size_t)(u >> 4) * SEQ + (u & 15) * 128;
        float gam[8], bet[8];
#pragma unroll
        for (int i = 0; i < 8; ++i) { gam[i] = lng[lane * 8 + i]; bet[i] = lnb[lane * 8 + i]; }
        __syncthreads();
        v4u rawn[4];
#pragma unroll
        for (int q = 0; q < 4; ++q) rawn[q] = *(const GAS v4u*)(PROJ + (row0 + wave * 16 + q) * NPROJ + 2048 + lane * 8);
#pragma unroll 1
        for (int tb = 0; tb < 16; tb += 4) {
            v4u raw4[4];
#pragma unroll
            for (int q = 0; q < 4; ++q) raw4[q] = rawn[q];
            if (tb + 4 < 16) {
#pragma unroll
                for (int q = 0; q < 4; ++q) rawn[q] = *(const GAS v4u*)(PROJ + (row0 + wave * 16 + tb + 4 + q) * NPROJ + 2048 + lane * 8); }
#pragma unroll
            for (int q = 0; q < 4; ++q) { const int tt = tb + q; const v4u raw = raw4[q]; float v[8]; float s = 0.f;
#pragma unroll
                for (int i = 0; i < 4; ++i) {
#ifdef GELU_IN_PROJ
                    v[2 * i] = bflo(raw[i]); v[2 * i + 1] = bfhi(raw[i]);
#else
                    const pg8::f32x2 ge = pg8::gelu_pk((pg8::f32x2){bflo(raw[i]), bfhi(raw[i])}); v[2 * i] = ge.x; v[2 * i + 1] = ge.y;
#endif
                    s += v[2 * i] + v[2 * i + 1]; }
                const float mean = wave_sum(s) * (1.0f / 512.0f); float s2 = 0.f;
#pragma unroll
                for (int i = 0; i < 8; ++i) { v[i] -= mean; s2 += v[i] * v[i]; }
                const float rstd = 1.0f / sqrtf(wave_sum(s2) * (1.0f / 512.0f) + EPS);
                v4u o;
#pragma unroll
                for (int i = 0; i < 4; ++i) o[i] = pk2(v[2 * i] * rstd * gam[2 * i] + bet[2 * i], v[2 * i + 1] * rstd * gam[2 * i + 1] + bet[2 * i + 1]);
                *(LAS v4u*)(lds + RING_OFF + (((lane >> 3) * 2 + ((lane >> 2) & 1)) * 8 + wave) * 1024 + tt * 64 + (lane & 3) * 16) = o; } }
        __syncthreads();
        const int nks = (mi < 2) ? 4 : 8;
        const LAS unsigned char* vb = lds + RING_OFF + ((lane >> 4) & 1) * 32 + (lane & 3) * 8 + (4 * hi + ((lane & 15) >> 2)) * 64;
        const int tokr = mi * 32 + r32;
        bf16x8 wfA[8], wfB[8]; v2u urA[4], urB[4]; float biasA = 0.f, biasB = 0.f;
#define GM_LOAD(g_, W_, U_, B_) do { const bf16* wrow_ = GW + ((size_t)(g_) * 128 + mi * 32 + r32) * 128 + hi * 8; \
            _Pragma("unroll") for (int ks = 0; ks < 8; ++ks) W_[ks] = *(const GAS bf16x8*)(wrow_ + ks * 16);     \
            const bf16* up_ = PROJ + (row0 + tokr) * NPROJ + 1536 + (g_) * 64 + ci * 32 + 4 * hi; \
            _Pragma("unroll") for (int gg = 0; gg < 4; ++gg) U_[gg] = *(const GAS v2u*)(up_ + 8 * gg); \
            B_ = bsp[(g_) * 128 + tokr]; } while (0)
#define GM_COMP(g_, W_, U_, B_) do { f32x16 acc; _Pragma("unroll") for (int i = 0; i < 16; ++i) acc[i] = 0.f; \
            _Pragma("unroll") for (int ks = 0; ks < 8; ++ks) if (ks < nks) { const LAS unsigned char* vp = vb + (((g_) * 2 + ci) * 8 + ks) * 1024; \
                const sba::s16x4 lo = sba::vtr(vp), hh = sba::vtr(vp + 512); const bf16x8 vf = (bf16x8){lo[0], lo[1], lo[2], lo[3], hh[0], hh[1], hh[2], hh[3]}; \
                acc = __builtin_amdgcn_mfma_f32_32x32x16_bf16(vf, W_[ks], acc, 0, 0, 0); } \
            bf16* op = MIX + (row0 + tokr) * D + 512 + (g_) * 64 + ci * 32 + 4 * hi; \
            _Pragma("unroll") for (int gg = 0; gg < 4; ++gg) { const v2u ur = U_[gg]; \
                const pg8::f32x2 ga = pg8::gelu_pk((pg8::f32x2){bflo(ur.x), bfhi(ur.x)}), gb = pg8::gelu_pk((pg8::f32x2){bflo(ur.y), bfhi(ur.y)}); \
                v2u o; o.x = pk2((acc[4 * gg] + B_) * ga.x, (acc[4 * gg + 1] + B_) * ga.y); o.y = pk2((acc[4 * gg + 2] + B_) * gb.x, (acc[4 * gg + 3] + B_) * gb.y); \
                *(GAS v2u*)(op + 8 * gg) = o; } } while (0)
        GM_LOAD(0, wfA, urA, biasA);
#pragma unroll 1
        for (int g = 0; g < 8; g += 2) {
            GM_LOAD(g + 1, wfB, urB, biasB);
            GM_COMP(g, wfA, urA, biasA);
            { const int g2 = (g + 2 < 8) ? g + 2 : 0; GM_LOAD(g2, wfA, urA, biasA); }
            GM_COMP(g + 1, wfB, urB, biasB);
        }
#undef GM_LOAD
#undef GM_COMP
    }
    __syncthreads();
}
__device__ __forceinline__ void moe_tables(const int* pcnt, LAS int* MT, LAS int* stage  , int p, int tid, bool first) {
    __syncthreads();
    if (first) { for (int i = tid; i < 4096; i += NWAVES * 64) stage[i] = pcnt[i]; }
    __syncthreads();
    if (tid < 16) { LAS int* M = MT + (tid >> 3) * MT_STRIDE; const int ee = tid & 7; int sacc = 0, pb = 0;
#pragma unroll 16
        for (int q = 0; q < 256; ++q) { if (q == p) pb = sacc; sacc += stage[q * 16 + tid]; }
        M[MT_TOT + ee] = sacc; M[MT_PBASE + ee] = pb; }
    __syncthreads();
    if (first) {
        if (tid == 0 || tid == 64) { LAS int* M = MT + (tid >> 6) * MT_STRIDE; int o = 0;
            for (int e = 0; e < 8; ++e) { M[MT_POFF + e] = o; o += ((M[MT_TOT + e] + 255) >> 8) << 8; }
            M[MT_POFF + 8] = o; M[MT_NT] = o >> 8; }
        __syncthreads();
#pragma unroll
        for (int k = 0; k < 2; ++k) { LAS int* M = MT + k * MT_STRIDE; LAS unsigned char* tile_e = (LAS unsigned char*)(M + MT_TILE); const int nt = M[MT_NT];
            for (int t = tid; t < nt; t += NWAVES * 64) { const int r = t * 256; int e = 0;
#pragma unroll
                for (int ee = 1; ee < 8; ++ee) if (r >= M[MT_POFF + ee]) e = ee;
                tile_e[t] = (unsigned char)e; } }
        __syncthreads();
    }
}
__device__ __forceinline__ void moe_gather2(const bf16* HB, unsigned char* XS, const int* pcnt, const int* tok_e, const int* tok_rank, const float* tok_gate, int* slot_tok, float* slot_gate,
                                            LAS int* MT, LAS unsigned char* lds, int blk, int G) {
    PHASE_IDS();
    LAS int* stage = (LAS int*)(lds + RING_OFF);
    moe_tables(pcnt, MT, stage, blk < T / 256 ? blk : 0, tid, true);
    if (blk == 0) {
        for (int k = 0; k < 2; ++k) { LAS int* M = MT + k * MT_STRIDE;
            for (int e = 0; e < 8; ++e) for (int s = M[MT_POFF + e] + M[MT_TOT + e] + tid; s < M[MT_POFF + e + 1]; s += NWAVES * 64) slot_tok[k * MAXTILES * 256 + s] = -1; }
    }
    for (int p = blk; p < T / 256; p += G) {
        if (p != blk) moe_tables(pcnt, MT, stage, p, tid, false);
        int myslot;
        { const int tj = p * 256 + wave * 32 + (lane >> 1), kj = lane & 1; const LAS int* M = MT + kj * MT_STRIDE;
          const int e = tok_e[tj * 2 + kj]; const int rk = tok_rank[tj * 2 + kj]; const float gt = tok_gate[tj * 2 + kj];
          myslot = kj * MAXTILES * 256 + M[MT_POFF + e] + M[MT_PBASE + e] + rk;
          slot_tok[myslot] = tj; slot_gate[myslot] = gt; }
#pragma unroll
        for (int r0 = 0; r0 < 32; r0 += 16) {
            v4u rowv[16];
#pragma unroll
            for (int q = 0; q < 16; ++q) rowv[q] = ((const GAS v4u*)((const unsigned char*)HB + (size_t)(p * 256 + wave * 32 + r0 + q) * D))[lane];
#pragma unroll
            for (int q = 0; q < 16; ++q) { const int sa = __shfl(myslot, 2 * (r0 + q)), sb = __shfl(myslot, 2 * (r0 + q) + 1);
                ((GAS v4u*)(XS + (size_t)sa * D))[lane] = rowv[q]; ((GAS v4u*)(XS + (size_t)sb * D))[lane] = rowv[q]; }
        }
    }
    __syncthreads();
}

template <bool OUT_F32>
__device__ __forceinline__ void moe_tail_combine(int k, const float* S, const bf16* xb, bf16* xbo, float* xf, const float* gate, const int* slot_tok, const float* slot_gate, LAS int* MT, int nsl, int blk, int G) {
    PHASE_IDS();
    const int ntk = MT[k * MT_STRIDE + MT_NT]; const int nwg = ntk * (D / 256); int full = (nwg / G) * G, ntail = nwg - full;
    if (ntail > 32) { full = nwg; ntail = 0; }
    pg8::StaticOrder SO; SO.init(ntk * 256, D, G, 0);
    const int gw = blk * NWAVES + wave, NGW = G * NWAVES;
    for (int idx = gw; idx < ntail * 256; idx += NGW) { const int q = idx >> 8, r = idx & 255;
        pg8::Unit u; SO.map(full + q, u); const int pmr = k * MAXTILES + u.pm;
        const int slot = pmr * 256 + r; const int tok = slot_tok[slot];
        if (tok < 0) continue;
        const float sg = slot_gate[slot]; const int col = u.pn * 256 + 4 * lane;
        f32x4 a = (f32x4){0.f, 0.f, 0.f, 0.f};
        for (int sl = 0; sl < nsl; ++sl) a += *(const f32x4*)(S + ((size_t)(q * nsl + sl) * 256 + r) * 256 + 4 * lane);
        const f32x4 g4 = *(const f32x4*)(gate + (size_t)(tok >> 11) * ADA + col);
        const v2u xw = *(const GAS v2u*)(xb + (size_t)tok * D + col);
        const f32x4 r4 = (f32x4){bflo(xw.x), bfhi(xw.x), bflo(xw.y), bfhi(xw.y)} + (g4 * sg) * a;
        if (OUT_F32) *(f32x4*)(xf + (size_t)tok * D + col) = r4;
        else { v2u o; o.x = pk2(r4[0], r4[1]); o.y = pk2(r4[2], r4[3]); *(GAS v2u*)(xbo + (size_t)tok * D + col) = o; } }
}

#ifndef SKIPMASK
#define SKIPMASK 0u
#endif
#define PH_ON(x) (((SKIPMASK) & (1u << (x))) == 0u)
#ifndef DBLMASK
#define DBLMASK 0u
#endif
#define PH_REP(x) for (int rep_ = 0; rep_ < ((((DBLMASK) >> (x)) & 1u) ? 2 : 1); ++rep_)
#define GRID_BAR() xcd_barrier(bar)
#define WS_() opaque_ptr(args.ws)
#define WG_SYNC() do { asm volatile("s_waitcnt vmcnt(0) lgkmcnt(0)" ::: "memory"); __syncthreads(); } while (0)
#ifndef PANEL_ORDER
typedef pg8::StaticOrder ChainOrder;
#define CHAIN_SYNC() GRID_BAR()
#else
typedef pg8::PanelOrder ChainOrder;
#define CHAIN_SYNC() WG_SYNC()
#endif
constexpr int MOE_NSL = 7, MOE_KSL = (DE / 2) / MOE_NSL;
__device__ __forceinline__ void moe_tail_split(int ntk, int G, int& full, int& ntail) { const int nwg = ntk * (D / 256); full = (nwg / G) * G; ntail = nwg - full; if (ntail > 32) { full = nwg; ntail = 0; } }
template <int K, int L>
__device__ __forceinline__ void moe_down_main(const Args& args, LAS unsigned char* lds, LAS int* MT, int blk, int G) {
    unsigned char* ws = WS_(); const int ntk = MT[K * MT_STRIDE + MT_NT]; int full, ntail; moe_tail_split(ntk, G, full, ntail);
    pg8::Gemm g{(const bf16*)(ws + WS_ACTM), (const bf16*)(ws + WS_MWD), ntk * 256, D, DE / 2, 0}; pg8::MoeOrder2L S; S.init(ntk * 256, D, G, blk);
    S.tile_e0 = (const LAS unsigned char*)(MT + MT_TILE); S.tile_e1 = (const LAS unsigned char*)(MT + MT_STRIDE + MT_TILE); S.ne_tiles = D / 256; S.nt0 = (K == 0) ? ntk : 0; S.base1 = MAXTILES; S.limit = full;
    pg8::EpiMoeDownB<(K == 1)> E{(const bf16*)(ws + WS_XB), (bf16*)(ws + WS_XB), args.out, (const bf16*)(ws + WS_G16), (const int*)(ws + WS_SLOTT), (const float*)(ws + WS_SLOTG)};
    pg8::gemm_phase<pg8::EpiMoeDownB<(K == 1)>, pg8::MoeOrder2L, true, true>(lds + RING_OFF, g, S, E);
}
template <int K>
__device__ __forceinline__ void moe_down_slices(const Args& args, LAS unsigned char* lds, LAS int* MT, int blk, int G) {
    unsigned char* ws2 = WS_(); const int ntk = MT[K * MT_STRIDE + MT_NT]; int full, ntail; moe_tail_split(ntk, G, full, ntail);
    if (ntail > 0) {
        pg8::Gemm g{(const bf16*)(ws2 + WS_ACTM), (const bf16*)(ws2 + WS_MWD), ntk * 256, D, MOE_KSL, DE / 2}; pg8::MoeTail2 S; S.init(ntk * 256, D, G, blk);
        S.tile_e0 = (const LAS unsigned char*)(MT + MT_TILE); S.tile_e1 = (const LAS unsigned char*)(MT + MT_STRIDE + MT_TILE); S.ne_tiles = D / 256; S.nt0 = (K == 0) ? ntk : 0; S.base1 = MAXTILES;
        S.base = full; S.ntail = ntail; S.nsl = MOE_NSL; S.ksl_bytes = MOE_KSL * 2;
        pg8::EpiTileF32F8 E{(float*)(ws2 + WS_XS) + (size_t)K * 32 * MOE_NSL * 65536};
        pg8::gemm_phase<pg8::EpiTileF32F8, pg8::MoeTail2, true, true>(lds + RING_OFF, g, S, E); }
}
template <int K, int L>
__device__ __forceinline__ void moe_down_combine(const Args& args, LAS int* MT, int blk, int G) {
    unsigned char* ws = WS_();
    moe_tail_combine<(K == 1)>(K, (const float*)(ws + WS_XS) + (size_t)K * 32 * MOE_NSL * 65536, (const bf16*)(ws + WS_XB), (bf16*)(ws + WS_XB), args.out,
                               (const float*)(ws + WS_ADA) + (size_t)L * 32 * ADA + 5 * D, (const int*)(ws + WS_SLOTT), (const float*)(ws + WS_SLOTG), MT, MOE_NSL, blk, G);
}
#define WS_() opaque_ptr(args.ws)
#define WG_SYNC() do { asm volatile("s_waitcnt vmcnt(0) lgkmcnt(0)" ::: "memory"); __syncthreads(); } while (0)
#ifndef PANEL_ORDER
typedef pg8::StaticOrder ChainOrder;
#define CHAIN_SYNC() GRID_BAR()
#else
typedef pg8::PanelOrder ChainOrder;
#define CHAIN_SYNC() WG_SYNC()
#endif
template <int K, int L>
__device__ __forceinline__ void moe_down_half(const Args& args, const XcdBarrier& bar, LAS unsigned char* lds, LAS int* MT, int blk, int G) {
    constexpr int NSL = 7, KSL = (DE / 2) / NSL;
    if (PH_ON(14)) { unsigned char* ws = WS_(); const int ntk = MT[K * MT_STRIDE + MT_NT];
      const int nwg = ntk * (D / 256); int full = (nwg / G) * G, ntail = nwg - full;
      if (ntail > 32) { full = nwg; ntail = 0; }
      { pg8::Gemm g{(const bf16*)(ws + WS_ACTM), (const bf16*)(ws + WS_MWD), ntk * 256, D, DE / 2, 0}; pg8::MoeOrder2L S; S.init(ntk * 256, D, G, blk);
        S.tile_e0 = (const LAS unsigned char*)(MT + MT_TILE); S.tile_e1 = (const LAS unsigned char*)(MT + MT_STRIDE + MT_TILE); S.ne_tiles = D / 256; S.nt0 = (K == 0) ? ntk : 0; S.base1 = MAXTILES; S.limit = full;
        pg8::EpiMoeDownB<(K == 1)> E{(const bf16*)(ws + WS_XB), (bf16*)(ws + WS_XB), args.out, (const bf16*)(ws + WS_G16), (const int*)(ws + WS_SLOTT), (const float*)(ws + WS_SLOTG)};
        pg8::gemm_phase<pg8::EpiMoeDownB<(K == 1)>, pg8::MoeOrder2L, true, true>(lds + RING_OFF, g, S, E); }
      if (ntail > 0) { unsigned char* ws2 = WS_();
        pg8::Gemm g{(const bf16*)(ws2 + WS_ACTM), (const bf16*)(ws2 + WS_MWD), ntk * 256, D, KSL, DE / 2}; pg8::MoeTail2 S; S.init(ntk * 256, D, G, blk);
        S.tile_e0 = (const LAS unsigned char*)(MT + MT_TILE); S.tile_e1 = (const LAS unsigned char*)(MT + MT_STRIDE + MT_TILE); S.ne_tiles = D / 256; S.nt0 = (K == 0) ? ntk : 0; S.base1 = MAXTILES;
        S.base = full; S.ntail = ntail; S.nsl = NSL; S.ksl_bytes = KSL * 2;
        pg8::EpiTileF32F8 E{(float*)(ws2 + WS_XS) + (size_t)K * 32 * NSL * 65536};
        pg8::gemm_phase<pg8::EpiTileF32F8, pg8::MoeTail2, true, true>(lds + RING_OFF, g, S, E); } }
    GRID_BAR();
    if (PH_ON(14)) { unsigned char* ws = WS_();
      moe_tail_combine<(K == 1)>(K, (const float*)(ws + WS_XS) + (size_t)K * 32 * NSL * 65536, (const bf16*)(ws + WS_XB), (bf16*)(ws + WS_XB), args.out,
                                 (const float*)(ws + WS_ADA) + (size_t)L * 32 * ADA + 5 * D, (const int*)(ws + WS_SLOTT), (const float*)(ws + WS_SLOTG), MT, NSL, blk, G); }
}
template <int L>
__device__ __forceinline__ void layer_body(const Args& args, const XcdBarrier& bar, LAS unsigned char* lds, int blk, int G) {
    LAS int* MT = (LAS int*)(lds + MOE_OFF);
    PH_REP(2) if (PH_ON(2)) { unsigned char* ws = WS_();
        if constexpr (L == 0) norm_phase<false>(args.in[0], args.in[4] + L * D, (const float*)(ws + WS_ADA) + (size_t)L * 32 * ADA, 1 * D, 0 * D, (bf16*)(ws + WS_HB),
                          nullptr, nullptr, nullptr, nullptr, nullptr, nullptr, lds, blk, G);
        else norm_phase<false, false, true>((const float*)(ws + WS_XB), args.in[4] + L * D, (const float*)(ws + WS_ADA) + (size_t)L * 32 * ADA, 1 * D, 0 * D, (bf16*)(ws + WS_HB),
                          nullptr, nullptr, nullptr, nullptr, nullptr, nullptr, lds, blk, G); }
    CHAIN_SYNC();
    PH_REP(3) if (PH_ON(3)) { unsigned char* ws = WS_();
      pg8::Gemm g{(const bf16*)(ws + WS_HB), (const bf16*)(ws + WS_WIN) + (size_t)L * NPROJ * D, T, NPROJ, D}; ChainOrder S; S.init(T, NPROJ, G, blk);
      pg8::EpiProjQK E{(bf16*)(ws + WS_BIG), args.in[7] + L * 64, args.in[8] + L * 64, C2, EPS};
      pg8::gemm_phase<pg8::EpiProjQK, ChainOrder, true, true>(lds + RING_OFF, g, S, E); }
    GRID_BAR();
    PH_REP(5) if (PH_ON(5)) { unsigned char* ws = WS_();
        sba::attn_phase((const bf16*)(ws + WS_BIG), (bf16*)(ws + WS_HB), lds, blk, G); }
    PH_REP(6) if (PH_ON(6)) { unsigned char* ws = WS_();
        gmlp_phase((const bf16*)(ws + WS_BIG), (bf16*)(ws + WS_HB), args.in[9] + L * 512, args.in[10] + L * 512, (const bf16*)(ws + WS_GW) + (size_t)L * 8 * 128 * 128, args.in[12] + L * 8 * 128, lds, blk, G); }
    GRID_BAR();
    if (PH_ON(7)) { unsigned char* ws = WS_();
      pg8::Gemm g{(const bf16*)(ws + WS_HB), (const bf16*)(ws + WS_WOUT) + (size_t)L * D * D, T, D, D}; ChainOrder S; S.init(T, D, G, blk);
      if constexpr (L == 0) { pg8::EpiResidB<true, false> E{(const void*)args.in[0], (bf16*)(ws + WS_XB), (const float*)(ws + WS_ADA) + (size_t)L * 32 * ADA + 2 * D};
        pg8::gemm_phase<pg8::EpiResidB<true, false>, ChainOrder, true, true>(lds + RING_OFF, g, S, E); }
      else { pg8::EpiResidB<false, false> E{(const void*)(ws + WS_XB), (bf16*)(ws + WS_XB), (const float*)(ws + WS_ADA) + (size_t)L * 32 * ADA + 2 * D};
        pg8::gemm_phase<pg8::EpiResidB<false, false>, ChainOrder, true, true>(lds + RING_OFF, g, S, E); } }
    CHAIN_SYNC();
    if constexpr (L == 0) {
        if (PH_ON(8)) { unsigned char* ws = WS_();
            norm_phase<false, (FFN_GU_FP8 != 0), true>((const float*)(ws + WS_XB), args.in[5] + L * D, (const float*)(ws + WS_ADA) + (size_t)L * 32 * ADA, 4 * D, 3 * D, (bf16*)(ws + WS_HB),
                              nullptr, nullptr, nullptr, nullptr, nullptr, nullptr, lds, blk, G); }
        CHAIN_SYNC();
        PH_REP(9) if (PH_ON(9)) { unsigned char* ws = WS_();
#if FFN_GU_FP8
          pg8::Gemm g{(const bf16*)(ws + WS_HB), (const bf16*)(ws + WS_WGU), T, 2 * FF, D / 2, 0}; ChainOrder S; S.init(T, 2 * FF, G, blk);
          typedef pg8::EpiSwigluX<true, (FFN_DOWN_FP8 != 0)> EpiGU; EpiGU E{ws + WS_ACT, FF};
          pg8::gemm_phase<EpiGU, ChainOrder, true, true>(lds + RING_OFF, g, S, E); }
#elif FFN_DOWN_FP8
          pg8::Gemm g{(const bf16*)(ws + WS_HB), (const bf16*)(ws + WS_WGU), T, 2 * FF, D}; ChainOrder S; S.init(T, 2 * FF, G, blk);
          pg8::EpiSwigluO8 E{ws + WS_ACT, FF};
          pg8::gemm_phase<pg8::EpiSwigluO8, ChainOrder, true, true>(lds + RING_OFF, g, S, E); }
#else
          pg8::Gemm g{(const bf16*)(ws + WS_HB), (const bf16*)(ws + WS_WGU), T, 2 * FF, D}; ChainOrder S; S.init(T, 2 * FF, G, blk);
          pg8::EpiSwiglu E{(bf16*)(ws + WS_ACT), FF};
          pg8::gemm_phase<pg8::EpiSwiglu, ChainOrder, true, true>(lds + RING_OFF, g, S, E); }
#endif
        CHAIN_SYNC();
        if (PH_ON(10)) { unsigned char* ws = WS_();
#if FFN_DOWN_FP8
          pg8::Gemm g{(const bf16*)(ws + WS_ACT), (const bf16*)(ws + WS_WD), T, D, FF / 2, 0}; ChainOrder S; S.init(T, D, G, blk);
          pg8::EpiResidB<false, true> E{(const void*)(ws + WS_XB), (bf16*)(ws + WS_XB), (const float*)(ws + WS_ADA) + (size_t)L * 32 * ADA + 5 * D};
          pg8::gemm_phase<pg8::EpiResidB<false, true>, ChainOrder, true, true>(lds + RING_OFF, g, S, E); }
#else
          pg8::Gemm g{(const bf16*)(ws + WS_ACT), (const bf16*)(ws + WS_WD), T, D, FF}; ChainOrder S; S.init(T, D, G, blk);
          pg8::EpiResidB<false, false> E{(const void*)(ws + WS_XB), (bf16*)(ws + WS_XB), (const float*)(ws + WS_ADA) + (size_t)L * 32 * ADA + 5 * D};
          pg8::gemm_phase<pg8::EpiResidB<false, false>, ChainOrder, true, true>(lds + RING_OFF, g, S, E); }
#endif
        CHAIN_SYNC();
    } else {
        PH_REP(11) if (PH_ON(11)) { unsigned char* ws = WS_();
            norm_phase<true, true, true>((const float*)(ws + WS_XB), args.in[5] + L * D, (const float*)(ws + WS_ADA) + (size_t)L * 32 * ADA, 4 * D, 3 * D, (bf16*)(ws + WS_HB), args.in[17], args.in[18],
                             (int*)(ws + WS_PCNT), (int*)(ws + WS_TOKE), (int*)(ws + WS_TOKR), (float*)(ws + WS_TOKG), lds, blk, G); }
        GRID_BAR();
        PH_REP(12) if (PH_ON(12)) { unsigned char* ws = WS_();
            moe_gather2((const bf16*)(ws + WS_HB), ws + WS_XS, (const int*)(ws + WS_PCNT), (const int*)(ws + WS_TOKE), (const int*)(ws + WS_TOKR), (const float*)(ws + WS_TOKG),
                        (int*)(ws + WS_SLOTT), (float*)(ws + WS_SLOTG), MT, lds, blk, G); }
        GRID_BAR();
        PH_REP(13) if (PH_ON(13)) { unsigned char* ws = WS_(); const int nt0 = MT[MT_NT], nt1 = MT[MT_STRIDE + MT_NT];
          pg8::Gemm g{(const bf16*)(ws + WS_XS), (const bf16*)(ws + WS_MWGU), (nt0 + nt1) * 256, 2 * DE, D / 2, 0}; pg8::MoeOrder2 S; S.init((nt0 + nt1) * 256, 2 * DE, G, blk);
          S.tile_e0 = (const LAS unsigned char*)(MT + MT_TILE); S.tile_e1 = (const LAS unsigned char*)(MT + MT_STRIDE + MT_TILE); S.ne_tiles = 2 * DE / 256; S.nt0 = nt0; S.base1 = MAXTILES;
          pg8::EpiSwigluF8 E{ws + WS_ACTM, DE};
          pg8::gemm_phase<pg8::EpiSwigluF8, pg8::MoeOrder2, true, true>(lds + RING_OFF, g, S, E); }
        GRID_BAR();
        if (PH_ON(14)) { moe_down_main<0, L>(args, lds, MT, blk, G); moe_down_slices<0>(args, lds, MT, blk, G); moe_down_slices<1>(args, lds, MT, blk, G); }
        GRID_BAR();
        if (PH_ON(14)) moe_down_combine<0, L>(args, MT, blk, G);
        GRID_BAR();
        if (PH_ON(14)) { moe_down_main<1, L>(args, lds, MT, blk, G); moe_down_combine<1, L>(args, MT, blk, G); }
    }
}
__global__ void __launch_bounds__(NWAVES * 64, 2) mk_fwd(const Args args) {
    extern __shared__ __attribute__((aligned(16))) unsigned char lds_raw[];
    LAS unsigned char* lds = (LAS unsigned char*)lds_raw;
    volatile LAS unsigned* MISC = (volatile LAS unsigned*)(lds + MISC_OFF);
    const int G = gridDim.x, blk = blockIdx.x;
    for (int u = threadIdx.x; u < (LDS_BYTES - LDSCTL_OFF) / 4; u += NWAVES * 64) ((LAS unsigned*)(lds + LDSCTL_OFF))[u] = 0u;
    __syncthreads();
    const XcdBarrier bar = xcd_barrier_post((unsigned*)(args.ws + WS_CTL) + CW_BAR, MISC + 8);
    PH_REP(0) if (PH_ON(0)) p0_ada(args, lds, blk, G);
    PH_REP(1) if (PH_ON(1)) p0_transposes(args, lds, blk, G);
    if (PH_ON(1)) p0_spatial(args, blk, G);
    GRID_BAR();
#ifdef PROBE_BARS
    for (int i_ = 0; i_ < PROBE_BARS; ++i_) GRID_BAR();
#endif
    layer_body<0>(args, bar, lds, blk, G);
    layer_body<1>(args, bar, lds, blk, G);
}

extern "C" void kernel_launch(void* const* d_in, const int* in_sizes, int n_in, void* d_out, int out_size, void* d_ws, size_t ws_size, hipStream_t stream) {
    static int grid = 0;
    if (grid == 0) {
        if (n_in != 22 || in_sizes[0] != T * D || out_size != T * D || ws_size < WS_END) {
            fprintf(stderr, "kernel_launch: built for 22 inputs, x/out of %d floats, >= %zu bytes of workspace; got n_in %d, in0 %d, out %d, ws %zu; nothing launched\n", T * D, (size_t)WS_END, n_in, n_in > 0 ? in_sizes[0] : -1, out_size, ws_size);
            grid = -1; return; }
        int dev = 0, cus = 0, per_cu = 0;
        if (hipGetDevice(&dev) != hipSuccess || hipDeviceGetAttribute(&cus, hipDeviceAttributeMultiprocessorCount, dev) != hipSuccess) { fprintf(stderr, "kernel_launch: device query failed\n"); grid = -1; return; }
        if (hipFuncSetAttribute((const void*)mk_fwd, hipFuncAttributeMaxDynamicSharedMemorySize, LDS_BYTES) != hipSuccess) { fprintf(stderr, "kernel_launch: hipFuncSetAttribute failed\n"); grid = -1; return; }
        if (hipOccupancyMaxActiveBlocksPerMultiprocessor(&per_cu, (const void*)mk_fwd, NWAVES * 64, LDS_BYTES) != hipSuccess || per_cu < 1)
            fprintf(stderr, "kernel_launch: note: occupancy query reports %d workgroups per CU\n", per_cu);
        (void)hipGetLastError();
        grid = cus;
    }
    if (grid < 0) return;
    if (hipMemsetAsync((char*)d_ws + WS_CTL, 0, CTL_ZERO_BYTES, stream) != hipSuccess) { fprintf(stderr, "kernel_launch: memset failed\n"); return; }
    Args a{};
    for (int i = 0; i < 22; ++i) a.in[i] = (const float*)d_in[i];
    a.out = (float*)d_out; a.ws = (unsigned char*)d_ws;
    hipLaunchKernelGGL(mk_fwd, dim3(grid), dim3(NWAVES * 64), LDS_BYTES, stream, a);
    const hipError_t le = hipPeekAtLastError();
    if (le != hipSuccess) fprintf(stderr, "kernel_launch: launch failed: %s\n", hipGetErrorName(le));
}
```
